# Optimizing an MI355X kernel written in HIP

```python
import math
import jax, jax.numpy as jnp
from jax import lax
import numpy as np

D_MODEL = 1024
BATCH = 4
SEQ = 8192
DEPTH = 1

HEAD_DIM = 64
MIX_WIDTH = D_MODEL
NSA_WIDTH = MIX_WIDTH // 2
RWKV_WIDTH = MIX_WIDTH - NSA_WIDTH
NSA_HEADS = NSA_WIDTH // HEAD_DIM
NSA_KV_GROUPS = 2
NSA_HPG = NSA_HEADS // NSA_KV_GROUPS
NSA_KV_WIDTH = NSA_KV_GROUPS * HEAD_DIM
CMP_BLOCK = 32
CMP_STRIDE = 16
CMP_HIDDEN = 2 * HEAD_DIM
SLC_BLOCK = 64
SLC_TOPK = 16
WINDOW = 512
Q_BLOCK = 128
NSA_COLS = NSA_WIDTH + 6 * NSA_KV_WIDTH + 3 * NSA_HEADS
RWKV_HEADS = RWKV_WIDTH // HEAD_DIM
RWKV_W_LORA = 32
RWKV_A_LORA = 32
RWKV_G_LORA = 96
RWKV_COLS = 3 * RWKV_WIDTH + RWKV_W_LORA + RWKV_A_LORA + RWKV_G_LORA
IN_COLS = NSA_COLS + RWKV_COLS
DECAY_SCALE = math.exp(-0.5)
GN_EPS = 64e-5
N_EXPERTS = 32
TOP_K = 4
D_EXPERT = D_MODEL
SWIGLU_LIMIT = 7.0
SWIGLU_ALPHA = 1.702
MOE_BLOCK = 512
ROPE_THETA = 10000.0
RMS_EPS = 1e-6
NEG_INF = -1e30
FORCED = 1e9

kernel_name = 'hybrid_nsa_rwkv7_moe_block'


def _split(x, sizes):
    out, off = [], 0
    for s in sizes:
        out.append(x[..., off:off + s])
        off += s
    return out


def rms_norm(x, g):
    x32 = x.astype(jnp.float32)
    y = x32 * lax.rsqrt(jnp.mean(x32 * x32, axis=-1, keepdims=True) + RMS_EPS)
    return (y * g.astype(jnp.float32)).astype(x.dtype)


def rope_tables(seq_len):
    half = HEAD_DIM // 2
    inv_freq = ROPE_THETA ** (-jnp.arange(half, dtype=jnp.float32) / half)
    ang = jnp.arange(seq_len, dtype=jnp.float32)[:, None] * inv_freq[None, :]
    return jnp.cos(ang), jnp.sin(ang)


def apply_rope(x, cos, sin):
    half = HEAD_DIM // 2
    x32 = x.astype(jnp.float32)
    x1, x2 = x32[..., :half], x32[..., half:]
    c = cos[None, :, None, :]
    s = sin[None, :, None, :]
    return jnp.concatenate([x1 * c - x2 * s, x2 * c + x1 * s], axis=-1).astype(x.dtype)


def cmp_to_slc_overlap(seq_len):
    nc = (seq_len - CMP_BLOCK) // CMP_STRIDE + 1
    ns = seq_len // SLC_BLOCK
    c0 = jnp.arange(nc)[:, None] * CMP_STRIDE
    s0 = jnp.arange(ns)[None, :] * SLC_BLOCK
    ov = jnp.minimum(c0 + CMP_BLOCK, s0 + SLC_BLOCK) - jnp.maximum(c0, s0)
    return jnp.maximum(ov, 0).astype(jnp.float32) / CMP_BLOCK


def compress_blocks(tok, pe, w1, w2):
    B, S, G, Dh = tok.shape
    nc = (S - CMP_BLOCK) // CMP_STRIDE + 1
    idx = jnp.arange(nc)[:, None] * CMP_STRIDE + jnp.arange(CMP_BLOCK)[None, :]
    blk = tok[:, idx] + pe[None, None, :, None, :].astype(tok.dtype)
    blk = blk.transpose(0, 1, 3, 2, 4).reshape(B, nc, G, CMP_BLOCK * Dh)
    return jax.nn.gelu(blk @ w1) @ w2


def nsa_attention(feat, cos, sin, overlap, k_pe, k_w1, k_w2, v_pe, v_w1, v_w2):
    B, S, _ = feat.shape
    G, HPG, H, Dh = NSA_KV_GROUPS, NSA_HPG, NSA_HEADS, HEAD_DIM
    f32 = jnp.float32
    q, kc, vc, ks, vs, kw, vw, gl = _split(feat, (NSA_WIDTH,) + (NSA_KV_WIDTH,) * 6 + (3 * H,))
    kv = lambda t: t.reshape(B, S, G, Dh)
    q = apply_rope(q.reshape(B, S, H, Dh), cos, sin)
    kc, ks, kw = (apply_rope(kv(t), cos, sin) for t in (kc, ks, kw))
    vc, vs, vw = kv(vc), kv(vs), kv(vw)
    k_cmp = compress_blocks(kc, k_pe, k_w1, k_w2)
    v_cmp = compress_blocks(vc, v_pe, v_w1, v_w2)
    nc = k_cmp.shape[1]
    ns = S // SLC_BLOCK
    n_sel = min(SLC_TOPK, ns)
    to_blocks = lambda t: t.reshape(B, ns, SLC_BLOCK, G, Dh).transpose(0, 3, 1, 2, 4)
    k_slc, v_slc = to_blocks(ks), to_blocks(vs)
    pad = lambda t: jnp.pad(t.transpose(0, 2, 1, 3), ((0, 0), (0, 0), (WINDOW, 0), (0, 0)))
    k_win, v_win = pad(kw), pad(vw)
    qg = q.reshape(B, S, G, HPG, Dh).transpose(0, 2, 3, 1, 4)
    gates = jax.nn.sigmoid(gl.astype(f32)).reshape(B, S, G, HPG, 3).transpose(0, 2, 3, 1, 4)
    scale = HEAD_DIM ** -0.5
    cmp_last = jnp.arange(nc) * CMP_STRIDE + CMP_BLOCK - 1
    blk_ids = jnp.arange(ns)
    b_idx = jnp.arange(B)[:, None, None, None]
    g_idx = jnp.arange(G)[None, :, None, None]
    win_off = jnp.arange(WINDOW + Q_BLOCK) - WINDOW
    slc_off = jnp.arange(SLC_BLOCK)

    def chunk(ci):
        s0 = ci * Q_BLOCK
        t = s0 + jnp.arange(Q_BLOCK)
        qc = lax.dynamic_slice_in_dim(qg, s0, Q_BLOCK, axis=3)
        gc = lax.dynamic_slice_in_dim(gates, s0, Q_BLOCK, axis=3)
        sc = jnp.einsum('bghqd,bngd->bghqn', qc, k_cmp, preferred_element_type=f32) * scale
        cmask = cmp_last[None, :] <= t[:, None]
        p_cmp = jnp.where(cmask, jax.nn.softmax(jnp.where(cmask, sc, NEG_INF), axis=-1), 0.0)
        o_cmp = jnp.einsum('bghqn,bngd->bghqd', p_cmp.astype(v_cmp.dtype), v_cmp)
        imp = jnp.einsum('bghqn,nj->bgqj', p_cmp, overlap)
        cur = t // SLC_BLOCK
        forced = ((blk_ids[None, :] == 0) | (blk_ids[None, :] == cur[:, None])
                  | (blk_ids[None, :] == cur[:, None] - 1))
        future = blk_ids[None, :] * SLC_BLOCK > t[:, None]
        imp = jnp.where(future, NEG_INF, jnp.where(forced, FORCED, imp))
        _, sel = lax.top_k(imp, n_sel)
        k_sel = k_slc[b_idx, g_idx, sel].reshape(B, G, Q_BLOCK, n_sel * SLC_BLOCK, Dh)
        v_sel = v_slc[b_idx, g_idx, sel].reshape(B, G, Q_BLOCK, n_sel * SLC_BLOCK, Dh)
        sel_pos = (sel[..., None] * SLC_BLOCK + slc_off).reshape(B, G, Q_BLOCK, n_sel * SLC_BLOCK)
        smask = (sel_pos <= t[None, None, :, None])[:, :, None]
        ss = jnp.einsum('bghqd,bgqnd->bghqn', qc, k_sel, preferred_element_type=f32) * scale
        p_slc = jax.nn.softmax(jnp.where(smask, ss, NEG_INF), axis=-1)
        o_slc = jnp.einsum('bghqn,bgqnd->bghqd', p_slc.astype(v_sel.dtype), v_sel)
        k_w = lax.dynamic_slice_in_dim(k_win, s0, WINDOW + Q_BLOCK, axis=2)
        v_w = lax.dynamic_slice_in_dim(v_win, s0, WINDOW + Q_BLOCK, axis=2)
        wpos = s0 + win_off
        wmask = ((wpos[None, :] <= t[:, None]) & (wpos[None, :] > t[:, None] - WINDOW)
                 & (wpos[None, :] >= 0))
        sw = jnp.einsum('bghqd,bgkd->bghqk', qc, k_w, preferred_element_type=f32) * scale
        p_win = jax.nn.softmax(jnp.where(wmask, sw, NEG_INF), axis=-1)
        o_win = jnp.einsum('bghqk,bgkd->bghqd', p_win.astype(v_w.dtype), v_w)
        return gc[..., 0:1] * o_cmp + gc[..., 1:2] * o_slc + gc[..., 2:3] * o_win

    out = lax.map(chunk, jnp.arange(S // Q_BLOCK))
    return out.transpose(1, 0, 4, 2, 3, 5).reshape(B, S, NSA_WIDTH).astype(feat.dtype)


def rwkv7_time_mix(feat, mu, w0, w2, a0, a2, g2, k_k, k_a, r_k, ln_w, ln_b):
    B, S, _ = feat.shape
    H, N = RWKV_HEADS, HEAD_DIM
    f32 = jnp.float32
    prev = jnp.pad(feat[:, :-1], ((0, 0), (1, 0), (0, 0)))
    feat = feat + (prev - feat) * mu
    r, k, v, wd, ad, gd = _split(feat, (RWKV_WIDTH,) * 3 + (RWKV_W_LORA, RWKV_A_LORA, RWKV_G_LORA))
    decay = jnp.exp(-DECAY_SCALE * jax.nn.sigmoid((w0 + jnp.tanh(wd) @ w2).astype(f32)))
    a = jax.nn.sigmoid((a0 + ad @ a2).astype(f32))
    g = jax.nn.sigmoid(gd) @ g2
    heads = lambda t: t.astype(f32).reshape(B, S, H, N)
    kk = heads(k * k_k)
    kk = kk / jnp.maximum(jnp.sqrt(jnp.sum(kk * kk, axis=-1, keepdims=True)), 1e-12)
    k = k.astype(f32) * (1.0 + (a - 1.0) * k_a.astype(f32))
    r_h, w_h, k_h, v_h, a_h = heads(r), heads(decay), heads(k), heads(v), heads(a)

    def step(state, inp):
        r_t, w_t, k_t, v_t, kk_t, a_t = inp
        sa = jnp.einsum('bhij,bhj->bhi', state, -kk_t)
        state = (state * w_t[:, :, None, :] + sa[..., None] * (kk_t * a_t)[:, :, None, :]
                 + v_t[..., None] * k_t[:, :, None, :])
        return state, jnp.einsum('bhij,bhj->bhi', state, r_t)

    xs = tuple(jnp.moveaxis(t, 1, 0) for t in (r_h, w_h, k_h, v_h, kk, a_h))
    _, ys = lax.scan(step, jnp.zeros((B, H, N, N), f32), xs)
    y = jnp.moveaxis(ys, 0, 1)
    mean = jnp.mean(y, axis=-1, keepdims=True)
    var = jnp.mean(jnp.square(y - mean), axis=-1, keepdims=True)
    y = ((y - mean) * lax.rsqrt(var + GN_EPS)).reshape(B, S, RWKV_WIDTH)
    y = y * ln_w.astype(f32) + ln_b.astype(f32)
    bonus = (jnp.sum(r_h * k_h * r_k.astype(f32), axis=-1, keepdims=True) * v_h).reshape(B, S, RWKV_WIDTH)
    return ((y + bonus) * g.astype(f32)).astype(feat.dtype)


def moe_ffn(h, router_w, router_b, w_gate_up, b_gate_up, w_down, b_down):
    B, S, D = h.shape
    T = B * S
    xf = h.reshape(T, D)
    logits = (xf @ router_w).astype(jnp.float32) + router_b.astype(jnp.float32)
    top_val, top_idx = lax.top_k(logits, TOP_K)
    top_w = jax.nn.softmax(top_val, axis=-1)
    n_assign = T * TOP_K
    e_flat = top_idx.reshape(-1)
    tok_flat = jnp.arange(n_assign, dtype=jnp.int32) // TOP_K
    w_flat = top_w.reshape(-1)
    order = jnp.argsort(e_flat)
    e_sorted = e_flat[order]
    counts = jnp.bincount(e_flat, length=N_EXPERTS)
    starts = jnp.cumsum(counts) - counts
    padded = ((counts + MOE_BLOCK - 1) // MOE_BLOCK) * MOE_BLOCK
    pad_ends = jnp.cumsum(padded)
    pad_starts = pad_ends - padded
    dest = pad_starts[e_sorted] + (jnp.arange(n_assign) - starts[e_sorted])
    n_blocks = -(-n_assign // MOE_BLOCK) + N_EXPERTS
    P = n_blocks * MOE_BLOCK
    slot_tok = jnp.full((P,), T, jnp.int32).at[dest].set(tok_flat[order])
    slot_w = jnp.zeros((P,), jnp.float32).at[dest].set(w_flat[order])
    blk_expert = jnp.minimum(
        jnp.searchsorted(pad_ends, jnp.arange(n_blocks) * MOE_BLOCK, side='right'), N_EXPERTS - 1)
    x_pad = jnp.concatenate([xf, jnp.zeros((1, D), xf.dtype)], axis=0)

    def expert_block(args):
        tok, wt, e = args
        xb = x_pad[tok]
        gu = xb @ w_gate_up[e] + b_gate_up[e]
        gate, up = gu[:, :D_EXPERT], gu[:, D_EXPERT:]
        gate = jnp.minimum(gate, SWIGLU_LIMIT)
        up = jnp.clip(up, -SWIGLU_LIMIT, SWIGLU_LIMIT)
        glu = gate * jax.nn.sigmoid(gate * SWIGLU_ALPHA)
        out = ((up + 1.0) * glu) @ w_down[e] + b_down[e]
        return out * wt[:, None].astype(out.dtype)

    outs = lax.map(expert_block, (slot_tok.reshape(n_blocks, MOE_BLOCK),
                                  slot_w.reshape(n_blocks, MOE_BLOCK), blk_expert))
    y = jnp.zeros((T + 1, D), outs.dtype).at[slot_tok].add(outs.reshape(P, D))
    return y[:T].reshape(B, S, D)


def setup_inputs(seed: int = 0) -> dict:
    key = jax.random.key(seed)
    keys = iter(jax.random.split(key, 64))

    def nrm(shape, std):
        return std * jax.random.normal(next(keys), shape, jnp.float32)

    def gain(shape):
        return 1.0 + nrm(shape, 0.05)

    L, D, F, E = DEPTH, D_MODEL, D_EXPERT, N_EXPERTS
    LB = CMP_BLOCK * HEAD_DIM
    return {
        'x': nrm((BATCH, SEQ, D), 1.0),
        'c': nrm((BATCH, D), 1.0),
        'ada_w': nrm((L, D, 6 * D), 0.5 * D ** -0.5),
        'ada_b': nrm((L, 6 * D), 0.02),
        'mix_pre_norm': gain((L, D)),
        'mix_post_norm': gain((L, D)),
        'ffn_pre_norm': gain((L, D)),
        'ffn_post_norm': gain((L, D)),
        'w_in': nrm((L, D, IN_COLS), D ** -0.5),
        'cmp_k_pe': nrm((L, CMP_BLOCK, HEAD_DIM), 0.1),
        'cmp_k_w1': nrm((L, LB, CMP_HIDDEN), LB ** -0.5),
        'cmp_k_w2': nrm((L, CMP_HIDDEN, HEAD_DIM), CMP_HIDDEN ** -0.5),
        'cmp_v_pe': nrm((L, CMP_BLOCK, HEAD_DIM), 0.1),
        'cmp_v_w1': nrm((L, LB, CMP_HIDDEN), LB ** -0.5),
        'cmp_v_w2': nrm((L, CMP_HIDDEN, HEAD_DIM), CMP_HIDDEN ** -0.5),
        'nsa_out_norm': gain((L, NSA_WIDTH)),
        'rwkv_mu': jax.random.uniform(next(keys), (L, RWKV_COLS), jnp.float32),
        'rwkv_w0': nrm((L, RWKV_WIDTH), 0.5),
        'rwkv_w2': nrm((L, RWKV_W_LORA, RWKV_WIDTH), 0.5 * RWKV_W_LORA ** -0.5),
        'rwkv_a0': nrm((L, RWKV_WIDTH), 0.1),
        'rwkv_a2': nrm((L, RWKV_A_LORA, RWKV_WIDTH), 0.5 * RWKV_A_LORA ** -0.5),
        'rwkv_g2': nrm((L, RWKV_G_LORA, RWKV_WIDTH), RWKV_G_LORA ** -0.5),
        'rwkv_k_k': 0.85 + nrm((L, RWKV_WIDTH), 0.05),
        'rwkv_k_a': gain((L, RWKV_WIDTH)),
        'rwkv_r_k': nrm((L, RWKV_HEADS, HEAD_DIM), 0.1),
        'rwkv_ln_w': gain((L, RWKV_WIDTH)),
        'rwkv_ln_b': nrm((L, RWKV_WIDTH), 0.02),
        'w_out': nrm((L, MIX_WIDTH, D), MIX_WIDTH ** -0.5),
        'router_w': nrm((L, D, E), D ** -0.5),
        'router_b': nrm((L, E), 0.01),
        'expert_w_gate_up': nrm((L, E, D, 2 * F), D ** -0.5),
        'expert_b_gate_up': nrm((L, E, 2 * F), 0.01),
        'expert_w_down': nrm((L, E, F, D), F ** -0.5),
        'expert_b_down': nrm((L, E, D), 0.01),
    }


def reference(x, c, ada_w, ada_b, mix_pre_norm, mix_post_norm, ffn_pre_norm, ffn_post_norm,
              w_in, cmp_k_pe, cmp_k_w1, cmp_k_w2, cmp_v_pe, cmp_v_w1, cmp_v_w2, nsa_out_norm,
              rwkv_mu, rwkv_w0, rwkv_w2, rwkv_a0, rwkv_a2, rwkv_g2, rwkv_k_k, rwkv_k_a, rwkv_r_k,
              rwkv_ln_w, rwkv_ln_b, w_out, router_w, router_b, expert_w_gate_up, expert_b_gate_up,
              expert_w_down, expert_b_down):
    S = x.shape[1]
    cos, sin = rope_tables(S)
    overlap = cmp_to_slc_overlap(S)
    c_act = jax.nn.silu(c)
    for l in range(DEPTH):
        ada = (c_act @ ada_w[l] + ada_b[l])[:, None, :]
        sh_m, sc_m, g_m, sh_f, sc_f, g_f = jnp.split(ada, 6, axis=-1)
        h = rms_norm(x, mix_pre_norm[l]) * (1.0 + sc_m) + sh_m
        proj = h @ w_in[l]
        o_nsa = nsa_attention(proj[..., :NSA_COLS], cos, sin, overlap, cmp_k_pe[l], cmp_k_w1[l],
                              cmp_k_w2[l], cmp_v_pe[l], cmp_v_w1[l], cmp_v_w2[l])
        o_rwkv = rwkv7_time_mix(proj[..., NSA_COLS:], rwkv_mu[l], rwkv_w0[l], rwkv_w2[l], rwkv_a0[l],
                                rwkv_a2[l], rwkv_g2[l], rwkv_k_k[l], rwkv_k_a[l], rwkv_r_k[l],
                                rwkv_ln_w[l], rwkv_ln_b[l])
        mixed = jnp.concatenate([rms_norm(o_nsa, nsa_out_norm[l]), o_rwkv], axis=-1) @ w_out[l]
        x = x + g_m * rms_norm(mixed, mix_post_norm[l])
        h = rms_norm(x, ffn_pre_norm[l]) * (1.0 + sc_f) + sh_f
        y = moe_ffn(h, router_w[l], router_b[l], expert_w_gate_up[l], expert_b_gate_up[l],
                    expert_w_down[l], expert_b_down[l])
        x = x + g_f * rms_norm(y, ffn_post_norm[l])
    return x
```

```cpp
#include <hip/hip_runtime.h>
#include <hip/hip_cooperative_groups.h>
#include <cstdio>
#include <cstdint>
namespace cg = cooperative_groups;

#ifndef MK_ONE_LAUNCH
#define MK_ONE_LAUNCH 1
#endif

typedef unsigned short bf16_t;
typedef short bf16x8 __attribute__((ext_vector_type(8)));
typedef float f32x4 __attribute__((ext_vector_type(4)));
typedef unsigned u32x4 __attribute__((ext_vector_type(4)));
typedef unsigned u32x2 __attribute__((ext_vector_type(2)));
typedef int i32x8 __attribute__((ext_vector_type(8)));
typedef int i32x4 __attribute__((ext_vector_type(4)));
typedef short s16x16 __attribute__((ext_vector_type(16)));
#define LAS __attribute__((address_space(3)))

constexpr int NB = 4, S = 8192, T = NB * S, D = 1024;
constexpr int NP = 3072;
constexpr int Q0 = 0, KC0 = 512, VC0 = 640, KS0 = 768, VS0 = 896, KW0 = 1024, VW0 = 1152, R0 = 1280, K0 = 1792, V0 = 2304, GL0 = 2816, WD0 = 2840;
constexpr int IN_COLS = 3000;
constexpr int NE = 32;
constexpr int NTHREADS = 512, NWAVES = 8;
constexpr int NPHASES = 15;
#ifndef EXPERT_CONV_IN_SCAN
#define EXPERT_CONV_IN_SCAN 1
#endif
constexpr int LDS_RING = 139264, LDS_TOTAL = 155648;

constexpr size_t MiB = 1u << 20;
constexpr size_t WS_CTL = 0;
constexpr size_t WS_BAR = 65536;
constexpr size_t WS_ADA = 1 * MiB;
constexpr size_t WS_COS = 2 * MiB, WS_SIN = 3 * MiB;
constexpr size_t WS_WIN = 4 * MiB;
constexpr size_t WS_WOUT = 10 * MiB;
constexpr size_t WS_CW1 = 12 * MiB;
constexpr size_t WS_CMP = 14 * MiB;
constexpr size_t WS_HID = 16 * MiB;
constexpr size_t WS_TOKW = 18 * MiB;
constexpr size_t WS_LIST = 984 * MiB;
constexpr size_t WS_BIAS1 = 23 * MiB;
constexpr size_t WS_WLORA = 23 * MiB + 65536;
constexpr size_t WS_LX = 768 * MiB;
constexpr size_t WS_WAG = 784 * MiB;
constexpr size_t WS_KVC = 24 * MiB;
constexpr size_t KVC_STRIDE = (size_t)(65536 + 16) * 64;
constexpr size_t WS_GU = 42 * MiB;
constexpr size_t WS_SROW = 138 * MiB;
constexpr size_t WS_QS = 139 * MiB;
constexpr size_t WS_H8 = 106 * MiB;
constexpr size_t WS_DN = 170 * MiB;
constexpr size_t WS_RA = 256 * MiB;
constexpr size_t WS_PROJ = 320 * MiB;
constexpr size_t WS_RW_W = 512 * MiB;
constexpr size_t WS_RW_R = 576 * MiB, WS_RW_K = 608 * MiB, WS_RW_V = 640 * MiB, WS_RW_KK = 672 * MiB, WS_RW_KKA = 704 * MiB, WS_RW_G = 736 * MiB;
constexpr size_t WS_Y = 768 * MiB;
constexpr size_t WS_ONSA = 832 * MiB;
constexpr size_t WS_MIXED = 320 * MiB;
constexpr size_t WS_ACT = 320 * MiB;
constexpr size_t WS_X1 = 600 * MiB;
constexpr size_t WS_YK = 728 * MiB;
constexpr size_t WS_H2X = 728 * MiB;
constexpr size_t WS_LOGP = 234 * MiB;
constexpr size_t WS_WRT = 250 * MiB;
constexpr size_t WS_KVI = 896 * MiB;
constexpr size_t WS_CMPI = 928 * MiB;
constexpr size_t WS_END = 1000 * MiB;

struct Params {
    const float* in[34];
    float* out;
    unsigned char* ws;
};
enum { I_X = 0, I_C, I_ADAW, I_ADAB, I_MIXPRE, I_MIXPOST, I_FFNPRE, I_FFNPOST, I_WIN, I_KPE, I_KW1, I_KW2, I_VPE, I_VW1, I_VW2, I_NSANORM,
       I_MU, I_W0, I_W2, I_A0, I_A2, I_G2, I_KK, I_KA, I_RK, I_LNW, I_LNB, I_WOUT, I_RW, I_RB, I_EGU, I_EBGU, I_EDN, I_EBDN };

__device__ __forceinline__ unsigned f2bf(float f) { unsigned u = __builtin_bit_cast(unsigned, f); return (u + 0x7fffu + ((u >> 16) & 1u)) >> 16; }
__device__ __forceinline__ float bf2f(unsigned short h) { return __builtin_bit_cast(float, (unsigned)h << 16); }
typedef float f32x2_pk __attribute__((ext_vector_type(2))); typedef __bf16 bf16x2_pk __attribute__((ext_vector_type(2)));
__device__ __forceinline__ unsigned pk2(float lo, float hi) { f32x2_pk v = {lo, hi}; bf16x2_pk b = __builtin_convertvector(v, bf16x2_pk); return __builtin_bit_cast(unsigned, b); }
__device__ __forceinline__ unsigned pk4f8(float a, float b, float c, float d) { int w = 0; w = __builtin_amdgcn_cvt_pk_fp8_f32(a, b, w, false); w = __builtin_amdgcn_cvt_pk_fp8_f32(c, d, w, true); return (unsigned)w; }
__device__ __forceinline__ float wave_sum(float v) {
#pragma unroll
    for (int o = 1; o < 64; o <<= 1) v += __shfl_xor(v, o);
    return v;
}
__device__ __forceinline__ float wave_max(float v) {
#pragma unroll
    for (int o = 1; o < 64; o <<= 1) v = fmaxf(v, __shfl_xor(v, o));
    return v;
}
__device__ __forceinline__ unsigned pk4i8(float a, float b, float c, float d) {
    const int ia = (int)__builtin_rintf(__builtin_amdgcn_fmed3f(a, -127.f, 127.f)), ib = (int)__builtin_rintf(__builtin_amdgcn_fmed3f(b, -127.f, 127.f)), ic = (int)__builtin_rintf(__builtin_amdgcn_fmed3f(c, -127.f, 127.f)), id = (int)__builtin_rintf(__builtin_amdgcn_fmed3f(d, -127.f, 127.f));
    return (unsigned)(ia & 255) | ((unsigned)(ib & 255) << 8) | ((unsigned)(ic & 255) << 16) | ((unsigned)id << 24);
}
__device__ __forceinline__ int tidx() { int t = (int)threadIdx.x; asm volatile("" : "+v"(t)); return t; }
__device__ __forceinline__ float sigmoidf_(float x) { return 1.f / (1.f + __expf(-x)); }
__device__ __forceinline__ void unpack8(u32x4 u, float (&f)[8]) {
    f[0] = __builtin_bit_cast(float, u.x << 16); f[1] = __builtin_bit_cast(float, u.x & 0xffff0000u); f[2] = __builtin_bit_cast(float, u.y << 16); f[3] = __builtin_bit_cast(float, u.y & 0xffff0000u);
    f[4] = __builtin_bit_cast(float, u.z << 16); f[5] = __builtin_bit_cast(float, u.z & 0xffff0000u); f[6] = __builtin_bit_cast(float, u.w << 16); f[7] = __builtin_bit_cast(float, u.w & 0xffff0000u);
}
__device__ __forceinline__ u32x4 pack8(const float (&f)[8]) { u32x4 o; o.x = pk2(f[0], f[1]); o.y = pk2(f[2], f[3]); o.z = pk2(f[4], f[5]); o.w = pk2(f[6], f[7]); return o; }
__device__ __forceinline__ int rope_d(int p) { return ((p >> 2) & 1) * 32 + ((p >> 5) & 1) * 16 + ((p >> 3) & 3) * 4 + (p & 3); }

template <int MODE = 0, class PMap, class KMap>
__device__ __forceinline__ void tr_tile(const float* __restrict__ src, int Nsrc, bf16_t* __restrict__ dst, int K, int p0, int k0, PMap pmap, KMap kmap, float* tile  , float qmul = 32.f) {
    const int tx = tidx() & 63, ty = tidx() >> 6;
    const int c = pmap(p0 + tx);
    float v[32];
#pragma unroll
    for (int i = 0; i < 32; ++i) { const int kk = ty + 8 * i; v[i] = (c >= 0) ? src[(size_t)kmap(k0 + kk) * Nsrc + c] : 0.f; }
#pragma unroll
    for (int i = 0; i < 32; ++i) tile[(ty + 8 * i) * 65 + tx] = v[i];
    __syncthreads();
    { const int pp = tidx() >> 3, kq = tidx() & 7;
#pragma unroll
      for (int j = 0; j < 4; ++j) { const float* tp = tile + (64 * j + 8 * kq) * 65 + pp;
        if constexpr (MODE == 1) { u32x2 o; o.x = pk4f8(32.f * tp[0], 32.f * tp[65], 32.f * tp[2 * 65], 32.f * tp[3 * 65]); o.y = pk4f8(32.f * tp[4 * 65], 32.f * tp[5 * 65], 32.f * tp[6 * 65], 32.f * tp[7 * 65]);
          *(u32x2*)((unsigned char*)dst + (size_t)(p0 + pp) * K + k0 + 64 * j + 8 * kq) = o; }
        else if constexpr (MODE == 2) { u32x2 o; o.x = pk4i8(qmul * tp[0], qmul * tp[65], qmul * tp[2 * 65], qmul * tp[3 * 65]); o.y = pk4i8(qmul * tp[4 * 65], qmul * tp[5 * 65], qmul * tp[6 * 65], qmul * tp[7 * 65]);
          *(u32x2*)((unsigned char*)dst + (size_t)(p0 + pp) * K + k0 + 64 * j + 8 * kq) = o; }
        else { u32x4 o; o.x = pk2(tp[0], tp[65]); o.y = pk2(tp[2 * 65], tp[3 * 65]); o.z = pk2(tp[4 * 65], tp[5 * 65]); o.w = pk2(tp[6 * 65], tp[7 * 65]);
          *(u32x4*)(dst + (size_t)(p0 + pp) * K + k0 + 64 * j + 8 * kq) = o; } } }
    __syncthreads();
}
struct MapId { __device__ int operator()(int p) const { return p; } };
struct MapWin { __device__ int operator()(int P) const {
    if (P < 1280) { const bool rope = (P < 640) || (P >= 768 && P < 896) || (P >= 1024 && P < 1152); return rope ? (P & ~63) + rope_d(P & 63) : P; }
    return P < 2816 ? P + 24 : (P < 2840 ? P - 2816 + 1280 : (P < IN_COLS ? P : -1)); } };
struct MapGU { __device__ int operator()(int P) const { return ((P >> 7) & 1) * 1024 + (P >> 8) * 128 + (P & 127); } };
struct MapCW1P { __device__ int operator()(int P) const { return P < 128 ? P : -1; } };
struct MapCW1K { __device__ int operator()(int k) const { return (k & ~63) + rope_d(k & 63); } };

__device__ __forceinline__ float sample_qmul(const float* __restrict__ w, float* red  ) {
    const int tid = tidx(); float s = 0.f;
#pragma unroll
    for (int i = 0; i < 8; ++i) { const float v = w[tid + 512 * i]; s += v * v; }
    s = wave_sum(s);
    __syncthreads();
    if ((tid & 63) == 0) red[tid >> 6] = s;
    __syncthreads();
    const float tot = ((red[0] + red[1]) + (red[2] + red[3])) + ((red[4] + red[5]) + (red[6] + red[7]));
    __syncthreads();
    const float rms = sqrtf(tot * (1.f / 4096.f));
    return rms > 0.f ? 127.f / (6.f * rms) : 0.f;
}
__device__ __forceinline__ void phase0(const Params& P, float* lds) {
    unsigned char* ws = P.ws;
    const int tid = tidx();
    if (blockIdx.x == 0 && tid < 128) ((unsigned*)(ws + WS_CTL))[tid] = 0u;
    for (int e = blockIdx.x * NTHREADS + tid; e < 2 * 256 * 1024; e += gridDim.x * NTHREADS) {
        const int which = e >> 18, n = (e >> 10) & 255, k = e & 1023; unsigned o = 0u;
        if (n < 64 && (which == 0 || n < 32)) { const float w = P.in[I_RW][k * 32 + (n & 31)]; const unsigned hi = f2bf(w); o = n < 32 ? hi : f2bf(w - __builtin_bit_cast(float, hi << 16)); }
        ((bf16_t*)(ws + WS_WRT))[e] = (bf16_t)o;
    }
    for (int e = blockIdx.x * NTHREADS + tid; e < 1536 * 256; e += gridDim.x * NTHREADS) {
        const int n = e >> 8, k = e & 255; float v = 0.f;
        if (n < 512) { if (k < 32) v = P.in[I_W2][k * 512 + n]; }
        else if (n < 1024) { if (k >= 32 && k < 64) v = P.in[I_A2][(k - 32) * 512 + n - 512]; }
        else if (k >= 64 && k < 160) v = P.in[I_G2][(k - 64) * 512 + n - 1024];
        ((bf16_t*)(ws + WS_WLORA))[e] = (bf16_t)f2bf(v);
    }
    constexpr int U_ADA = 192, U_ROPE = 0, U_WIN = 48 * 4, U_WOUT = 16 * 4, U_CW1 = 2 * 4 * 8, U_B1 = 16, U_GU = 32 * 32 * 4, U_DN = 32 * 16 * 4;
    constexpr int TOTAL = U_ADA + U_ROPE + U_WIN + U_WOUT + U_CW1 + U_B1 + (EXPERT_CONV_IN_SCAN ? 0 : U_GU + U_DN);
    for (int u = blockIdx.x; u < TOTAL; u += gridDim.x) {
        int r = u;
        if (r < U_ADA) {
            float* cs = lds;
            float* part = lds + 4096;
            for (int i = tid; i < 4096; i += NTHREADS) { const float c0 = P.in[I_C][i]; cs[i] = c0 * sigmoidf_(c0); }
            __syncthreads();
            const int col = tid & 31, kg = tid >> 5, n = r * 32 + col;
            float a0 = 0.f, a1 = 0.f, a2 = 0.f, a3 = 0.f;
            const float* cw = P.in[I_ADAW] + (size_t)(kg * 64) * 6144 + n;
#pragma unroll 8
            for (int k = 0; k < 64; ++k) {
                const float w = cw[(size_t)k * 6144]; const int kk = kg * 64 + k;
                a0 += w * cs[kk]; a1 += w * cs[1024 + kk]; a2 += w * cs[2048 + kk]; a3 += w * cs[3072 + kk];
            }
            part[(kg * 4 + 0) * 32 + col] = a0; part[(kg * 4 + 1) * 32 + col] = a1; part[(kg * 4 + 2) * 32 + col] = a2; part[(kg * 4 + 3) * 32 + col] = a3;
            __syncthreads();
            if (tid < 128) { const int b = tid >> 5, j = tid & 31; float sacc = 0.f;
#pragma unroll
                for (int g = 0; g < 16; ++g) sacc += part[(g * 4 + b) * 32 + j];
                ((float*)(ws + WS_ADA))[b * 6144 + r * 32 + j] = sacc + P.in[I_ADAB][r * 32 + j]; }
            __syncthreads();
            continue;
        }
        r -= U_ADA;
        if (r < U_ROPE) {
            const int e = r * 512 + tid, t = e >> 5, j = e & 31;
            const double inv = pow(10000.0, -(double)j / 32.0);
            const float ang = (float)t * (float)inv;
            ((float*)(ws + WS_COS))[e] = (float)cos((double)ang);
            ((float*)(ws + WS_SIN))[e] = (float)sin((double)ang);
            continue;
        }
        r -= U_ROPE;
        if (r < U_WIN) { const float qm = sample_qmul(P.in[I_WIN], lds + 256 * 65); if (r == 0 && tid == 0) ((float*)(ws + WS_QS))[0] = qm > 0.f ? 1.f / qm : 0.f;
            tr_tile<2>(P.in[I_WIN], IN_COLS, (bf16_t*)(ws + WS_WIN), 1024, (r >> 2) * 64, (r & 3) * 256, MapWin(), MapId(), lds, qm); continue; }
        r -= U_WIN;
        if (r < U_WOUT) { tr_tile(P.in[I_WOUT], 1024, (bf16_t*)(ws + WS_WOUT), 1024, (r >> 2) * 64, (r & 3) * 256, MapId(), MapId(), lds); continue; }
        r -= U_WOUT;
        if (r < U_CW1) { const int kv = r >> 5, q = r & 31; bf16_t* dst = (bf16_t*)(ws + WS_CW1) + (size_t)kv * 256 * 2048;
            if (kv == 0) tr_tile(P.in[I_KW1], 128, dst, 2048, (q >> 3) * 64, (q & 7) * 256, MapCW1P(), MapCW1K(), lds);
            else tr_tile(P.in[I_VW1], 128, dst, 2048, (q >> 3) * 64, (q & 7) * 256, MapCW1P(), MapId(), lds);
            continue; }
        r -= U_CW1;
        if (r < U_B1) {
            const int kv = r >> 3, sl = r & 7;
            const float* pe = P.in[kv ? I_VPE : I_KPE]; const float* w1 = P.in[kv ? I_VW1 : I_KW1];
            const int n = tid & 127, qd = tid >> 7; float a = 0.f;
            const int kb = sl * 256 + qd * 64;
#pragma unroll 16
            for (int k = 0; k < 64; ++k) a += pe[kb + k] * w1[(size_t)(kb + k) * 128 + n];
            lds[tid] = a; __syncthreads();
            if (tid < 128) ((float*)(ws + WS_BIAS1))[(kv * 8 + sl) * 128 + tid] = (lds[tid] + lds[tid + 128]) + (lds[tid + 256] + lds[tid + 384]);
            __syncthreads();
            continue;
        }
        r -= U_B1;
        static_assert(EXPERT_CONV_IN_SCAN, "the expert weights (fp8) are converted by the scan units' loader waves");
    }
}

__device__ __forceinline__ void phase1(const Params& P) {
    const int lane = tidx() & 63, gw = blockIdx.x * NWAVES + (tidx() >> 6), ngw = gridDim.x * NWAVES;
    const float* ada = (const float*)(P.ws + WS_ADA);
    bf16_t* XN = (bf16_t*)(P.ws + WS_RA);
    for (int row = gw; row < T; row += ngw) {
        const int b = row / S;
        const f32x4* xr = (const f32x4*)(P.in[I_X] + (size_t)row * D) + lane;
        f32x4 v[4]; float s = 0.f;
#pragma unroll
        for (int j = 0; j < 4; ++j) { v[j] = xr[64 * j]; s += v[j].x * v[j].x + v[j].y * v[j].y + v[j].z * v[j].z + v[j].w * v[j].w; }
        const float rstd = rsqrtf(wave_sum(s) * (1.f / D) + 1e-6f);
        unsigned* o = (unsigned*)((unsigned char*)XN + (size_t)row * D) + lane;
        f32x4 h[4]; float am = 0.f;
#pragma unroll
        for (int j = 0; j < 4; ++j) {
            const int c = 4 * (lane + 64 * j);
            const f32x4 g = *(const f32x4*)(P.in[I_MIXPRE] + c), sh = *(const f32x4*)(ada + b * 6144 + c), sc = *(const f32x4*)(ada + b * 6144 + 1024 + c);
            h[j] = v[j] * rstd * g * (sc + 1.f) + sh;
            am = fmaxf(fmaxf(am, fmaxf(fabsf(h[j].x), fabsf(h[j].y))), fmaxf(fabsf(h[j].z), fabsf(h[j].w)));
        }
        am = wave_max(am);
        const float qm = am > 0.f ? 127.f / am : 0.f;
        if (lane == 0) ((float*)(P.ws + WS_SROW))[row] = am * (1.f / 127.f);
#pragma unroll
        for (int j = 0; j < 4; ++j) o[64 * j] = pk4i8(h[j].x * qm, h[j].y * qm, h[j].z * qm, h[j].w * qm);
    }
}

namespace g8 {
constexpr int BM = 256, BK = 64, HALF = 128, HTB = HALF * BK * 2, STAGE_BYTES = 8 * HTB;
__device__ __forceinline__ int lds_byte(int r, int c) { const int st = (r >> 4) * 2 + (c >> 5), rr = r & 15, cc = c & 31, ob = rr * 64 + cc * 2; return st * 1024 + (ob ^ (((ob >> 9) & 1) << 5)); }
__device__ __forceinline__ void stage_rc(int b, int& R, int& C) { const int st = b / 1024, sb = b % 1024, swz = sb ^ (((sb >> 9) & 1) << 5); R = (st >> 1) * 16 + swz / 64; C = (st & 1) * 32 + (swz % 64) / 2; }
__device__ __forceinline__ int perm32(int rho) { const int n = rho >> 4, i = rho & 15; return 8 * (i >> 2) + 4 * n + (i & 3); }
__device__ __forceinline__ i32x8 cat8(bf16x8 a, bf16x8 b) { const s16x16 v = __builtin_shufflevector(a, b, 0, 1, 2, 3, 4, 5, 6, 7, 8, 9, 10, 11, 12, 13, 14, 15); return __builtin_bit_cast(i32x8, v); }
__device__ __forceinline__ unsigned cvt_pk_bf16(float lo, float hi) { unsigned r; asm volatile("v_cvt_pk_bf16_f32 %0, %1, %2" : "=v"(r) : "v"(lo), "v"(hi)); return r; }

__device__ __forceinline__ void mma8(f32x4 (&c)[4][2], const bf16x8 (&At)[4][2], const bf16x8 (&Bt)[2][2]) {
    const i32x8 a0 = cat8(At[0][0], At[0][1]), a1 = cat8(At[1][0], At[1][1]), a2 = cat8(At[2][0], At[2][1]), a3 = cat8(At[3][0], At[3][1]), b0 = cat8(Bt[0][0], Bt[0][1]), b1 = cat8(Bt[1][0], Bt[1][1]);
    const unsigned one = 0x7f7f7f7fu;
    asm volatile("s_setprio 1\n\ts_nop 1\n\t"
                 "v_mfma_scale_f32_16x16x128_f8f6f4 %0, %8, %10, %0, %14, %14 op_sel_hi:[0,0,0]\n\t"
                 "v_mfma_scale_f32_16x16x128_f8f6f4 %1, %9, %10, %1, %14, %14 op_sel_hi:[0,0,0]\n\t"
                 "v_mfma_scale_f32_16x16x128_f8f6f4 %2, %8, %11, %2, %14, %14 op_sel_hi:[0,0,0]\n\t"
                 "v_mfma_scale_f32_16x16x128_f8f6f4 %3, %9, %11, %3, %14, %14 op_sel_hi:[0,0,0]\n\t"
                 "v_mfma_scale_f32_16x16x128_f8f6f4 %4, %8, %12, %4, %14, %14 op_sel_hi:[0,0,0]\n\t"
                 "v_mfma_scale_f32_16x16x128_f8f6f4 %5, %9, %12, %5, %14, %14 op_sel_hi:[0,0,0]\n\t"
                 "v_mfma_scale_f32_16x16x128_f8f6f4 %6, %8, %13, %6, %14, %14 op_sel_hi:[0,0,0]\n\t"
                 "v_mfma_scale_f32_16x16x128_f8f6f4 %7, %9, %13, %7, %14, %14 op_sel_hi:[0,0,0]\n\t"
                 "s_setprio 0"
                 : "+v"(c[0][0]), "+v"(c[0][1]), "+v"(c[1][0]), "+v"(c[1][1]), "+v"(c[2][0]), "+v"(c[2][1]), "+v"(c[3][0]), "+v"(c[3][1])
                 : "v"(b0), "v"(b1), "v"(a0), "v"(a1), "v"(a2), "v"(a3), "v"(one));
}

template <bool NOP>
__device__ __forceinline__ void mma8_settle(f32x4 (&c)[2][4][2]) {
#define G8_PIN16 "+v"(c[0][0][0]), "+v"(c[0][0][1]), "+v"(c[0][1][0]), "+v"(c[0][1][1]), "+v"(c[0][2][0]), "+v"(c[0][2][1]), "+v"(c[0][3][0]), "+v"(c[0][3][1]), \
                 "+v"(c[1][0][0]), "+v"(c[1][0][1]), "+v"(c[1][1][0]), "+v"(c[1][1][1]), "+v"(c[1][2][0]), "+v"(c[1][2][1]), "+v"(c[1][3][0]), "+v"(c[1][3][1])
    if constexpr (NOP) asm volatile("s_nop 15\n\ts_nop 7" : G8_PIN16); else asm volatile("" : G8_PIN16);
#undef G8_PIN16
}

struct Unit { const char* A; const char* B; unsigned va[2][2]; int x0, x1, x2, x3; };

template <bool PERM, int MODE = 0, class Epi, class Sched>
__device__ __forceinline__ void gemm_phase(LAS unsigned char* lds, int K, int ldb, const Sched& S, const Epi& E) {
    const int tid = tidx(), wid = __builtin_amdgcn_readfirstlane(tid >> 6), lane = tid & 63, wr = wid >> 2, wc = wid & 3, fr = lane & 15, fq = lane >> 4;
    int nt = K / BK; asm volatile("" : "+s"(nt));
    unsigned vb[2][2];
    { int R0, C0, R1, C1; stage_rc(tid * 16, R0, C0); stage_rc(tid * 16 + 8192, R1, C1);
      const int Rb0 = PERM ? ((R0 & ~31) + perm32(R0 & 31)) : R0, Rb1 = PERM ? ((R1 & ~31) + perm32(R1 & 31)) : R1;
      vb[0][0] = (unsigned)(Rb0 * ldb + C0) * 2u; vb[0][1] = (unsigned)(Rb1 * ldb + C1) * 2u; vb[1][0] = (unsigned)((Rb0 + HALF) * ldb + C0) * 2u; vb[1][1] = (unsigned)((Rb1 + HALF) * ldb + C1) * 2u; }
    const size_t kstep = (size_t)(BK * 2);
    const unsigned ldsw = (unsigned)wid * 1024u;
    const int aoff = lds_byte(wr * 64 + fr, fq * 8), boff = lds_byte(wc * 32 + fr, fq * 8);
#define G8_SA(b, h) (((b) * 2 + (h)) * HTB)
#define G8_SB(b, h) ((4 + (b) * 2 + (h)) * HTB)
#define G8_STAGE(bufoff, gbase, v0, v1) do { unsigned o0_ = (v0), o1_ = (v1); asm volatile("" : "+v"(o0_), "+v"(o1_));     \
        __builtin_amdgcn_global_load_lds((const unsigned*)((gbase) + o0_), (LAS unsigned*)(lds + (bufoff) + ldsw), 16, 0, 0); \
        __builtin_amdgcn_global_load_lds((const unsigned*)((gbase) + o1_), (LAS unsigned*)(lds + (bufoff) + ldsw + 8192), 16, 0, 0); } while (0)
#define G8_LDA(dst, b, h) do { _Pragma("unroll") for (int m = 0; m < 4; ++m) _Pragma("unroll") for (int k = 0; k < 2; ++k) dst[m][k] = *(const LAS bf16x8*)(lds + G8_SA(b, h) + aoff + m * 2048 + k * 1024); } while (0)
#define G8_LDB(dst, b, h) do { _Pragma("unroll") for (int n = 0; n < 2; ++n) _Pragma("unroll") for (int k = 0; k < 2; ++k) dst[n][k] = *(const LAS bf16x8*)(lds + G8_SB(b, h) + boff + n * 2048 + k * 1024); } while (0)
#define G8_MMA(ai, bj, At, Bt) do { if constexpr (MODE == 1) mma8(acc[ai][bj], At, Bt); else if constexpr (MODE == 2) { __builtin_amdgcn_s_setprio(1); _Pragma("unroll") for (int m = 0; m < 4; ++m) _Pragma("unroll") for (int n = 0; n < 2; ++n) _Pragma("unroll") for (int k = 0; k < 2; ++k) \
        acc[ai][bj][m][n] = __builtin_bit_cast(f32x4, __builtin_amdgcn_mfma_i32_16x16x64_i8(__builtin_bit_cast(i32x4, Bt[n][k]), __builtin_bit_cast(i32x4, At[m][k]), __builtin_bit_cast(i32x4, acc[ai][bj][m][n]), 0, 0, 0)); __builtin_amdgcn_s_setprio(0); } \
        else { __builtin_amdgcn_s_setprio(1); _Pragma("unroll") for (int m = 0; m < 4; ++m) _Pragma("unroll") for (int n = 0; n < 2; ++n) _Pragma("unroll") for (int k = 0; k < 2; ++k) \
        acc[ai][bj][m][n] = __builtin_amdgcn_mfma_f32_16x16x32_bf16(Bt[n][k], At[m][k], acc[ai][bj][m][n], 0, 0, 0); __builtin_amdgcn_s_setprio(0); } } while (0)
#define G8_WAIT_V(n) asm volatile("s_waitcnt vmcnt(" #n ")" ::: "memory")
#define G8_WAIT_L(n) asm volatile("s_waitcnt lgkmcnt(" #n ")" ::: "memory")
#define G8_BAR __builtin_amdgcn_s_barrier()
#define G8_SCHED __builtin_amdgcn_sched_barrier(0)
    Unit cur, nxt; int ui = 0;
#define G8_NEXT(i, u) ({ int R0_, C0_, R1_, C1_; const int t_ = tidx(); stage_rc(t_ * 16, R0_, C0_); stage_rc(t_ * 16 + 8192, R1_, C1_); S.next((i), (u), R0_, C0_, R1_, C1_); })
    if (!G8_NEXT(0, cur)) return;
    f32x4 acc[2][2][4][2];
#pragma unroll
    for (int a = 0; a < 2; ++a)
#pragma unroll
        for (int b = 0; b < 2; ++b)
#pragma unroll
            for (int m = 0; m < 4; ++m)
#pragma unroll
                for (int n = 0; n < 2; ++n) acc[a][b][m][n] = (f32x4){0.f, 0.f, 0.f, 0.f};
    bf16x8 At[4][2], B0[2][2], B1[2][2];
    G8_STAGE(G8_SB(0, 0), cur.B, vb[0][0], vb[0][1]); G8_STAGE(G8_SB(0, 1), cur.B, vb[1][0], vb[1][1]); G8_STAGE(G8_SA(0, 0), cur.A, cur.va[0][0], cur.va[0][1]); G8_STAGE(G8_SA(0, 1), cur.A, cur.va[1][0], cur.va[1][1]);
    if (wr == 1) G8_BAR;
    G8_WAIT_V(2); G8_BAR;
    G8_STAGE(G8_SB(1, 0), cur.B + kstep, vb[0][0], vb[0][1]); G8_STAGE(G8_SA(1, 0), cur.A + kstep, cur.va[0][0], cur.va[0][1]); G8_STAGE(G8_SB(1, 1), cur.B + kstep, vb[1][0], vb[1][1]);
    G8_WAIT_V(6); G8_BAR;
    for (;;) {
        const bool has_next = G8_NEXT(ui + 1, nxt);
        if (!has_next) nxt = cur;
        for (int t = 0; t < nt; t += 2) {
            const bool last = (t == nt - 2);
            const char* a1 = cur.A + (size_t)(t + 1) * kstep;
            const char* a2 = last ? nxt.A : cur.A + (size_t)(t + 2) * kstep; const char* b2 = last ? nxt.B : cur.B + (size_t)(t + 2) * kstep;
            const char* a3 = a2 + kstep; const char* b3 = b2 + kstep;
            const unsigned w00 = last ? nxt.va[0][0] : cur.va[0][0], w01 = last ? nxt.va[0][1] : cur.va[0][1], w10 = last ? nxt.va[1][0] : cur.va[1][0], w11 = last ? nxt.va[1][1] : cur.va[1][1];
            G8_LDB(B0, 0, 0); G8_LDB(B1, 0, 1); G8_SCHED; G8_LDA(At, 0, 0); G8_STAGE(G8_SA(1, 1), a1, cur.va[1][0], cur.va[1][1]);
            G8_WAIT_V(8); G8_WAIT_L(0); G8_BAR; G8_MMA(0, 0, At, B0); G8_MMA(0, 1, At, B1); G8_BAR; G8_SCHED;
            G8_LDA(At, 0, 1); G8_STAGE(G8_SB(0, 0), b2, vb[0][0], vb[0][1]); G8_STAGE(G8_SB(0, 1), b2, vb[1][0], vb[1][1]); G8_STAGE(G8_SA(0, 0), a2, w00, w01);
            G8_WAIT_V(8); G8_WAIT_L(0); G8_BAR; G8_MMA(1, 0, At, B0); G8_MMA(1, 1, At, B1); G8_BAR; G8_SCHED;
            G8_LDB(B0, 1, 0); G8_LDB(B1, 1, 1); G8_SCHED; G8_LDA(At, 1, 0); G8_STAGE(G8_SA(0, 1), a2, w10, w11);
            G8_WAIT_V(8); G8_WAIT_L(0); G8_BAR; G8_MMA(0, 0, At, B0); G8_MMA(0, 1, At, B1); G8_BAR; G8_SCHED;
            G8_LDA(At, 1, 1); G8_STAGE(G8_SB(1, 0), b3, vb[0][0], vb[0][1]); G8_STAGE(G8_SB(1, 1), b3, vb[1][0], vb[1][1]); G8_STAGE(G8_SA(1, 0), a3, w00, w01);
            G8_WAIT_V(8); G8_WAIT_L(0); G8_BAR; G8_MMA(1, 0, At, B0); G8_MMA(1, 1, At, B1); G8_BAR; G8_SCHED;
        }
        if (wr == 0) G8_BAR;
        if constexpr (MODE == 2) {
            const int fr_ = tidx() & 15;
            _Pragma("unroll") for (int a = 0; a < 2; ++a) _Pragma("unroll") for (int m = 0; m < 4; ++m) { const float sc = E.rs(cur, a * 128 + wr * 64 + m * 16 + fr_);
                _Pragma("unroll") for (int b = 0; b < 2; ++b) _Pragma("unroll") for (int n = 0; n < 2; ++n) _Pragma("unroll") for (int i = 0; i < 4; ++i) { const f32x4 t = acc[a][b][m][n]; const i32x4 ti = __builtin_bit_cast(i32x4, t); acc[a][b][m][n][i] = (float)ti[i] * sc; } }
        }
        if constexpr (MODE == 1) {
            mma8_settle<true>(acc[0]); mma8_settle<false>(acc[1]);
            _Pragma("unroll") for (int a = 0; a < 2; ++a) _Pragma("unroll") for (int b = 0; b < 2; ++b) _Pragma("unroll") for (int m = 0; m < 4; ++m) _Pragma("unroll") for (int n = 0; n < 2; ++n) acc[a][b][m][n] *= (1.f / 32.f);
        }
        { const int l_ = tidx() & 63; E(acc, cur, wr, wc, l_ & 15, l_ >> 4); }
        if (!has_next) break;
#pragma unroll
        for (int a = 0; a < 2; ++a)
#pragma unroll
            for (int b = 0; b < 2; ++b)
#pragma unroll
                for (int m = 0; m < 4; ++m)
#pragma unroll
                    for (int n = 0; n < 2; ++n) acc[a][b][m][n] = (f32x4){0.f, 0.f, 0.f, 0.f};
        cur = nxt; ++ui;
        if (wr == 1) G8_BAR;
    }
    G8_WAIT_V(0);
    G8_BAR;
#undef G8_NEXT
#undef G8_SA
#undef G8_SB
#undef G8_STAGE
#undef G8_LDA
#undef G8_LDB
#undef G8_MMA
#undef G8_WAIT_V
#undef G8_WAIT_L
#undef G8_BAR
#undef G8_SCHED
}

__device__ __forceinline__ const char* uptr(const void* p) {
    const unsigned long long v = (unsigned long long)p; const unsigned lo = __builtin_amdgcn_readfirstlane((unsigned)v), hi = __builtin_amdgcn_readfirstlane((unsigned)(v >> 32));
    return (const char*)(((unsigned long long)hi << 32) | lo); }
__device__ __forceinline__ int ui(int v) { return __builtin_amdgcn_readfirstlane(v); }
__device__ __forceinline__ void dense_unit(Unit& u, const bf16_t* A, int lda, const bf16_t* Bt, int ldb, int pm, int pn, int R0, int C0, int R1, int C1) {
    u.A = uptr(A + (size_t)pm * BM * lda); u.B = uptr(Bt + (size_t)pn * BM * ldb);
    u.va[0][0] = (unsigned)(R0 * lda + C0) * 2u; u.va[0][1] = (unsigned)(R1 * lda + C1) * 2u; u.va[1][0] = (unsigned)((R0 + HALF) * lda + C0) * 2u; u.va[1][1] = (unsigned)((R1 + HALF) * lda + C1) * 2u;
    u.x0 = ui(pm); u.x1 = ui(pn); u.x2 = 0; u.x3 = 0;
}
__device__ __forceinline__ bool static_tile(int i, int G, int c, int nM, int nN, int& pm, int& pn) {
    const int nwg = nM * nN; const long L = (long)i * G + c; if (L >= nwg) return false;
    int wgid = (int)L; { const int q = nwg / 8, r = nwg % 8, xcd = wgid % 8, off = wgid / 8; wgid = (xcd < r ? xcd * (q + 1) : r * (q + 1) + (xcd - r) * q) + off; }
    const int nig = 8 * nN, gid = wgid / nig, fm = gid * 8, gsz = (nM - fm) < 8 ? (nM - fm) : 8;
    pm = fm + ((wgid % nig) % gsz); pn = (wgid % nig) / gsz; return true;
}
}

struct SchedDense {
    const bf16_t* A; const bf16_t* Bt; int lda, ldb, nM, nN;
    __device__ __forceinline__ bool next(int i, g8::Unit& u, int R0, int C0, int R1, int C1) const {
        int pm, pn; if (!g8::static_tile(i, (int)gridDim.x, (int)blockIdx.x, nM, nN, pm, pn)) return false;
        g8::dense_unit(u, A, lda, Bt, ldb, pm, pn, R0, C0, R1, C1); return true;
    }
};
struct EpiInProj {
    bf16_t* proj; bf16_t* kvc; unsigned char* kvi; const float* COS; const float* SIN; const float* srow; const float* qs;
    __device__ __forceinline__ float rs(const g8::Unit& u, int r) const { return srow[u.x0 * 256 + r] * qs[0]; }
    __device__ __forceinline__ void operator()(const f32x4 (&acc)[2][2][4][2], const g8::Unit& u, int wr, int wc, int fr, int fq) const {
        const int pm = u.x0, pn = u.x1;
        f32x4 frv;
#pragma unroll
        for (int i = 0; i < 4; ++i) frv[i] = __builtin_amdgcn_exp2f(-(float)(16 * (wc & 1) + 4 * fq + i) * (13.287712379549449f / 32.f)) * 0.15915494309189535f;
#pragma unroll
        for (int ai = 0; ai < 2; ++ai)
#pragma unroll
            for (int m = 0; m < 4; ++m) {
                const int row = pm * 256 + ai * 128 + wr * 64 + m * 16 + fr, t = row & (S - 1);
                f32x4 cs = {0.f, 0.f, 0.f, 0.f}, sn = {0.f, 0.f, 0.f, 0.f};
                if (pn < 5) {
#pragma unroll
                    for (int i = 0; i < 4; ++i) { const float rev = __builtin_amdgcn_fractf((float)t * frv[i]); cs[i] = __builtin_amdgcn_cosf(rev); sn[i] = __builtin_amdgcn_sinf(rev); }
                }
                u32x4 w[2];
#pragma unroll
                for (int bj = 0; bj < 2; ++bj) {
                    f32x4 v0 = acc[ai][bj][m][0], v1 = acc[ai][bj][m][1];
                    if (pn < 2 || (pn < 5 && bj == 0)) { const f32x4 x1 = v0, x2 = v1; v0 = x1 * cs - x2 * sn; v1 = x2 * cs + x1 * sn; }
                    w[bj].x = g8::cvt_pk_bf16(v0[0], v0[1]); w[bj].y = g8::cvt_pk_bf16(v0[2], v0[3]); w[bj].z = g8::cvt_pk_bf16(v1[0], v1[1]); w[bj].w = g8::cvt_pk_bf16(v1[2], v1[3]);
                }
                if (pn == 3 || pn == 4) {
                    const int b = row / S, g = wc >> 1, key = t & 63;
                    unsigned char* ti = kvi + ((size_t)(((pn - 3) * NB + b) * 2 + g) * (S / 64) + (t >> 6)) * 16384;
                    *(u32x4*)(ti + ((wc & 1) * 4 + fq) * 1024 + key * 16) = w[0];
                    *(u32x4*)(ti + 8192 + (wc & 1) * 4096 + (key >> 4) * 1024 + (key & 15) * 64 + fq * 16) = w[1];
                } else {
                    bf16_t* pr = proj + (size_t)row * NP + pn * 256 + wc * 32 + 8 * fq;
                    *(u32x4*)pr = w[0]; *(u32x4*)(pr + 128) = w[1];
                    if (pn == 2) {
                        const int b = row / S, g = wc >> 1;
                        bf16_t* kp = kvc + ((size_t)((b * 2 + g) * S + t)) * 64 + (wc & 1) * 32 + 8 * fq;
                        *(u32x4*)kp = w[0]; *(u32x4*)(kp + KVC_STRIDE) = w[1];
                    }
                }
                asm volatile("" ::: "memory");
            }
    }
};
__device__ __forceinline__ void phase2(const Params& P, LAS unsigned char* lds) {
    unsigned char* ws = P.ws;
    SchedDense Sd{(const bf16_t*)(ws + WS_RA), (const bf16_t*)(ws + WS_WIN), D / 2, D / 2, T / 256, NP / 256};
    EpiInProj E{(bf16_t*)(ws + WS_PROJ), (bf16_t*)(ws + WS_KVC), ws + WS_KVI, (const float*)(ws + WS_COS), (const float*)(ws + WS_SIN), (const float*)(ws + WS_SROW), (const float*)(ws + WS_QS)};
    g8::gemm_phase<true, 2>(lds, D / 2, D / 2, Sd, E);
}

__device__ __forceinline__ float gelu_tanh(float x) { const float u = 0.7978845608028654f * (x + 0.044715f * x * x * x); return 0.5f * x * (1.f + tanhf(u)); }
struct SchedCmp {
    const bf16_t* kvc; const bf16_t* cw1;
    __device__ __forceinline__ bool next(int i, g8::Unit& u, int R0, int C0, int R1, int C1) const {
        const int id = (int)blockIdx.x + i * (int)gridDim.x; if (id >= 32) return false;
        const int kv = id >> 4, mt = id & 15;
        g8::dense_unit(u, kvc + (size_t)kv * KVC_STRIDE, 1024, cw1 + (size_t)kv * 256 * 2048, 2048, mt, 0, R0, C0, R1, C1); u.x2 = g8::ui(kv); return true;
    }
};
struct EpiCmp {
    bf16_t* hid; const float* bias1;
    __device__ __forceinline__ void operator()(const f32x4 (&acc)[2][2][4][2], const g8::Unit& u, int wr, int wc, int fr, int fq) const {
        const int kv = u.x2, col = wc * 32 + 8 * fq;
        f32x4 b0 = {0.f, 0.f, 0.f, 0.f}, b1 = {0.f, 0.f, 0.f, 0.f};
#pragma unroll
        for (int sl = 0; sl < 8; ++sl) { b0 += *(const f32x4*)(bias1 + (kv * 8 + sl) * 128 + col); b1 += *(const f32x4*)(bias1 + (kv * 8 + sl) * 128 + col + 4); }
#pragma unroll
        for (int ai = 0; ai < 2; ++ai)
#pragma unroll
            for (int m = 0; m < 4; ++m) {
                const int row = u.x0 * 256 + ai * 128 + wr * 64 + m * 16 + fr;
                const f32x4 v0 = acc[ai][0][m][0] + b0, v1 = acc[ai][0][m][1] + b1;
                u32x4 w; w.x = pk2(gelu_tanh(v0[0]), gelu_tanh(v0[1])); w.y = pk2(gelu_tanh(v0[2]), gelu_tanh(v0[3])); w.z = pk2(gelu_tanh(v1[0]), gelu_tanh(v1[1])); w.w = pk2(gelu_tanh(v1[2]), gelu_tanh(v1[3]));
                *(u32x4*)(hid + ((size_t)kv * 4096 + row) * 128 + col) = w;
            }
    }
};
__device__ __forceinline__ void phase3(const Params& P, LAS unsigned char* lds) {
    unsigned char* ws = P.ws;
    {
        SchedCmp Sc{(const bf16_t*)(ws + WS_KVC), (const bf16_t*)(ws + WS_CW1)};
        EpiCmp E{(bf16_t*)(ws + WS_HID), (const float*)(ws + WS_BIAS1)};
        g8::gemm_phase<true>(lds, 2048, 2048, Sc, E);
    }
    const bf16_t* proj = (const bf16_t*)(ws + WS_PROJ);
    const float* mu = P.in[I_MU];
    bf16_t* LX = (bf16_t*)(ws + WS_LX);
    for (int e = blockIdx.x * NTHREADS + tidx(); e < T * 32; e += gridDim.x * NTHREADS) {
        const int row = e >> 5, c0 = (e & 31) * 8, t = row & (S - 1);
        u32x4 o = {0u, 0u, 0u, 0u};
        if (c0 < 160) {
            const u32x4 cu = *(const u32x4*)(proj + (size_t)row * NP + WD0 + c0);
            u32x4 pu = {0u, 0u, 0u, 0u}; if (t > 0) pu = *(const u32x4*)(proj + (size_t)(row - 1) * NP + WD0 + c0);
            float cv[8], pv_[8], xs[8]; unpack8(cu, cv); unpack8(pu, pv_);
#pragma unroll
            for (int i = 0; i < 8; ++i) {
                float x = cv[i] + (pv_[i] - cv[i]) * mu[1536 + c0 + i];
                xs[i] = c0 < 32 ? tanhf(x) : (c0 >= 64 ? sigmoidf_(x) : x);
            }
            o = pack8(xs);
        }
        *(u32x4*)(LX + (size_t)row * 256 + c0) = o;
    }
}

struct EpiBf16 {
    bf16_t* O; int ldc;
    __device__ __forceinline__ void operator()(const f32x4 (&acc)[2][2][4][2], const g8::Unit& u, int wr, int wc, int fr, int fq) const {
#pragma unroll
        for (int ai = 0; ai < 2; ++ai)
#pragma unroll
            for (int m = 0; m < 4; ++m) {
                bf16_t* rowp = O + (size_t)(u.x0 * 256 + ai * 128 + wr * 64 + m * 16 + fr) * ldc + u.x1 * 256 + wc * 32 + 8 * fq;
#pragma unroll
                for (int bj = 0; bj < 2; ++bj) {
                    const f32x4 v0 = acc[ai][bj][m][0], v1 = acc[ai][bj][m][1];
                    u32x4 w; w.x = g8::cvt_pk_bf16(v0[0], v0[1]); w.y = g8::cvt_pk_bf16(v0[2], v0[3]); w.z = g8::cvt_pk_bf16(v1[0], v1[1]); w.w = g8::cvt_pk_bf16(v1[2], v1[3]);
                    *(u32x4*)(rowp + bj * 128) = w;
                }
            }
    }
};
__device__ __forceinline__ void phase4(const Params& P, LAS unsigned char* lds, float* ldsf) {
    unsigned char* ws = P.ws;
    {
        SchedDense Sd{(const bf16_t*)(ws + WS_LX), (const bf16_t*)(ws + WS_WLORA), 256, 256, T / 256, 1536 / 256};
        EpiBf16 E{(bf16_t*)(ws + WS_WAG), 1536};
        g8::gemm_phase<true>(lds, 256, 256, Sd, E);
    }
    __syncthreads();
    float* w2s = ldsf;
    float* hs = ldsf + 2 * 128 * 64 + (tidx() >> 6) * 128;
    for (int i = tidx(); i < 2 * 128 * 64 / 4; i += NTHREADS) { const int kv = i >> 11, j = i & 2047; ((f32x4*)w2s)[i] = ((const f32x4*)P.in[kv ? I_VW2 : I_KW2])[j]; }
    __syncthreads();
    const int lane = tidx() & 63, gw = blockIdx.x * NWAVES + (tidx() >> 6), ngw = gridDim.x * NWAVES;
    for (int item = gw; item < 2 * 4096; item += ngw) {
        const int kv = item >> 12, row = item & 4095;
        const unsigned hw = ((const unsigned*)((const bf16_t*)(ws + WS_HID) + ((size_t)kv * 4096 + row) * 128))[lane];
        hs[2 * lane] = __builtin_bit_cast(float, hw << 16); hs[2 * lane + 1] = __builtin_bit_cast(float, hw & 0xffff0000u);
        asm volatile("s_waitcnt lgkmcnt(0)" ::: "memory");
        const int ns = kv ? lane : rope_d(lane);
        const float* wc = w2s + kv * 8192 + ns;
        float a0 = 0.f, a1 = 0.f;
#pragma unroll 8
        for (int c = 0; c < 128; c += 4) { const f32x4 h4 = *(const f32x4*)(hs + c); a0 += h4.x * wc[c * 64] + h4.z * wc[(c + 2) * 64]; a1 += h4.y * wc[(c + 1) * 64] + h4.w * wc[(c + 3) * 64]; }
        const float a = a0 + a1;
        { const int bg = row >> 9, i = row & 511, key = i & 63, n = lane; unsigned char* ti = ws + WS_CMPI + ((size_t)bg * 8 + (i >> 6)) * 16384;
          if (kv == 0) *(bf16_t*)(ti + (n >> 3) * 1024 + key * 16 + (n & 7) * 2) = (bf16_t)f2bf(a);
          else *(bf16_t*)(ti + 8192 + (n >> 5) * 4096 + (key >> 4) * 1024 + (key & 15) * 64 + (n & 31) * 2) = (bf16_t)f2bf(a); }
        asm volatile("s_waitcnt lgkmcnt(0)" ::: "memory");
    }
}

__device__ __forceinline__ void phase5p(const Params& P) {
    unsigned char* ws = P.ws;
    const int lane = tidx() & 63, gw = blockIdx.x * NWAVES + (tidx() >> 6), ngw = gridDim.x * NWAVES, c0 = 8 * lane;
    const bf16_t* proj = (const bf16_t*)(ws + WS_PROJ); const bf16_t* wag = (const bf16_t*)(ws + WS_WAG);
    const float* mu = P.in[I_MU];
    float w0[8], a0v[8], kkw[8], kaw[8], mur[8], muk[8], muv[8];
#pragma unroll
    for (int i = 0; i < 8; ++i) { w0[i] = P.in[I_W0][c0 + i]; a0v[i] = P.in[I_A0][c0 + i]; kkw[i] = P.in[I_KK][c0 + i]; kaw[i] = P.in[I_KA][c0 + i]; mur[i] = mu[c0 + i]; muk[i] = mu[512 + c0 + i]; muv[i] = mu[1024 + c0 + i]; }
    for (int row = gw; row < T; row += ngw) {
        const bool has_prev = (row & (S - 1)) != 0;
        const bf16_t* pr = proj + (size_t)row * NP + c0; const bf16_t* pp = has_prev ? pr - NP : pr; const bf16_t* wg = wag + (size_t)row * 1536 + c0;
        const u32x4 r8 = *(const u32x4*)(pr + R0), k8 = *(const u32x4*)(pr + K0), v8 = *(const u32x4*)(pr + V0);
        const u32x4 rp8 = *(const u32x4*)(pp + R0), kp8 = *(const u32x4*)(pp + K0), vp8 = *(const u32x4*)(pp + V0);
        const u32x4 wl8 = *(const u32x4*)(wg), al8 = *(const u32x4*)(wg + 512), gg8 = *(const u32x4*)(wg + 1024);
        float rc[8], kc[8], vc[8], rp[8], kp[8], vp[8], wl[8], al[8];
        unpack8(r8, rc); unpack8(k8, kc); unpack8(v8, vc); unpack8(rp8, rp); unpack8(kp8, kp); unpack8(vp8, vp); unpack8(wl8, wl); unpack8(al8, al);
        float ro[8], ko[8], vo[8], wo[8], kk[8], kka[8], av[8]; float ss = 0.f;
#pragma unroll
        for (int i = 0; i < 8; ++i) {
            const float pr_ = has_prev ? rp[i] : 0.f, pk_ = has_prev ? kp[i] : 0.f, pv_ = has_prev ? vp[i] : 0.f;
            ro[i] = rc[i] + (pr_ - rc[i]) * mur[i]; const float k = kc[i] + (pk_ - kc[i]) * muk[i]; vo[i] = vc[i] + (pv_ - vc[i]) * muv[i];
            av[i] = sigmoidf_(a0v[i] + al[i]);
            wo[i] = __expf(-0.6065306597126334f * sigmoidf_(w0[i] + wl[i]));
            kk[i] = k * kkw[i]; ss += kk[i] * kk[i];
            ko[i] = k * (1.f + (av[i] - 1.f) * kaw[i]);
        }
        ss += __shfl_xor(ss, 1); ss += __shfl_xor(ss, 2); ss += __shfl_xor(ss, 4);
        const float inv = 1.f / fmaxf(sqrtf(ss), 1e-12f);
#pragma unroll
        for (int i = 0; i < 8; ++i) { kk[i] *= inv; kka[i] = kk[i] * av[i]; }
        const size_t o = (size_t)row * 512 + c0;
        *(f32x4*)((float*)(ws + WS_RW_W) + o) = (f32x4){wo[0], wo[1], wo[2], wo[3]}; *(f32x4*)((float*)(ws + WS_RW_W) + o + 4) = (f32x4){wo[4], wo[5], wo[6], wo[7]};
        *(u32x4*)((bf16_t*)(ws + WS_RW_R) + o) = pack8(ro); *(u32x4*)((bf16_t*)(ws + WS_RW_K) + o) = pack8(ko); *(u32x4*)((bf16_t*)(ws + WS_RW_V) + o) = pack8(vo);
        *(u32x4*)((bf16_t*)(ws + WS_RW_KK) + o) = pack8(kk); *(u32x4*)((bf16_t*)(ws + WS_RW_KKA) + o) = pack8(kka); *(u32x4*)((bf16_t*)(ws + WS_RW_G) + o) = gg8;
    }
}

namespace att {
typedef float f32x16 __attribute__((ext_vector_type(16)));
typedef short s16x4 __attribute__((ext_vector_type(4)));
typedef float f32x2_t __attribute__((ext_vector_type(2)));
typedef __bf16 bf16x2_t __attribute__((ext_vector_type(2)));
constexpr float C2 = 0.125f * 1.4426950408889634f;
constexpr int SLOT = 16384;
constexpr int GROUP = 3, NSLOT = 2 * GROUP;
constexpr int IMP_STRIDE = 136;
constexpr int WAVE_LDS = 256 + 8 * IMP_STRIDE * 4 + 128;
constexpr int WAVE_OFF = NSLOT * SLOT;
constexpr int LDS_NEED = WAVE_OFF + NWAVES * WAVE_LDS;
constexpr int QT = 8 * NWAVES;
constexpr float THR = 8.f;

__device__ __forceinline__ int crow(int r, int hi) { return (r & 3) + 8 * (r >> 2) + 4 * hi; }
__device__ __forceinline__ unsigned cvtpk(float lo, float hi) { f32x2_t v = {lo, hi}; bf16x2_t b = __builtin_convertvector(v, bf16x2_t); return __builtin_bit_cast(unsigned, b); }
__device__ __forceinline__ float ex2(float x) { return __builtin_amdgcn_exp2f(x); }

__device__ __forceinline__ void tile_dma(const unsigned char* gt, LAS unsigned char* slot, int wid, int lane) {
    const unsigned char* src = gt + wid * 2048 + lane * 16;
    __builtin_amdgcn_global_load_lds((const unsigned*)src, (LAS unsigned*)(slot + wid * 2048), 16, 0, 0);
    __builtin_amdgcn_global_load_lds((const unsigned*)(src + 1024), (LAS unsigned*)(slot + wid * 2048 + 1024), 16, 0, 0);
}
__device__ __forceinline__ void qkt(f32x16& p0, f32x16& p1, const LAS unsigned char* Kslot, const bf16x8 (&qr)[4], float cinit, int r32, int hi) {
    const LAS unsigned char* kb = Kslot + hi * 1024 + r32 * 16;
#pragma unroll
    for (int r = 0; r < 16; ++r) { p0[r] = cinit; p1[r] = cinit; }
#pragma unroll
    for (int d0 = 0; d0 < 4; ++d0) {
        const bf16x8 b0 = *(const LAS bf16x8*)(kb + d0 * 2048);
        const bf16x8 b1 = *(const LAS bf16x8*)(kb + d0 * 2048 + 512);
        p0 = __builtin_amdgcn_mfma_f32_32x32x16_bf16(b0, qr[d0], p0, 0, 0, 0);
        p1 = __builtin_amdgcn_mfma_f32_32x32x16_bf16(b1, qr[d0], p1, 0, 0, 0);
    }
}
struct VFrag { s16x4 lo[2][4], hi[2][4]; };
__device__ __forceinline__ void pv_read(VFrag& v, int vb) {
#pragma unroll
    for (int d0 = 0; d0 < 2; ++d0)
#pragma unroll
        for (int ks = 0; ks < 4; ++ks) {
            asm volatile("ds_read_b64_tr_b16 %0,%1 offset:%c2" : "=&v"(v.lo[d0][ks]) : "v"(vb), "i"(d0 * 4096 + ks * 1024) : "memory");
            asm volatile("ds_read_b64_tr_b16 %0,%1 offset:%c2" : "=&v"(v.hi[d0][ks]) : "v"(vb), "i"(d0 * 4096 + ks * 1024 + 512) : "memory");
        }
}
__device__ __forceinline__ void pv_mma(f32x16 (&o)[2], VFrag& v, bf16x8 pa0, bf16x8 pa1, bf16x8 pa2, bf16x8 pa3) {
    asm volatile("s_waitcnt lgkmcnt(0)" : "+v"(v.lo[0][0]), "+v"(v.lo[0][1]), "+v"(v.lo[0][2]), "+v"(v.lo[0][3]), "+v"(v.hi[0][0]), "+v"(v.hi[0][1]), "+v"(v.hi[0][2]), "+v"(v.hi[0][3]) :: "memory");
    asm volatile("" : "+v"(v.lo[1][0]), "+v"(v.lo[1][1]), "+v"(v.lo[1][2]), "+v"(v.lo[1][3]), "+v"(v.hi[1][0]), "+v"(v.hi[1][1]), "+v"(v.hi[1][2]), "+v"(v.hi[1][3]));
#pragma unroll
    for (int d0 = 0; d0 < 2; ++d0) {
#define ATT_PK(k) (bf16x8){v.lo[d0][k][0], v.lo[d0][k][1], v.lo[d0][k][2], v.lo[d0][k][3], v.hi[d0][k][0], v.hi[d0][k][1], v.hi[d0][k][2], v.hi[d0][k][3]}
        o[d0] = __builtin_amdgcn_mfma_f32_32x32x16_bf16(pa0, ATT_PK(0), o[d0], 0, 0, 0);
        o[d0] = __builtin_amdgcn_mfma_f32_32x32x16_bf16(pa1, ATT_PK(1), o[d0], 0, 0, 0);
        o[d0] = __builtin_amdgcn_mfma_f32_32x32x16_bf16(pa2, ATT_PK(2), o[d0], 0, 0, 0);
        o[d0] = __builtin_amdgcn_mfma_f32_32x32x16_bf16(pa3, ATT_PK(3), o[d0], 0, 0, 0);
#undef ATT_PK
    }
}
__device__ __forceinline__ float max3f(float a, float b, float c) { float r; asm("v_max3_f32 %0, %1, %2, %3" : "=v"(r) : "v"(a), "v"(b), "v"(c)); return r; }
__device__ __forceinline__ float max32(const f32x16& p0, const f32x16& p1) {
    float a = max3f(p0[0], p0[1], p1[0]), b = max3f(p0[2], p0[3], p1[1]); a = max3f(a, p1[2], p1[3]);
#pragma unroll
    for (int r = 4; r < 16; r += 4) { a = max3f(a, p0[r], p0[r + 1]); b = max3f(b, p0[r + 2], p0[r + 3]); a = max3f(a, p1[r], p1[r + 1]); b = max3f(b, p1[r + 2], p1[r + 3]); }
    a = fmaxf(a, b);
    return fmaxf(a, __shfl_xor(a, 32));
}
__device__ __forceinline__ void pack_p(const f32x16& p0, const f32x16& p1, bf16x8& a0, bf16x8& a1, bf16x8& a2, bf16x8& a3) {
    u32x4 w0 = {cvtpk(p0[0], p0[1]), cvtpk(p0[2], p0[3]), cvtpk(p0[4], p0[5]), cvtpk(p0[6], p0[7])};
    u32x4 w1 = {cvtpk(p0[8], p0[9]), cvtpk(p0[10], p0[11]), cvtpk(p0[12], p0[13]), cvtpk(p0[14], p0[15])};
    u32x4 w2 = {cvtpk(p1[0], p1[1]), cvtpk(p1[2], p1[3]), cvtpk(p1[4], p1[5]), cvtpk(p1[6], p1[7])};
    u32x4 w3 = {cvtpk(p1[8], p1[9]), cvtpk(p1[10], p1[11]), cvtpk(p1[12], p1[13]), cvtpk(p1[14], p1[15])};
    a0 = __builtin_bit_cast(bf16x8, w0); a1 = __builtin_bit_cast(bf16x8, w1); a2 = __builtin_bit_cast(bf16x8, w2); a3 = __builtin_bit_cast(bf16x8, w3);
}
__device__ __forceinline__ void bcast_rows(LAS float* wsf, float v, int r32, int hi, float (&f)[16]) {
    if (hi == 0) wsf[r32] = v;
    asm volatile("s_waitcnt lgkmcnt(0)" ::: "memory");
#pragma unroll
    for (int r = 0; r < 16; ++r) f[r] = wsf[crow(r, hi)];
    asm volatile("s_waitcnt lgkmcnt(0)" ::: "memory");
}

template <int MODE, class PreF, class MaskF>
__device__ __forceinline__ void flash_pass(LAS unsigned char* lds, LAS float* wsf, LAS float* imp, const unsigned char* img, int t_lo, int t_hi,
                                           const bf16x8 (&qr)[4], PreF pref, MaskF maskf, float& m, float& l, f32x16 (&o)[2], int r32, int hi) {
    if (t_lo > t_hi) return;
    const int tid = tidx(), wid = __builtin_amdgcn_readfirstlane(tid >> 6), lane = tid & 63;
    const int ngroups = (t_hi - t_lo + GROUP) / GROUP;
    for (int tt = 0; tt < GROUP; ++tt) if (t_lo + tt <= t_hi) tile_dma(img + (size_t)(t_lo + tt) * SLOT, lds + tt * SLOT, wid, lane);
    asm volatile("s_waitcnt vmcnt(0)" ::: "memory");
    __syncthreads();
    const int vbl = (int)(unsigned)(uintptr_t)(lds + 8192) + ((tid >> 4) & 1) * 32 + (tid & 3) * 8 + (4 * hi + ((tid & 15) >> 2)) * 64;
    float carry_prev = 0.f; bool fresh = (MODE != 1);
    for (int gi = 0; gi < ngroups; ++gi) {
        const int half = (gi & 1) * GROUP;
        if (gi + 1 < ngroups) {
            for (int tt = 0; tt < GROUP; ++tt) { const int t = t_lo + (gi + 1) * GROUP + tt; if (t <= t_hi) tile_dma(img + (size_t)t * SLOT, lds + ((GROUP - half) + tt) * SLOT, wid, lane); }
        }
#pragma unroll 1
        for (int tt = 0; tt < GROUP; ++tt) {
            const int t = t_lo + gi * GROUP + tt;
            if (t > t_hi) break;
            bool sel = true;
            const bool act = pref(t, sel);
            if (!act) { if (MODE == 1) carry_prev = 0.f; continue; }
            LAS unsigned char* buf = lds + (half + tt) * SLOT;
            f32x16 p0, p1;
            qkt(p0, p1, buf, qr, sel ? -m : -__builtin_inff(), r32, hi);
            VFrag vf;
            if (MODE != 0) pv_read(vf, vbl + (half + tt) * SLOT);
            maskf(t, p0, p1);
            if (MODE == 0 || MODE == 2) {
                const float rm = max32(p0, p1);
                const float dl = ((fresh || rm > THR) && rm > -3.0e38f) ? rm : 0.f;
                if (__any(dl != 0.f)) {
#pragma unroll
                    for (int r = 0; r < 16; ++r) { p0[r] -= dl; p1[r] -= dl; }
                    m += dl; const float alpha = ex2(-dl); l *= alpha;
                    if (MODE == 2 && !fresh) {
                        float f[16]; bcast_rows(wsf, alpha, r32, hi, f);
#pragma unroll
                        for (int r = 0; r < 16; ++r) { o[0][r] *= f[r]; o[1][r] *= f[r]; }
                    }
                }
                fresh = false;
                float sum = 0.f;
#pragma unroll
                for (int r = 0; r < 16; ++r) { p0[r] = ex2(p0[r]); p1[r] = ex2(p1[r]); sum += p0[r] + p1[r]; }
                l += sum;
            } else {
#pragma unroll
                for (int r = 0; r < 16; ++r) { p0[r] = ex2(p0[r]) * l; p1[r] = ex2(p1[r]) * l; }
                float a[8], cy[8];
#pragma unroll
                for (int k = 0; k < 4; ++k) {
                    a[k] = (p0[4 * k] + p0[4 * k + 1]) + (p0[4 * k + 2] + 0.5f * p0[4 * k + 3]); cy[k] = 0.5f * p0[4 * k + 3];
                    a[4 + k] = (p1[4 * k] + p1[4 * k + 1]) + (p1[4 * k + 2] + 0.5f * p1[4 * k + 3]); cy[4 + k] = 0.5f * p1[4 * k + 3];
                }
                float cx[8];
#pragma unroll
                for (int q8 = 0; q8 < 8; ++q8) cx[q8] = __shfl_xor(cy[q8], 32);
#pragma unroll
                for (int q8 = 0; q8 < 8; ++q8) {
                    float v = a[q8] + (hi ? cx[q8] : (q8 > 0 ? cx[q8 - 1] : carry_prev));
                    v += __shfl_xor(v, 1); v += __shfl_xor(v, 2);
                    if ((r32 & 3) == 0) imp[(r32 >> 2) * IMP_STRIDE + 16 * t + 2 * q8 + hi] = v;
                }
                carry_prev = cx[7];
            }
            if (MODE != 0) {
                bf16x8 a0, a1, a2, a3; pack_p(p0, p1, a0, a1, a2, a3);
                pv_mma(o, vf, a0, a1, a2, a3);
            }
        }
        asm volatile("s_waitcnt vmcnt(0)" ::: "memory");
        __syncthreads();
    }
}

__device__ __forceinline__ void nsa_unit(const Params& P, int b, int g, int t0, LAS unsigned char* lds) {
    unsigned char* ws = P.ws;
    const bf16_t* proj = (const bf16_t*)(ws + WS_PROJ);
    const int tid = tidx(), wid = tid >> 6, lane = tid & 63, r32 = lane & 31, hi = lane >> 5;
    LAS unsigned char* wl = lds + WAVE_OFF + wid * WAVE_LDS;
    LAS float* wsf = (LAS float*)wl; LAS float* imp = (LAS float*)(wl + 256); LAS unsigned* selm = (LAS unsigned*)(wl + 256 + 8 * IMP_STRIDE * 4);
    const int tq = t0 + 8 * wid + (r32 >> 2), head = g * 4 + (r32 & 3);
    const int tq_lo = __builtin_amdgcn_readfirstlane(t0 + 8 * wid);
    const size_t row = (size_t)b * S + tq;
    bf16x8 qr[4];
#pragma unroll
    for (int d0 = 0; d0 < 4; ++d0) {
        const u32x4 raw = *(const u32x4*)(proj + row * NP + Q0 + head * 64 + d0 * 16 + hi * 8);
        u32x4 sc;
        sc.x = cvtpk(__builtin_bit_cast(float, raw.x << 16) * C2, __builtin_bit_cast(float, raw.x & 0xffff0000u) * C2); sc.y = cvtpk(__builtin_bit_cast(float, raw.y << 16) * C2, __builtin_bit_cast(float, raw.y & 0xffff0000u) * C2);
        sc.z = cvtpk(__builtin_bit_cast(float, raw.z << 16) * C2, __builtin_bit_cast(float, raw.z & 0xffff0000u) * C2); sc.w = cvtpk(__builtin_bit_cast(float, raw.w << 16) * C2, __builtin_bit_cast(float, raw.w & 0xffff0000u) * C2);
        qr[d0] = __builtin_bit_cast(bf16x8, sc);
    }
    const bf16_t* gl = proj + row * NP + GL0 + head * 3;
    const float g0 = sigmoidf_(bf2f(gl[0])), g1 = sigmoidf_(bf2f(gl[1])), g2 = sigmoidf_(bf2f(gl[2]));
    f32x16 o[2], out[2];
    auto emit = [&](float fac, bool first) {
        if (hi == 0) wsf[r32] = fac;
        asm volatile("s_waitcnt lgkmcnt(0)" ::: "memory");
#pragma unroll
        for (int r = 0; r < 16; ++r) {
            const float f = wsf[crow(r, hi)];
            if (first) { out[0][r] = o[0][r] * f; out[1][r] = o[1][r] * f; } else { out[0][r] += o[0][r] * f; out[1][r] += o[1][r] * f; }
        }
        asm volatile("s_waitcnt lgkmcnt(0)" ::: "memory");
    };
    const float NINF = -__builtin_inff();
    auto pre_all = [&](int, bool&) -> bool { return true; };
    for (int i = lane; i < 8 * IMP_STRIDE; i += 64) imp[i] = 0.f;
    {
        const unsigned char* img = ws + WS_CMPI + (size_t)(b * 2 + g) * 8 * SLOT;
        const int c_hi = (t0 + QT - 32) >> 10;
        const int ivis = tq >= 31 ? ((tq - 31) >> 4) : -1;
        const int ivis_lo = tq_lo >= 31 ? ((tq_lo - 31) >> 4) : -1;
        auto maskc = [&](int t, f32x16& p0, f32x16& p1) {
            if (64 * t + 63 > ivis_lo) {
                const int kb = 64 * t + 4 * hi;
#pragma unroll
                for (int r = 0; r < 16; ++r) { const int i = kb + (r & 3) + 8 * (r >> 2); if (i > ivis) p0[r] = NINF; if (i + 32 > ivis) p1[r] = NINF; }
            }
        };
        float m = 0.f, l = 0.f;
        flash_pass<0>(lds, wsf, imp, img, 0, c_hi, qr, pre_all, maskc, m, l, o, r32, hi);
        l += __shfl_xor(l, 32);
        float linv = l > 0.f ? 1.f / l : 0.f;
        o[0] = (f32x16){0.f}; o[1] = (f32x16){0.f};
        flash_pass<1>(lds, wsf, imp, img, 0, c_hi, qr, pre_all, maskc, m, linv, o, r32, hi);
        emit(g0, true);
    }
    unsigned sw0, sw1, sw2, sw3;
    {
        const int tok = lane >> 3, sub = lane & 7, tqs = t0 + 8 * wid + tok, cur = tqs >> 6;
        float val[16];
#pragma unroll
        for (int e = 0; e < 16; ++e) {
            const int j = 8 * e + sub; float x = imp[tok * IMP_STRIDE + j];
            if (j * 64 > tqs) x = -1.0e30f; else if (j == 0 || j == cur || j == cur - 1) x = 1.0e9f;
            val[e] = x;
        }
        unsigned m0 = 0u, m1 = 0u, m2 = 0u, m3 = 0u;
#pragma unroll 1
        for (int r = 0; r < 16; ++r) {
            float bv = val[0]; int bj = sub;
#pragma unroll
            for (int e = 1; e < 16; ++e) if (val[e] > bv) { bv = val[e]; bj = 8 * e + sub; }
#pragma unroll
            for (int o2 = 1; o2 < 8; o2 <<= 1) { const float ov = __shfl_xor(bv, o2); const int oj = __shfl_xor(bj, o2); if (ov > bv || (ov == bv && oj < bj)) { bv = ov; bj = oj; } }
            if (bv > -1.0e29f) {
                const unsigned bit = 1u << (bj & 31); const int wq = bj >> 5;
                m0 |= wq == 0 ? bit : 0u; m1 |= wq == 1 ? bit : 0u; m2 |= wq == 2 ? bit : 0u; m3 |= wq == 3 ? bit : 0u;
#pragma unroll
                for (int e = 0; e < 16; ++e) if (bj == 8 * e + sub) val[e] = -3.0e38f;
            }
        }
        if (sub == 0) { selm[tok * 4 + 0] = m0; selm[tok * 4 + 1] = m1; selm[tok * 4 + 2] = m2; selm[tok * 4 + 3] = m3; }
        asm volatile("s_waitcnt lgkmcnt(0)" ::: "memory");
        sw0 = selm[(r32 >> 2) * 4 + 0]; sw1 = selm[(r32 >> 2) * 4 + 1]; sw2 = selm[(r32 >> 2) * 4 + 2]; sw3 = selm[(r32 >> 2) * 4 + 3];
        asm volatile("s_waitcnt lgkmcnt(0)" ::: "memory");
    }
    {
        const unsigned char* img = ws + WS_KVI + (size_t)((0 * NB + b) * 2 + g) * (S / 64) * SLOT;
        auto pres = [&](int t, bool& sel) -> bool {
            const unsigned w = t < 32 ? sw0 : (t < 64 ? sw1 : (t < 96 ? sw2 : sw3));
            sel = (w >> (t & 31)) & 1u;
            return __any(sel);
        };
        auto masks = [&](int t, f32x16& p0, f32x16& p1) {
            if (64 * t + 63 > tq_lo) {
                const int kb0 = 64 * t + 4 * hi;
#pragma unroll
                for (int r = 0; r < 16; ++r) { const int pos = kb0 + (r & 3) + 8 * (r >> 2); if (pos > tq) p0[r] = NINF; if (pos + 32 > tq) p1[r] = NINF; }
            }
        };
        float m = 0.f, l = 0.f; o[0] = (f32x16){0.f}; o[1] = (f32x16){0.f};
        flash_pass<2>(lds, wsf, imp, img, 0, (t0 + QT - 1) >> 6, qr, pres, masks, m, l, o, r32, hi);
        l += __shfl_xor(l, 32);
        emit(l > 0.f ? g1 / l : 0.f, false);
    }
    {
        const unsigned char* img = ws + WS_KVI + (size_t)((1 * NB + b) * 2 + g) * (S / 64) * SLOT;
        auto maskw = [&](int t, f32x16& p0, f32x16& p1) {
            if (64 * t + 63 > tq_lo || 64 * t < tq_lo + 7 - 511) {
                const int kb0 = 64 * t + 4 * hi;
#pragma unroll
                for (int r = 0; r < 16; ++r) { const int pos = kb0 + (r & 3) + 8 * (r >> 2); if (pos > tq || pos < tq - 511) p0[r] = NINF; if (pos + 32 > tq || pos + 32 < tq - 511) p1[r] = NINF; }
            }
        };
        float m = 0.f, l = 0.f; o[0] = (f32x16){0.f}; o[1] = (f32x16){0.f};
        const int lo = t0 - 511 > 0 ? (t0 - 511) >> 6 : 0;
        flash_pass<2>(lds, wsf, imp, img, lo, (t0 + QT - 1) >> 6, qr, pre_all, maskw, m, l, o, r32, hi);
        l += __shfl_xor(l, 32);
        emit(l > 0.f ? g2 / l : 0.f, false);
    }
    bf16_t* on = (bf16_t*)(ws + WS_ONSA) + ((size_t)b * S + t0 + 8 * wid) * 512 + g * 256 + r32;
#pragma unroll
    for (int r = 0; r < 16; ++r) {
        const int q = crow(r, hi); bf16_t* op = on + (size_t)(q >> 2) * 512 + (q & 3) * 64;
        op[0] = (bf16_t)f2bf(out[0][r]); op[32] = (bf16_t)f2bf(out[1][r]);
    }
}
}

template <int CTRL> __device__ __forceinline__ float dppf(float v) { return __builtin_bit_cast(float, __builtin_amdgcn_update_dpp(0, __builtin_bit_cast(int, v), CTRL, 0xf, 0xf, true)); }
__device__ __forceinline__ float sum16(float v) { v += dppf<0x128>(v); v += dppf<0x124>(v); v += dppf<0x122>(v); v += dppf<0x121>(v); return v; }
struct ScanRegs { f32x4 w0, w1; u32x4 kk, ka, k, r; unsigned v; };
__device__ __forceinline__ f32x4 bflo(u32x4 u) { return (f32x4){__builtin_bit_cast(float, u.x << 16), __builtin_bit_cast(float, u.x & 0xffff0000u), __builtin_bit_cast(float, u.y << 16), __builtin_bit_cast(float, u.y & 0xffff0000u)}; }
__device__ __forceinline__ f32x4 bfhi(u32x4 u) { return (f32x4){__builtin_bit_cast(float, u.z << 16), __builtin_bit_cast(float, u.z & 0xffff0000u), __builtin_bit_cast(float, u.w << 16), __builtin_bit_cast(float, u.w & 0xffff0000u)}; }
__device__ __forceinline__ void rwkv_scan_unit(const Params& P, int b, int h, int qr, int unit, float* sm  ) {
    unsigned char* ws = P.ws;
    const int tid = tidx(); const bool comp = tid < 256;
    const int rowl = (tid & 255) >> 4, l16 = tid & 15;
    const int lst = (tid & 255) >> 3, j8 = tid & 7;
    float s0 = 0.f, s1 = 0.f, s2 = 0.f, s3 = 0.f;
    const float* Ww = (const float*)(ws + WS_RW_W);
    const bf16_t* Rr = (const bf16_t*)(ws + WS_RW_R); const bf16_t* Kk = (const bf16_t*)(ws + WS_RW_K); const bf16_t* Vv = (const bf16_t*)(ws + WS_RW_V);
    const bf16_t* KK = (const bf16_t*)(ws + WS_RW_KK); const bf16_t* KA = (const bf16_t*)(ws + WS_RW_KKA);
    float* Y = (float*)(ws + WS_Y);
    constexpr int SR = 336, CH = 32 * SR;
    auto gload = [&](ScanRegs& R, int t0) {
        const size_t base = ((size_t)b * S + t0 + lst) * 512 + h * 64 + 8 * j8;
        R.w0 = *(const f32x4*)(Ww + base); R.w1 = *(const f32x4*)(Ww + base + 4); R.kk = *(const u32x4*)(KK + base); R.ka = *(const u32x4*)(KA + base);
        R.k = *(const u32x4*)(Kk + base); R.r = *(const u32x4*)(Rr + base); R.v = *(const unsigned*)(Vv + base - 8 * j8 + qr * 16 + 2 * j8);
    };
    auto lstore = [&](const ScanRegs& R, float* buf) {
        float* q = buf + lst * SR + 8 * j8;
        *(f32x4*)q = R.w0; *(f32x4*)(q + 4) = R.w1; *(f32x4*)(q + 64) = bflo(R.kk); *(f32x4*)(q + 68) = bfhi(R.kk); *(f32x4*)(q + 128) = bflo(R.ka); *(f32x4*)(q + 132) = bfhi(R.ka);
        *(f32x4*)(q + 192) = bflo(R.k); *(f32x4*)(q + 196) = bfhi(R.k); *(f32x4*)(q + 256) = bflo(R.r); *(f32x4*)(q + 260) = bfhi(R.r);
        buf[lst * SR + 320 + 2 * j8] = __builtin_bit_cast(float, R.v << 16); buf[lst * SR + 321 + 2 * j8] = __builtin_bit_cast(float, R.v & 0xffff0000u);
    };
    typedef float f2 __attribute__((ext_vector_type(2)));
    auto compute16 = [&](const float* buf) -> float {
        const float* q0 = buf + l16 * 4; const float* qv = buf + 320 + rowl;
        f2 sa_ = {s0, s1}, sb_ = {s2, s3};
        f32x4 w = *(const f32x4*)(q0), kk = *(const f32x4*)(q0 + 64), ka = *(const f32x4*)(q0 + 128), k = *(const f32x4*)(q0 + 192), r = *(const f32x4*)(q0 + 256);
        float v = qv[0];
        float ep[16];
#pragma unroll
        for (int st = 0; st < 16; ++st) {
            f32x4 wn, kkn, kan, kn, rn; float vn;
            if (st < 15) { const float* q = q0 + (st + 1) * SR; wn = *(const f32x4*)(q); kkn = *(const f32x4*)(q + 64); kan = *(const f32x4*)(q + 128); kn = *(const f32x4*)(q + 192); rn = *(const f32x4*)(q + 256); vn = qv[(st + 1) * SR]; }
            const f2 d = sa_ * (f2){kk.x, kk.y} + sb_ * (f2){kk.z, kk.w};
            const float sa = -sum16(d.x + d.y);
            const f2 vv = {v, v}, ss = {sa, sa};
            const f2 ta = sa_ * (f2){w.x, w.y} + vv * (f2){k.x, k.y}, tb = sb_ * (f2){w.z, w.w} + vv * (f2){k.z, k.w};
            sa_ = ta + ss * (f2){ka.x, ka.y}; sb_ = tb + ss * (f2){ka.z, ka.w};
            const f2 e = sa_ * (f2){r.x, r.y} + sb_ * (f2){r.z, r.w};
            ep[st] = e.x + e.y;
            asm volatile("" : "+v"(ep[st]));
            if (st < 15) { w = wn; kk = kkn; ka = kan; k = kn; r = rn; v = vn; }
        }
        s0 = sa_.x; s1 = sa_.y; s2 = sb_.x; s3 = sb_.y;
        const bool b3 = (l16 & 8) != 0, b2 = (l16 & 4) != 0, b1 = (l16 & 2) != 0, b0 = (l16 & 1) != 0;
        float e8[8], e4[4], e2[2];
#pragma unroll
        for (int i = 0; i < 8; ++i) { const float keep = b3 ? ep[i + 8] : ep[i], send = b3 ? ep[i] : ep[i + 8]; e8[i] = keep + dppf<0x128>(send); }
#pragma unroll
        for (int i = 0; i < 4; ++i) { const float keep = b2 ? e8[i + 4] : e8[i], send = b2 ? e8[i] : e8[i + 4]; e4[i] = keep + dppf<0x141>(send); }
#pragma unroll
        for (int i = 0; i < 2; ++i) { const float keep = b1 ? e4[i + 2] : e4[i], send = b1 ? e4[i] : e4[i + 2]; e2[i] = keep + dppf<0x4E>(send); }
        { const float keep = b0 ? e2[1] : e2[0], send = b0 ? e2[0] : e2[1]; return keep + dppf<0xB1>(send); }
    };
    auto ystore = [&](float yk, int t0) { Y[((size_t)b * S + t0 + l16) * 512 + h * 64 + qr * 16 + rowl] = yk; };
    float* ct = sm + 2 * CH;
    constexpr int CT = 64 * 65;
    const int lt = tid & 255, ctx = lt & 63, cty = lt >> 6, cpp = lt >> 2, ckq = lt & 3;
    float cva[16], cvb[16];
    auto conv_src = [&](int tile, const float*& src, int& nsrc, unsigned char*& dst, int& p0, int& k0, int& col) {
        if (tile < 16384) { const int e = tile >> 9, q = tile & 511; src = P.in[I_EGU] + (size_t)e * 1024 * 2048; nsrc = 2048; dst = ws + WS_GU + (size_t)e * 2048 * 1024; p0 = (q >> 4) * 64; k0 = (q & 15) * 64; col = MapGU()(p0 + ctx); }
        else { const int t2 = tile - 16384, e = t2 >> 8, q = t2 & 255; src = P.in[I_EDN] + (size_t)e * 1024 * 1024; nsrc = 1024; dst = ws + WS_DN + (size_t)e * 1024 * 1024; p0 = (q >> 4) * 64; k0 = (q & 15) * 64; col = p0 + ctx; }
    };
    auto conv_load = [&](float (&cv)[16], int iv) {
        const int tile = unit * 192 + iv; if (iv >= 192 || !EXPERT_CONV_IN_SCAN) return;
        const float* src; int nsrc, p0, k0, col; unsigned char* dst; conv_src(tile, src, nsrc, dst, p0, k0, col);
#pragma unroll
        for (int i = 0; i < 16; ++i) cv[i] = src[(size_t)(k0 + cty + 4 * i) * nsrc + col];
    };
    auto conv_lds = [&](const float (&cv)[16], float* buf, int iv) {
        if (iv >= 192 || !EXPERT_CONV_IN_SCAN) return;
#pragma unroll
        for (int i = 0; i < 16; ++i) buf[(cty + 4 * i) * 65 + ctx] = cv[i];
    };
    auto conv_out = [&](const float* buf, int iv) {
        const int tile = unit * 192 + iv; if (iv >= 192 || !EXPERT_CONV_IN_SCAN) return;
        const float* src; int nsrc, p0, k0, col; unsigned char* dst; conv_src(tile, src, nsrc, dst, p0, k0, col);
        const float* tp = buf + (16 * ckq) * 65 + cpp;
        u32x4 o0;
        o0.x = pk4f8(32.f * tp[0], 32.f * tp[65], 32.f * tp[2 * 65], 32.f * tp[3 * 65]); o0.y = pk4f8(32.f * tp[4 * 65], 32.f * tp[5 * 65], 32.f * tp[6 * 65], 32.f * tp[7 * 65]);
        o0.z = pk4f8(32.f * tp[8 * 65], 32.f * tp[9 * 65], 32.f * tp[10 * 65], 32.f * tp[11 * 65]); o0.w = pk4f8(32.f * tp[12 * 65], 32.f * tp[13 * 65], 32.f * tp[14 * 65], 32.f * tp[15 * 65]);
        *(u32x4*)(dst + (size_t)(p0 + cpp) * 1024 + k0 + 16 * ckq) = o0;
    };
    ScanRegs RA, RB;
    __syncthreads();
    if (!comp) { gload(RA, 0); lstore(RA, sm); gload(RA, 32); gload(RB, 64); conv_load(cva, 0); conv_load(cvb, 1); }
    __syncthreads();
    if (comp) __builtin_amdgcn_s_setprio(3);
    for (int c = 0; c < S / 32; c += 2) {
        if (comp) { const float y0 = compute16(sm), y1 = compute16(sm + 16 * SR); ystore(y0, 32 * c); ystore(y1, 32 * c + 16); }
        else { lstore(RA, sm + CH); if (32 * (c + 3) < S) gload(RA, 32 * (c + 3)); conv_lds(cva, ct, c); }
        __syncthreads();
        if (comp) { const float y2 = compute16(sm + CH), y3 = compute16(sm + CH + 16 * SR); ystore(y2, 32 * (c + 1)); ystore(y3, 32 * (c + 1) + 16); }
        else { if (32 * (c + 2) < S) lstore(RB, sm); if (32 * (c + 4) < S) gload(RB, 32 * (c + 4)); conv_out(ct, c); conv_load(cva, c + 2); conv_lds(cvb, ct + CT, c + 1); }
        __syncthreads();
        if (!comp) { conv_out(ct + CT, c + 1); conv_load(cvb, c + 3); }
    }
    __builtin_amdgcn_s_setprio(0);
    __syncthreads();
}

__device__ __forceinline__ void phase5(const Params& P, LAS unsigned char* lds, float* ldsf) {
    constexpr int U_SCAN = NB * 8 * 4, U_ATT = NB * 2 * (S / att::QT);
    for (int u = blockIdx.x; u < U_SCAN; u += gridDim.x) rwkv_scan_unit(P, u >> 5, (u >> 2) & 7, u & 3, u, ldsf);
    unsigned* qhead = (unsigned*)(P.ws + WS_CTL) + 64;
    LAS int* slot = (LAS int*)(lds + LDS_RING + 64);
    for (;;) {
        __syncthreads();
        if (tidx() == 0) *slot = (int)atomicAdd(qhead, 1u);
        __syncthreads();
        const int a = *slot;
        if (a >= U_ATT) break;
        const int qt = (S / att::QT - 1) - (a >> 3), b = (a >> 1) & 3, g = a & 1;
        att::nsa_unit(P, b, g, qt * att::QT, lds);
    }
}


__device__ __forceinline__ void phase6(const Params& P) {
    unsigned char* ws = P.ws;
    const int lane = tidx() & 63, gw = blockIdx.x * NWAVES + (tidx() >> 6), ngw = gridDim.x * NWAVES, c0 = 8 * lane;
    bf16_t* amix = (bf16_t*)(ws + WS_RA);
    float gn[8], lw[8], lb[8], rk[8];
#pragma unroll
    for (int i = 0; i < 8; ++i) { gn[i] = P.in[I_NSANORM][c0 + i]; lw[i] = P.in[I_LNW][c0 + i]; lb[i] = P.in[I_LNB][c0 + i]; rk[i] = P.in[I_RK][c0 + i]; }
    for (int row = gw; row < T; row += ngw) {
        const size_t o = (size_t)row * 512 + c0;
        const u32x4 n8 = *(const u32x4*)((const bf16_t*)(ws + WS_ONSA) + o);
        const f32x4 y0 = *(const f32x4*)((const float*)(ws + WS_Y) + o), y1 = *(const f32x4*)((const float*)(ws + WS_Y) + o + 4);
        const u32x4 r8 = *(const u32x4*)((const bf16_t*)(ws + WS_RW_R) + o), k8 = *(const u32x4*)((const bf16_t*)(ws + WS_RW_K) + o), v8 = *(const u32x4*)((const bf16_t*)(ws + WS_RW_V) + o), g8 = *(const u32x4*)((const bf16_t*)(ws + WS_RW_G) + o);
        float nv[8]; unpack8(n8, nv); const float yv[8] = {y0.x, y0.y, y0.z, y0.w, y1.x, y1.y, y1.z, y1.w};
        float s = 0.f;
#pragma unroll
        for (int i = 0; i < 8; ++i) s += nv[i] * nv[i];
        const float rstd = rsqrtf(wave_sum(s) * (1.f / 512.f) + 1e-6f);
        float on[8];
#pragma unroll
        for (int i = 0; i < 8; ++i) on[i] = nv[i] * rstd * gn[i];
        *(u32x4*)(amix + (size_t)row * D + c0) = pack8(on);
        float rr[8], kk[8], vv[8], gg[8]; unpack8(r8, rr); unpack8(k8, kk); unpack8(v8, vv); unpack8(g8, gg);
        float sm = 0.f, bs = 0.f;
#pragma unroll
        for (int i = 0; i < 8; ++i) { sm += yv[i]; bs += rr[i] * kk[i] * rk[i]; }
        sm += __shfl_xor(sm, 1); sm += __shfl_xor(sm, 2); sm += __shfl_xor(sm, 4);
        bs += __shfl_xor(bs, 1); bs += __shfl_xor(bs, 2); bs += __shfl_xor(bs, 4);
        const float mean = sm * (1.f / 64.f); float vs = 0.f;
#pragma unroll
        for (int i = 0; i < 8; ++i) { const float d = yv[i] - mean; vs += d * d; }
        vs += __shfl_xor(vs, 1); vs += __shfl_xor(vs, 2); vs += __shfl_xor(vs, 4);
        const float rs = rsqrtf(vs * (1.f / 64.f) + 64e-5f);
        float oo[8];
#pragma unroll
        for (int i = 0; i < 8; ++i) oo[i] = ((yv[i] - mean) * rs * lw[i] + lb[i] + bs * vv[i]) * gg[i];
        *(u32x4*)(amix + (size_t)row * D + 512 + c0) = pack8(oo);
    }
}

struct EpiF32 {
    float* C; int ldc;
    __device__ __forceinline__ void operator()(const f32x4 (&acc)[2][2][4][2], const g8::Unit& u, int wr, int wc, int fr, int fq) const {
        const int row0 = u.x0 * 256 + wr * 64 + fr, col0 = u.x1 * 256 + wc * 32 + 4 * fq;
#pragma unroll
        for (int ai = 0; ai < 2; ++ai)
#pragma unroll
            for (int m = 0; m < 4; ++m) { float* rowp = C + (size_t)(row0 + ai * 128 + m * 16) * ldc + col0;
#pragma unroll
                for (int bj = 0; bj < 2; ++bj)
#pragma unroll
                    for (int n = 0; n < 2; ++n) *(f32x4*)(rowp + bj * 128 + n * 16) = acc[ai][bj][m][n]; }
    }
};
__device__ __forceinline__ void phase7(const Params& P, LAS unsigned char* lds) {
    unsigned char* ws = P.ws;
    SchedDense Sd{(const bf16_t*)(ws + WS_RA), (const bf16_t*)(ws + WS_WOUT), D, D, T / 256, D / 256};
    EpiBf16 E{(bf16_t*)(ws + WS_MIXED), D};
    g8::gemm_phase<true>(lds, D, D, Sd, E);
}

__device__ __forceinline__ void phase8(const Params& P) {
    unsigned char* ws = P.ws;
    const int wid = tidx() >> 6, lane = tidx() & 63, gw = blockIdx.x * NWAVES + wid, ngw = gridDim.x * NWAVES;
    const float* ada = (const float*)(ws + WS_ADA);
    for (int row = gw; row < T; row += ngw) {
        const int b = row / S;
        const u32x2* mr = (const u32x2*)((const bf16_t*)(ws + WS_MIXED) + (size_t)row * D) + lane;
        const f32x4* xr = (const f32x4*)(P.in[I_X] + (size_t)row * D) + lane;
        f32x4 m[4]; float s = 0.f;
#pragma unroll
        for (int j = 0; j < 4; ++j) { const u32x2 w = mr[64 * j]; m[j] = (f32x4){__builtin_bit_cast(float, w.x << 16), __builtin_bit_cast(float, w.x & 0xffff0000u), __builtin_bit_cast(float, w.y << 16), __builtin_bit_cast(float, w.y & 0xffff0000u)};
            s += m[j].x * m[j].x + m[j].y * m[j].y + m[j].z * m[j].z + m[j].w * m[j].w; }
        const float rstd = rsqrtf(wave_sum(s) * (1.f / D) + 1e-6f);
        f32x4 x1[4]; float s2 = 0.f;
#pragma unroll
        for (int j = 0; j < 4; ++j) {
            const int c = 4 * (lane + 64 * j);
            const f32x4 g = *(const f32x4*)(P.in[I_MIXPOST] + c), gm = *(const f32x4*)(ada + b * 6144 + 2048 + c);
            x1[j] = xr[64 * j] + gm * (m[j] * rstd * g);
            s2 += x1[j].x * x1[j].x + x1[j].y * x1[j].y + x1[j].z * x1[j].z + x1[j].w * x1[j].w;
            ((f32x4*)((float*)(ws + WS_X1) + (size_t)row * D))[lane + 64 * j] = x1[j];
        }
        const float rstd2 = rsqrtf(wave_sum(s2) * (1.f / D) + 1e-6f);
        u32x2* ho = (u32x2*)((bf16_t*)(ws + WS_H2X) + (size_t)row * 2048) + lane;
#pragma unroll
        for (int j = 0; j < 4; ++j) {
            const int c = 4 * (lane + 64 * j);
            const f32x4 g = *(const f32x4*)(P.in[I_FFNPRE] + c), sh = *(const f32x4*)(ada + b * 6144 + 3072 + c), sc = *(const f32x4*)(ada + b * 6144 + 4096 + c);
            const f32x4 h = x1[j] * rstd2 * g * (sc + 1.f) + sh;
            const unsigned h0 = f2bf(h.x), h1 = f2bf(h.y), h2 = f2bf(h.z), h3 = f2bf(h.w);
            u32x2 w; w.x = h0 | (h1 << 16); w.y = h2 | (h3 << 16); ho[64 * j] = w;
            u32x2 l; l.x = pk2(h.x - __builtin_bit_cast(float, h0 << 16), h.y - __builtin_bit_cast(float, h1 << 16)); l.y = pk2(h.z - __builtin_bit_cast(float, h2 << 16), h.w - __builtin_bit_cast(float, h3 << 16));
            ho[256 + 64 * j] = l;
            ((unsigned*)(ws + WS_H8 + (size_t)row * 1024))[lane + 64 * j] = pk4f8(__builtin_amdgcn_fmed3f(h.x, -448.f, 448.f), __builtin_amdgcn_fmed3f(h.y, -448.f, 448.f), __builtin_amdgcn_fmed3f(h.z, -448.f, 448.f), __builtin_amdgcn_fmed3f(h.w, -448.f, 448.f));
        }
    }
}

struct SchedRouter {
    const bf16_t* H2X; const bf16_t* WRT;
    __device__ __forceinline__ bool next(int i, g8::Unit& u, int R0, int C0, int R1, int C1) const {
        const int id = (int)blockIdx.x + i * (int)gridDim.x; if (id >= 2 * (T / 256)) return false;
        const int which = id & 1, pm = id >> 1;
        g8::dense_unit(u, H2X + which * 1024, 2048, WRT + (size_t)which * 256 * 1024, 1024, pm, 0, R0, C0, R1, C1); u.x2 = g8::ui(which); return true;
    }
};
struct EpiLogits {
    float* LOGP;
    __device__ __forceinline__ void operator()(const f32x4 (&acc)[2][2][4][2], const g8::Unit& u, int wr, int wc, int fr, int fq) const {
        if (wc < 2) {
            float* base = LOGP + (size_t)u.x2 * T * 64;
#pragma unroll
            for (int ai = 0; ai < 2; ++ai)
#pragma unroll
                for (int m = 0; m < 4; ++m) { float* rowp = base + (size_t)(u.x0 * 256 + ai * 128 + wr * 64 + m * 16 + fr) * 64 + wc * 32 + 4 * fq;
#pragma unroll
                    for (int n = 0; n < 2; ++n) *(f32x4*)(rowp + n * 16) = acc[ai][0][m][n]; }
        }
    }
};
__device__ __forceinline__ void phase8b(const Params& P, LAS unsigned char* lds) {
    unsigned char* ws = P.ws;
    SchedRouter Sr{(const bf16_t*)(ws + WS_H2X), (const bf16_t*)(ws + WS_WRT)};
    EpiLogits E{(float*)(ws + WS_LOGP)};
    g8::gemm_phase<false>(lds, D, D, Sr, E);
}

__device__ __forceinline__ void phase8c(const Params& P, LAS unsigned char* lds) {
    unsigned char* ws = P.ws;
    unsigned* cnt = (unsigned*)(ws + WS_CTL);
    const float* L0 = (const float*)(ws + WS_LOGP); const float* L1 = L0 + (size_t)T * 64;
    LAS unsigned* lcnt = (LAS unsigned*)lds;
    const int tid = tidx();
    for (int blk = blockIdx.x; blk < T / 128; blk += gridDim.x) {
        __syncthreads();
        if (tid < 64) lcnt[tid] = 0u;
        __syncthreads();
        int ti[4] = {0, 0, 0, 0}; float wv[4] = {0.f, 0.f, 0.f, 0.f}; unsigned rk[4] = {0u, 0u, 0u, 0u};
        const int row = blk * 128 + tid;
        if (tid < 128) {
            float lg[32];
#pragma unroll
            for (int q = 0; q < 8; ++q) {
                const f32x4 a = *(const f32x4*)(L0 + (size_t)row * 64 + 4 * q), b2 = *(const f32x4*)(L0 + (size_t)row * 64 + 32 + 4 * q), c = *(const f32x4*)(L1 + (size_t)row * 64 + 4 * q), rb = *(const f32x4*)(P.in[I_RB] + 4 * q);
                const f32x4 v = ((a + b2) + c) + rb;
                lg[4 * q] = v.x; lg[4 * q + 1] = v.y; lg[4 * q + 2] = v.z; lg[4 * q + 3] = v.w;
            }
            float tv[4];
#pragma unroll
            for (int r = 0; r < 4; ++r) {
                float bv = lg[0]; int bi = 0;
#pragma unroll
                for (int e = 1; e < 32; ++e) if (lg[e] > bv) { bv = lg[e]; bi = e; }
                tv[r] = bv; ti[r] = bi;
#pragma unroll
                for (int e = 0; e < 32; ++e) if (e == bi) lg[e] = -3.0e38f;
            }
            const float e1 = __expf(tv[1] - tv[0]), e2 = __expf(tv[2] - tv[0]), e3 = __expf(tv[3] - tv[0]);
            const float inv = 1.f / (1.f + e1 + e2 + e3);
            wv[0] = inv; wv[1] = e1 * inv; wv[2] = e2 * inv; wv[3] = e3 * inv;
#pragma unroll
            for (int r = 0; r < 4; ++r) rk[r] = atomicAdd((unsigned*)(lcnt + ti[r]), 1u);
        }
        __syncthreads();
        if (tid < 32) lcnt[32 + tid] = atomicAdd(cnt + tid, lcnt[tid]);
        __syncthreads();
        if (tid < 128) {
#pragma unroll
            for (int r = 0; r < 4; ++r) {
                const unsigned pos = lcnt[32 + ti[r]] + rk[r];
                ((u32x2*)(ws + WS_LIST))[(size_t)ti[r] * T + pos] = (u32x2){(unsigned)(row * 4 + r), 0u};
                ((unsigned*)(ws + WS_TOKW))[row * 4 + r] = ((unsigned)ti[r] << 20) | pos;
                ((float*)(ws + WS_TOKW + 524288))[row * 4 + r] = wv[r];
            }
        }
    }
}

constexpr int MOE_TAB_OFF = LDS_RING + 256;
__device__ __forceinline__ void moe_table(const unsigned* cnt, int ntn, LAS unsigned char* lds) {
    LAS int* tab = (LAS int*)(lds + MOE_TAB_OFF);
    __syncthreads();
    if (tidx() < 64) {
        const int lane = tidx(); const int c = lane < NE ? (int)cnt[lane] : 0, m = (c + 255) >> 8;
        int inc = m;
#pragma unroll
        for (int o = 1; o < 32; o <<= 1) { const int t = __shfl_up(inc, o); if (lane >= o) inc += t; }
        if (lane < NE) { tab[lane] = (inc - m) * ntn; tab[64 + lane] = (inc - m) * 256; tab[128 + lane] = c; }
        if (lane == NE - 1) tab[NE] = inc * ntn;
    }
    __syncthreads();
}
__device__ __forceinline__ bool moe_unit(LAS unsigned char* lds, int u, int ntn, int& e, int& mt, int& nt, int& base_rows, int& ce) {
    const LAS int* tab = (const LAS int*)(lds + MOE_TAB_OFF);
    const int lane = tidx() & 63;
    if (u >= tab[NE]) return false;
    const int st = lane < NE ? tab[lane] : 0x7fffffff;
    const unsigned long long bal = __ballot(u >= st);
    e = __builtin_popcountll(bal) - 1;
    const int r = u - tab[e]; mt = r / ntn; nt = r % ntn; base_rows = tab[64 + e]; ce = tab[128 + e];
    return true;
}
struct SchedGU {
    LAS unsigned char* lds; const u32x2* list; const unsigned char* H8; const unsigned char* W;
    __device__ __forceinline__ bool next(int i, g8::Unit& u, int R0, int C0, int R1, int C1) const {
        int e, mt, nt, base, ce; if (!moe_unit(lds, (int)((blockIdx.x & 7) * (gridDim.x >> 3) + (blockIdx.x >> 3)) + i * (int)gridDim.x, 8, e, mt, nt, base, ce)) return false;
        const u32x2* le = list + (size_t)e * T;
        const int i00 = mt * 256 + R0, i01 = mt * 256 + R1, i10 = i00 + 128, i11 = i01 + 128;
        const int t00 = (int)(i00 < ce ? le[i00].x : 0u) >> 2, t01 = (int)(i01 < ce ? le[i01].x : 0u) >> 2, t10 = (int)(i10 < ce ? le[i10].x : 0u) >> 2, t11 = (int)(i11 < ce ? le[i11].x : 0u) >> 2;
        u.A = g8::uptr(H8); u.B = g8::uptr(W + ((size_t)e * 2048 + nt * 256) * 1024);
        u.va[0][0] = (unsigned)(t00 * 512 + C0) * 2u; u.va[0][1] = (unsigned)(t01 * 512 + C1) * 2u; u.va[1][0] = (unsigned)(t10 * 512 + C0) * 2u; u.va[1][1] = (unsigned)(t11 * 512 + C1) * 2u;
        u.x0 = g8::ui(base + mt * 256); u.x1 = g8::ui(nt); u.x2 = g8::ui(e); u.x3 = g8::ui(ce - mt * 256); return true;
    }
};
struct EpiGU {
    unsigned char* act; const float* bgu;
    __device__ __forceinline__ void operator()(const f32x4 (&acc)[2][2][4][2], const g8::Unit& u, int wr, int wc, int fr, int fq) const {
        const int col = u.x1 * 128 + wc * 32 + 8 * fq; const float* bg = bgu + (size_t)u.x2 * 2048 + col;
        const f32x4 bg0 = *(const f32x4*)bg, bg1 = *(const f32x4*)(bg + 4), bu0 = *(const f32x4*)(bg + 1024), bu1 = *(const f32x4*)(bg + 1028);
#pragma unroll
        for (int ai = 0; ai < 2; ++ai)
#pragma unroll
            for (int m = 0; m < 4; ++m) {
                const int r = ai * 128 + wr * 64 + m * 16 + fr;
                f32x4 o[2];
#pragma unroll
                for (int n = 0; n < 2; ++n) {
                    const f32x4 gv = acc[ai][0][m][n] + (n ? bg1 : bg0), uv = acc[ai][1][m][n] + (n ? bu1 : bu0);
#pragma unroll
                    for (int i = 0; i < 4; ++i) { const float gate = fminf(gv[i], 7.f), up = fminf(fmaxf(uv[i], -7.f), 7.f); o[n][i] = (up + 1.f) * (gate * sigmoidf_(1.702f * gate)); }
                }
                u32x2 w; w.x = pk4f8(o[0][0], o[0][1], o[0][2], o[0][3]); w.y = pk4f8(o[1][0], o[1][1], o[1][2], o[1][3]);
                *(u32x2*)(act + (size_t)(u.x0 + r) * D + col) = w;
                asm volatile("" ::: "memory");
            }
    }
};
__device__ __forceinline__ void phase9(const Params& P, LAS unsigned char* lds) {
    unsigned char* ws = P.ws;
    moe_table((const unsigned*)(ws + WS_CTL), 8, lds);
    SchedGU Sg{lds, (const u32x2*)(ws + WS_LIST), ws + WS_H8, ws + WS_GU};
    EpiGU E{ws + WS_ACT, P.in[I_EBGU]};
    g8::gemm_phase<true, true>(lds, D / 2, D / 2, Sg, E);
}
struct SchedDN {
    LAS unsigned char* lds; const unsigned char* act; const unsigned char* W;
    __device__ __forceinline__ bool next(int i, g8::Unit& u, int R0, int C0, int R1, int C1) const {
        int e, mt, nt, base, ce; if (!moe_unit(lds, (int)((blockIdx.x & 7) * (gridDim.x >> 3) + (blockIdx.x >> 3)) + i * (int)gridDim.x, 4, e, mt, nt, base, ce)) return false;
        g8::dense_unit(u, (const bf16_t*)(act + (size_t)(base + mt * 256) * D), D / 2, (const bf16_t*)(W + ((size_t)e * 1024 + nt * 256) * 1024), D / 2, 0, 0, R0, C0, R1, C1);
        u.x0 = g8::ui(base + mt * 256); u.x1 = g8::ui(nt); u.x2 = g8::ui(e); u.x3 = 0; return true;
    }
};
struct EpiDN {
    bf16_t* yk; const float* bdn;
    __device__ __forceinline__ void operator()(const f32x4 (&acc)[2][2][4][2], const g8::Unit& u, int wr, int wc, int fr, int fq) const {
        f32x4 bd[2][2];
#pragma unroll
        for (int bj = 0; bj < 2; ++bj) { const float* bp = bdn + (size_t)u.x2 * 1024 + u.x1 * 256 + bj * 128 + wc * 32 + 8 * fq; bd[bj][0] = *(const f32x4*)bp; bd[bj][1] = *(const f32x4*)(bp + 4); }
#pragma unroll
        for (int ai = 0; ai < 2; ++ai)
#pragma unroll
            for (int m = 0; m < 4; ++m) {
                bf16_t* rowp = yk + (size_t)(u.x0 + ai * 128 + wr * 64 + m * 16 + fr) * D + u.x1 * 256 + wc * 32 + 8 * fq;
#pragma unroll
                for (int bj = 0; bj < 2; ++bj) {
                    const f32x4 v0 = acc[ai][bj][m][0] + bd[bj][0], v1 = acc[ai][bj][m][1] + bd[bj][1];
                    u32x4 o; o.x = g8::cvt_pk_bf16(v0[0], v0[1]); o.y = g8::cvt_pk_bf16(v0[2], v0[3]); o.z = g8::cvt_pk_bf16(v1[0], v1[1]); o.w = g8::cvt_pk_bf16(v1[2], v1[3]);
                    *(u32x4*)(rowp + bj * 128) = o;
                }
            }
    }
};
__device__ __forceinline__ void phase10(const Params& P, LAS unsigned char* lds) {
    unsigned char* ws = P.ws;
    moe_table((const unsigned*)(ws + WS_CTL), 4, lds);
    SchedDN Sn{lds, ws + WS_ACT, ws + WS_DN};
    EpiDN E{(bf16_t*)(ws + WS_YK), P.in[I_EBDN]};
    g8::gemm_phase<true, true>(lds, D / 2, D / 2, Sn, E);
}

__device__ __forceinline__ void phase11(const Params& P, LAS unsigned char* lds) {
    unsigned char* ws = P.ws;
    const int lane = tidx() & 63, gw = blockIdx.x * NWAVES + (tidx() >> 6), ngw = gridDim.x * NWAVES;
    const float* ada = (const float*)(ws + WS_ADA);
    LAS int* ebase = (LAS int*)lds;
    if (tidx() == 0) { const unsigned* cnt = (const unsigned*)(ws + WS_CTL); int rows = 0; for (int i = 0; i < NE; ++i) { ebase[i] = rows; rows += (((int)cnt[i] + 255) >> 8) * 256; } }
    __syncthreads();
    for (int row = gw; row < T; row += ngw) {
        const int b = row / S;
        const u32x4 tp0 = *(const u32x4*)((const unsigned*)(ws + WS_TOKW) + (size_t)row * 4); const f32x4 tw0 = *(const f32x4*)((const float*)(ws + WS_TOKW + 524288) + (size_t)row * 4);
        const unsigned ep[4] = {tp0.x, tp0.y, tp0.z, tp0.w}; const float wk[4] = {tw0.x, tw0.y, tw0.z, tw0.w};
        f32x4 y[4]; float s = 0.f;
#pragma unroll
        for (int j = 0; j < 4; ++j) y[j] = (f32x4){0.f, 0.f, 0.f, 0.f};
#pragma unroll
        for (int k = 0; k < 4; ++k) {
            const size_t prow = (size_t)(ebase[ep[k] >> 20] + (int)(ep[k] & 0xfffffu));
            const u32x2* yr = (const u32x2*)((const bf16_t*)(ws + WS_YK) + prow * D);
#pragma unroll
            for (int j = 0; j < 4; ++j) { const u32x2 w = yr[lane + 64 * j];
                y[j].x += wk[k] * __builtin_bit_cast(float, w.x << 16); y[j].y += wk[k] * __builtin_bit_cast(float, w.x & 0xffff0000u); y[j].z += wk[k] * __builtin_bit_cast(float, w.y << 16); y[j].w += wk[k] * __builtin_bit_cast(float, w.y & 0xffff0000u); }
        }
#pragma unroll
        for (int j = 0; j < 4; ++j) s += y[j].x * y[j].x + y[j].y * y[j].y + y[j].z * y[j].z + y[j].w * y[j].w;
        const float rstd = rsqrtf(wave_sum(s) * (1.f / D) + 1e-6f);
#pragma unroll
        for (int j = 0; j < 4; ++j) {
            const int c = 4 * (lane + 64 * j);
            const f32x4 g = *(const f32x4*)(P.in[I_FFNPOST] + c), gf = *(const f32x4*)(ada + b * 6144 + 5120 + c);
            const f32x4 x1 = ((const f32x4*)((const float*)(ws + WS_X1) + (size_t)row * D))[lane + 64 * j];
            ((f32x4*)(P.out + (size_t)row * D))[lane + 64 * j] = x1 + gf * (y[j] * rstd * g);
        }
    }
}

#define RLX_AGENT __ATOMIC_RELAXED, __HIP_MEMORY_SCOPE_AGENT
#define XB_TMO      128
#define XB_XCNT(j)  (256  + 64 * (j))
#define XB_XSUB(j)  (1280 + 64 * (j))
#define XB_XGEN(j)  (2304 + 64 * (j))
#define XB_TOP      3328
#define XB_TOPGEN   3392
#define XCD_BAR_WORDS 3456
#define XB_SPIN_CAP (1u << 18)

__device__ __forceinline__ unsigned xb_ld(unsigned* p)              { return __hip_atomic_load(p, __ATOMIC_RELAXED, __HIP_MEMORY_SCOPE_AGENT); }
__device__ __forceinline__ unsigned xb_add(unsigned* p, unsigned v) { return __hip_atomic_fetch_add(p, v, __ATOMIC_RELAXED, __HIP_MEMORY_SCOPE_AGENT); }
__device__ __forceinline__ unsigned xb_xcc_id() { return (unsigned)__builtin_amdgcn_s_getreg((3 << 11) | 20) & 0xFu; }
#define XB_SPIN(cond, bar) do { unsigned _sp = 0; while (cond) { __builtin_amdgcn_s_sleep(1); \
    if ((++_sp & 255u) == 0u) { if (xb_ld(&(bar)[XB_TMO])) break; if (_sp > XB_SPIN_CAP) { atomicAdd(&(bar)[XB_TMO], 1u); break; } } } } while (0)

struct XcdBarrier {
    unsigned* bar; unsigned x;
    volatile LAS unsigned* st;
};

__device__ __forceinline__ XcdBarrier xcd_barrier_post(unsigned* bar, volatile LAS unsigned* st) {
    XcdBarrier b; b.bar = bar; b.x = xb_xcc_id(); b.st = st;
    if (threadIdx.x == 0) (void)xb_add(&bar[XB_XCNT(b.x)], 1u);
    return b;
}
__device__ __forceinline__ void xcd_barrier_complete(unsigned* bar, unsigned x, unsigned& nloc, unsigned& nx) {
    const unsigned G = gridDim.x * gridDim.y * gridDim.z;
    unsigned sum, cnt, mine, sp = 0u;
    for (;;) {
        sum = 0u; cnt = 0u; mine = 0u;
#pragma unroll
        for (unsigned j = 0; j < 16; ++j) { const unsigned c = xb_ld(&bar[XB_XCNT(j)]); sum += c; cnt += (c > 0u) ? 1u : 0u; mine = (j == x) ? c : mine; }
        if (sum == G) break;
        __builtin_amdgcn_s_sleep(1);
        if ((++sp & 255u) == 0u) { if (xb_ld(&bar[XB_TMO])) break; if (sp > XB_SPIN_CAP) { atomicAdd(&bar[XB_TMO], 1u); break; } }
    }
    nloc = mine > 0u ? mine : 1u; nx = cnt > 0u ? cnt : 1u;
}

__device__ __forceinline__ void xcd_barrier(const XcdBarrier& b) {
    asm volatile("s_waitcnt vmcnt(0)" ::: "memory");
    __syncthreads();
    if (threadIdx.x == 0) {
        unsigned* bar = b.bar;
        __builtin_amdgcn_s_waitcnt(0);
        unsigned nloc = b.st[0], nx = b.st[1];
        if (nloc == 0u) { xcd_barrier_complete(bar, b.x, nloc, nx); b.st[0] = nloc; b.st[1] = nx; }
        const unsigned old = xb_add(&bar[XB_XSUB(b.x)], 1u);
        const unsigned gen = old / nloc;
        if (old + 1u == (gen + 1u) * nloc) {
            __builtin_amdgcn_fence(__ATOMIC_RELEASE, "agent");
            asm volatile("s_waitcnt vmcnt(0)" ::: "memory");
            const unsigned og = xb_add(&bar[XB_TOP], 1u);
            const unsigned tg = og / nx;
            if (og + 1u == (tg + 1u) * nx) xb_add(&bar[XB_TOPGEN], 1u);
            else XB_SPIN(xb_ld(&bar[XB_TOPGEN]) == tg, bar);
            __builtin_amdgcn_fence(__ATOMIC_ACQUIRE, "agent");
            xb_add(&bar[XB_XGEN(b.x)], 1u);
            asm volatile("s_waitcnt vmcnt(0)" ::: "memory");
        } else {
            XB_SPIN(xb_ld(&bar[XB_XGEN(b.x)]) == gen, bar);
            __builtin_amdgcn_fence(__ATOMIC_ACQUIRE, "agent");
            asm volatile("s_waitcnt vmcnt(0)" ::: "memory");
        }
    }
    __syncthreads();
}


static_assert(att::LDS_NEED <= LDS_RING && g8::STAGE_BYTES <= LDS_RING, "LDS ring");
__global__ void __launch_bounds__(NTHREADS, 2) mega(Params P, int ph_lo, int ph_hi) {
    extern __shared__ __attribute__((aligned(16))) unsigned char lds_raw[];
    LAS unsigned char* lds = (LAS unsigned char*)lds_raw;
    float* ldsf = (float*)lds_raw;
    cg::grid_group grid = cg::this_grid();
    LAS unsigned* bst = (LAS unsigned*)(lds + LDS_RING);
    if (threadIdx.x < 2) bst[threadIdx.x] = 0u;
    __syncthreads();
    const bool one = (ph_hi - ph_lo) > 1;
    XcdBarrier bar; bar.bar = (unsigned*)(P.ws + WS_BAR); bar.x = 0; bar.st = nullptr;
    if (one) bar = xcd_barrier_post((unsigned*)(P.ws + WS_BAR), (volatile LAS unsigned*)bst);
#define RUN_PHASE(k, call) do { if (ph_lo <= (k) && (k) < ph_hi) { call; if ((k) + 1 < ph_hi) { if ((k) == 0 && ph_hi > 1000) grid.sync(); else xcd_barrier(bar); } } } while (0)
    RUN_PHASE(0, phase0(P, ldsf));
    RUN_PHASE(1, phase1(P));
    RUN_PHASE(2, phase2(P, lds));
    RUN_PHASE(3, phase3(P, lds));
    RUN_PHASE(4, phase4(P, lds, ldsf));
    RUN_PHASE(5, phase5p(P));
    RUN_PHASE(6, phase5(P, lds, ldsf));
    RUN_PHASE(7, phase6(P));
    RUN_PHASE(8, phase7(P, lds));
    RUN_PHASE(9, phase8(P));
    RUN_PHASE(10, phase8b(P, lds));
    RUN_PHASE(11, phase8c(P, lds));
    RUN_PHASE(12, phase9(P, lds));
    RUN_PHASE(13, phase10(P, lds));
    RUN_PHASE(14, phase11(P, lds));
#undef RUN_PHASE
}

extern "C" void kernel_launch(void* const* d_in, const int* in_sizes, int n_in, void* d_out, int out_size, void* d_ws, size_t ws_size, hipStream_t stream) {
    static int grid = 0;
    if (grid == 0) {
        if (n_in != 34 || out_size != T * D || ws_size < WS_END) { fprintf(stderr, "kernel_launch: unexpected problem (n_in %d, out %d, ws %zu)\n", n_in, out_size, ws_size); grid = -1; return; }
        int dev = 0, cus = 0, per_cu = 0;
        (void)hipGetDevice(&dev);
        (void)hipDeviceGetAttribute(&cus, hipDeviceAttributeMultiprocessorCount, dev);
        if (hipFuncSetAttribute((const void*)mega, hipFuncAttributeMaxDynamicSharedMemorySize, LDS_TOTAL) != hipSuccess) { fprintf(stderr, "kernel_launch: hipFuncSetAttribute failed\n"); grid = -1; return; }
        (void)hipOccupancyMaxActiveBlocksPerMultiprocessor(&per_cu, mega, NTHREADS, LDS_TOTAL);
        if (per_cu < 1) { fprintf(stderr, "kernel_launch: occupancy query says %d\n", per_cu); grid = -1; return; }
        grid = cus;
    }
    if (grid < 0) return;
    Params p{};
    for (int i = 0; i < 34; ++i) p.in[i] = (const float*)d_in[i];
    p.out = (float*)d_out; p.ws = (unsigned char*)d_ws;
#if MK_ONE_LAUNCH
    (void)hipMemsetAsync((char*)d_ws + WS_BAR, 0, XCD_BAR_WORDS * 4, stream);
    int lo = 0, hi = NPHASES;
    void* args[] = {&p, &lo, &hi};
    hipError_t e = hipLaunchCooperativeKernel((void*)mega, dim3(grid), dim3(NTHREADS), args, LDS_TOTAL, stream);
    if (e != hipSuccess) fprintf(stderr, "cooperative launch failed: %s (grid %d)\n", hipGetErrorString(e), grid);
#else
    for (int ph = 0; ph < NPHASES; ++ph) hipLaunchKernelGGL(mega, dim3(grid), dim3(NTHREADS), LDS_TOTAL, stream, p, ph, ph + 1);
#endif
}
```

```cpp
#include <hip/hip_runtime.h>
#include <hip/hip_cooperative_groups.h>
#include <cstdio>
#include <cstdint>
namespace cg = cooperative_groups;

#ifndef MK_ONE_LAUNCH
#define MK_ONE_LAUNCH 1
#endif

typedef unsigned short bf16_t;
typedef short bf16x8 __attribute__((ext_vector_type(8)));
typedef float f32x4 __attribute__((ext_vector_type(4)));
typedef unsigned u32x4 __attribute__((ext_vector_type(4)));
typedef unsigned u32x2 __attribute__((ext_vector_type(2)));
typedef int i32x8 __attribute__((ext_vector_type(8)));
typedef int i32x4 __attribute__((ext_vector_type(4)));
typedef short s16x16 __attribute__((ext_vector_type(16)));
#define LAS __attribute__((address_space(3)))

constexpr int NB = 4, S = 8192, T = NB * S, D = 1024;
constexpr int NP = 3072;
constexpr int Q0 = 0, KC0 = 512, VC0 = 640, KS0 = 768, VS0 = 896, KW0 = 1024, VW0 = 1152, R0 = 1280, K0 = 1792, V0 = 2304, GL0 = 2816, WD0 = 2840;
constexpr int IN_COLS = 3000;
constexpr int NE = 32;
constexpr int NTHREADS = 512, NWAVES = 8;
constexpr int NPHASES = 13;
#ifndef EXPERT_CONV_IN_SCAN
#define EXPERT_CONV_IN_SCAN 1
#endif
constexpr int LDS_RING = 139264, LDS_TOTAL = 155648;

constexpr size_t MiB = 1u << 20;
constexpr size_t WS_CTL = 0;
constexpr size_t WS_BAR = 65536;
constexpr size_t WS_ADA = 1 * MiB;
constexpr size_t WS_COS = 2 * MiB, WS_SIN = 3 * MiB;
constexpr size_t WS_WIN = 4 * MiB;
constexpr size_t WS_WOUT = 10 * MiB;
constexpr size_t WS_CW1 = 12 * MiB;
constexpr size_t WS_CMP = 14 * MiB;
constexpr size_t WS_HID = 16 * MiB;
constexpr size_t WS_TOKW = 18 * MiB;
constexpr size_t WS_LIST = 984 * MiB;
constexpr size_t WS_BIAS1 = 23 * MiB;
constexpr size_t WS_WLORA = 23 * MiB + 65536;
constexpr size_t WS_LX = 768 * MiB;
constexpr size_t WS_WAG = 784 * MiB;
constexpr size_t WS_KVC = 24 * MiB;
constexpr size_t KVC_STRIDE = (size_t)(65536 + 16) * 64;
constexpr size_t WS_GU = 42 * MiB;
constexpr size_t WS_SROW = 138 * MiB;
constexpr size_t WS_QS = 139 * MiB;
constexpr size_t WS_H8 = 106 * MiB;
constexpr size_t WS_DN = 170 * MiB;
constexpr size_t WS_RA = 256 * MiB;
constexpr size_t WS_PROJ = 320 * MiB;
constexpr size_t WS_RW_W = 512 * MiB;
constexpr size_t WS_RW_R = 576 * MiB, WS_RW_K = 608 * MiB, WS_RW_V = 640 * MiB, WS_RW_KK = 672 * MiB, WS_RW_KKA = 704 * MiB, WS_RW_G = 736 * MiB;
constexpr size_t WS_Y = 768 * MiB;
constexpr size_t WS_ONSA = 832 * MiB;
constexpr size_t WS_MIXED = 320 * MiB;
constexpr size_t WS_ACT = 320 * MiB;
constexpr size_t WS_X1 = 600 * MiB;
constexpr size_t WS_YK = 728 * MiB;
constexpr size_t WS_H2X = 728 * MiB;
constexpr size_t WS_LOGP = 234 * MiB;
constexpr size_t WS_WRT = 250 * MiB;
constexpr size_t WS_KVI = 896 * MiB;
constexpr size_t WS_CMPI = 928 * MiB;
constexpr size_t WS_END = 1000 * MiB;

struct Params {
    const float* in[34];
    float* out;
    unsigned char* ws;
};
enum { I_X = 0, I_C, I_ADAW, I_ADAB, I_MIXPRE, I_MIXPOST, I_FFNPRE, I_FFNPOST, I_WIN, I_KPE, I_KW1, I_KW2, I_VPE, I_VW1, I_VW2, I_NSANORM,
       I_MU, I_W0, I_W2, I_A0, I_A2, I_G2, I_KK, I_KA, I_RK, I_LNW, I_LNB, I_WOUT, I_RW, I_RB, I_EGU, I_EBGU, I_EDN, I_EBDN };

__device__ __forceinline__ unsigned f2bf(float f) { unsigned u = __builtin_bit_cast(unsigned, f); return (u + 0x7fffu + ((u >> 16) & 1u)) >> 16; }
__device__ __forceinline__ float bf2f(unsigned short h) { return __builtin_bit_cast(float, (unsigned)h << 16); }
typedef float f32x2_pk __attribute__((ext_vector_type(2))); typedef __bf16 bf16x2_pk __attribute__((ext_vector_type(2)));
__device__ __forceinline__ unsigned pk2(float lo, float hi) { f32x2_pk v = {lo, hi}; bf16x2_pk b = __builtin_convertvector(v, bf16x2_pk); return __builtin_bit_cast(unsigned, b); }
__device__ __forceinline__ unsigned pk4f8(float a, float b, float c, float d) { int w = 0; w = __builtin_amdgcn_cvt_pk_fp8_f32(a, b, w, false); w = __builtin_amdgcn_cvt_pk_fp8_f32(c, d, w, true); return (unsigned)w; }
__device__ __forceinline__ float wave_sum(float v) {
#pragma unroll
    for (int o = 1; o < 64; o <<= 1) v += __shfl_xor(v, o);
    return v;
}
__device__ __forceinline__ float wave_max(float v) {
#pragma unroll
    for (int o = 1; o < 64; o <<= 1) v = fmaxf(v, __shfl_xor(v, o));
    return v;
}
__device__ __forceinline__ unsigned pk4i8(float a, float b, float c, float d) {
    const int ia = (int)__builtin_rintf(__builtin_amdgcn_fmed3f(a, -127.f, 127.f)), ib = (int)__builtin_rintf(__builtin_amdgcn_fmed3f(b, -127.f, 127.f)), ic = (int)__builtin_rintf(__builtin_amdgcn_fmed3f(c, -127.f, 127.f)), id = (int)__builtin_rintf(__builtin_amdgcn_fmed3f(d, -127.f, 127.f));
    return (unsigned)(ia & 255) | ((unsigned)(ib & 255) << 8) | ((unsigned)(ic & 255) << 16) | ((unsigned)id << 24);
}
__device__ __forceinline__ int tidx() { int t = (int)threadIdx.x; asm volatile("" : "+v"(t)); return t; }
__device__ __forceinline__ float sigmoidf_(float x) { return 1.f / (1.f + __expf(-x)); }
__device__ __forceinline__ void unpack8(u32x4 u, float (&f)[8]) {
    f[0] = __builtin_bit_cast(float, u.x << 16); f[1] = __builtin_bit_cast(float, u.x & 0xffff0000u); f[2] = __builtin_bit_cast(float, u.y << 16); f[3] = __builtin_bit_cast(float, u.y & 0xffff0000u);
    f[4] = __builtin_bit_cast(float, u.z << 16); f[5] = __builtin_bit_cast(float, u.z & 0xffff0000u); f[6] = __builtin_bit_cast(float, u.w << 16); f[7] = __builtin_bit_cast(float, u.w & 0xffff0000u);
}
__device__ __forceinline__ u32x4 pack8(const float (&f)[8]) { u32x4 o; o.x = pk2(f[0], f[1]); o.y = pk2(f[2], f[3]); o.z = pk2(f[4], f[5]); o.w = pk2(f[6], f[7]); return o; }
__device__ __forceinline__ int rope_d(int p) { return ((p >> 2) & 1) * 32 + ((p >> 5) & 1) * 16 + ((p >> 3) & 3) * 4 + (p & 3); }

template <int MODE = 0, class PMap, class KMap>
__device__ __forceinline__ void tr_tile(const float* __restrict__ src, int Nsrc, bf16_t* __restrict__ dst, int K, int p0, int k0, PMap pmap, KMap kmap, float* tile  , float qmul = 32.f) {
    const int tx = tidx() & 63, ty = tidx() >> 6;
    const int c = pmap(p0 + tx);
    float v[32];
#pragma unroll
    for (int i = 0; i < 32; ++i) { const int kk = ty + 8 * i; v[i] = (c >= 0) ? src[(size_t)kmap(k0 + kk) * Nsrc + c] : 0.f; }
#pragma unroll
    for (int i = 0; i < 32; ++i) tile[(ty + 8 * i) * 65 + tx] = v[i];
    __syncthreads();
    { const int pp = tidx() >> 3, kq = tidx() & 7;
#pragma unroll
      for (int j = 0; j < 4; ++j) { const float* tp = tile + (64 * j + 8 * kq) * 65 + pp;
        if constexpr (MODE == 1) { u32x2 o; o.x = pk4f8(32.f * tp[0], 32.f * tp[65], 32.f * tp[2 * 65], 32.f * tp[3 * 65]); o.y = pk4f8(32.f * tp[4 * 65], 32.f * tp[5 * 65], 32.f * tp[6 * 65], 32.f * tp[7 * 65]);
          *(u32x2*)((unsigned char*)dst + (size_t)(p0 + pp) * K + k0 + 64 * j + 8 * kq) = o; }
        else if constexpr (MODE == 2) { u32x2 o; o.x = pk4i8(qmul * tp[0], qmul * tp[65], qmul * tp[2 * 65], qmul * tp[3 * 65]); o.y = pk4i8(qmul * tp[4 * 65], qmul * tp[5 * 65], qmul * tp[6 * 65], qmul * tp[7 * 65]);
          *(u32x2*)((unsigned char*)dst + (size_t)(p0 + pp) * K + k0 + 64 * j + 8 * kq) = o; }
        else { u32x4 o; o.x = pk2(tp[0], tp[65]); o.y = pk2(tp[2 * 65], tp[3 * 65]); o.z = pk2(tp[4 * 65], tp[5 * 65]); o.w = pk2(tp[6 * 65], tp[7 * 65]);
          *(u32x4*)(dst + (size_t)(p0 + pp) * K + k0 + 64 * j + 8 * kq) = o; } } }
    __syncthreads();
}
struct MapId { __device__ int operator()(int p) const { return p; } };
struct MapWin { __device__ int operator()(int P) const {
    if (P < 1280) { const bool rope = (P < 640) || (P >= 768 && P < 896) || (P >= 1024 && P < 1152); return rope ? (P & ~63) + rope_d(P & 63) : P; }
    return P < 2816 ? P + 24 : (P < 2840 ? P - 2816 + 1280 : (P < IN_COLS ? P : -1)); } };
struct MapGU { __device__ int operator()(int P) const { return ((P >> 7) & 1) * 1024 + (P >> 8) * 128 + (P & 127); } };
struct MapCW1P { __device__ int operator()(int P) const { return P < 128 ? P : -1; } };
struct MapCW1K { __device__ int operator()(int k) const { return (k & ~63) + rope_d(k & 63); } };

__device__ __forceinline__ float sample_qmul(const float* __restrict__ w, float* red  ) {
    const int tid = tidx(); float s = 0.f;
#pragma unroll
    for (int i = 0; i < 8; ++i) { const float v = w[tid + 512 * i]; s += v * v; }
    s = wave_sum(s);
    __syncthreads();
    if ((tid & 63) == 0) red[tid >> 6] = s;
    __syncthreads();
    const float tot = ((red[0] + red[1]) + (red[2] + red[3])) + ((red[4] + red[5]) + (red[6] + red[7]));
    __syncthreads();
    const float rms = sqrtf(tot * (1.f / 4096.f));
    return rms > 0.f ? 127.f / (6.f * rms) : 0.f;
}
__device__ __forceinline__ void phase0(const Params& P, float* lds) {
    unsigned char* ws = P.ws;
    const int tid = tidx();
    if (blockIdx.x == 0 && tid < 128) ((unsigned*)(ws + WS_CTL))[tid] = 0u;
    for (int e = blockIdx.x * NTHREADS + tid; e < 1536 * 256; e += gridDim.x * NTHREADS) {
        const int n = e >> 8, k = e & 255; float v = 0.f;
        if (n < 512) { if (k < 32) v = P.in[I_W2][k * 512 + n]; }
        else if (n < 1024) { if (k >= 32 && k < 64) v = P.in[I_A2][(k - 32) * 512 + n - 512]; }
        else if (k >= 64 && k < 160) v = P.in[I_G2][(k - 64) * 512 + n - 1024];
        ((bf16_t*)(ws + WS_WLORA))[e] = (bf16_t)f2bf(v);
    }
    constexpr int U_ADA = 192, U_ROPE = 0, U_WIN = 48 * 4, U_WOUT = 16 * 4, U_CW1 = 2 * 4 * 8, U_B1 = 16, U_GU = 32 * 32 * 4, U_DN = 32 * 16 * 4;
    constexpr int TOTAL = U_ADA + U_ROPE + U_WIN + U_WOUT + U_CW1 + U_B1 + (EXPERT_CONV_IN_SCAN ? 0 : U_GU + U_DN);
    for (int u = blockIdx.x; u < TOTAL; u += gridDim.x) {
        int r = u;
        if (r < U_ADA) {
            float* cs = lds;
            float* part = lds + 4096;
            for (int i = tid; i < 4096; i += NTHREADS) { const float c0 = P.in[I_C][i]; cs[i] = c0 * sigmoidf_(c0); }
            __syncthreads();
            const int col = tid & 31, kg = tid >> 5, n = r * 32 + col;
            float a0 = 0.f, a1 = 0.f, a2 = 0.f, a3 = 0.f;
            const float* cw = P.in[I_ADAW] + (size_t)(kg * 64) * 6144 + n;
#pragma unroll 8
            for (int k = 0; k < 64; ++k) {
                const float w = cw[(size_t)k * 6144]; const int kk = kg * 64 + k;
                a0 += w * cs[kk]; a1 += w * cs[1024 + kk]; a2 += w * cs[2048 + kk]; a3 += w * cs[3072 + kk];
            }
            part[(kg * 4 + 0) * 32 + col] = a0; part[(kg * 4 + 1) * 32 + col] = a1; part[(kg * 4 + 2) * 32 + col] = a2; part[(kg * 4 + 3) * 32 + col] = a3;
            __syncthreads();
            if (tid < 128) { const int b = tid >> 5, j = tid & 31; float sacc = 0.f;
#pragma unroll
                for (int g = 0; g < 16; ++g) sacc += part[(g * 4 + b) * 32 + j];
                ((float*)(ws + WS_ADA))[b * 6144 + r * 32 + j] = sacc + P.in[I_ADAB][r * 32 + j]; }
            __syncthreads();
            continue;
        }
        r -= U_ADA;
        if (r < U_ROPE) {
            const int e = r * 512 + tid, t = e >> 5, j = e & 31;
            const double inv = pow(10000.0, -(double)j / 32.0);
            const float ang = (float)t * (float)inv;
            ((float*)(ws + WS_COS))[e] = (float)cos((double)ang);
            ((float*)(ws + WS_SIN))[e] = (float)sin((double)ang);
            continue;
        }
        r -= U_ROPE;
        if (r < U_WIN) { const float qm = sample_qmul(P.in[I_WIN], lds + 256 * 65); if (r == 0 && tid == 0) ((float*)(ws + WS_QS))[0] = qm > 0.f ? 1.f / qm : 0.f;
            tr_tile<2>(P.in[I_WIN], IN_COLS, (bf16_t*)(ws + WS_WIN), 1024, (r >> 2) * 64, (r & 3) * 256, MapWin(), MapId(), lds, qm); continue; }
        r -= U_WIN;
        if (r < U_WOUT) { tr_tile(P.in[I_WOUT], 1024, (bf16_t*)(ws + WS_WOUT), 1024, (r >> 2) * 64, (r & 3) * 256, MapId(), MapId(), lds); continue; }
        r -= U_WOUT;
        if (r < U_CW1) { const int kv = r >> 5, q = r & 31; bf16_t* dst = (bf16_t*)(ws + WS_CW1) + (size_t)kv * 256 * 2048;
            if (kv == 0) tr_tile(P.in[I_KW1], 128, dst, 2048, (q >> 3) * 64, (q & 7) * 256, MapCW1P(), MapCW1K(), lds);
            else tr_tile(P.in[I_VW1], 128, dst, 2048, (q >> 3) * 64, (q & 7) * 256, MapCW1P(), MapId(), lds);
            continue; }
        r -= U_CW1;
        if (r < U_B1) {
            const int kv = r >> 3, sl = r & 7;
            const float* pe = P.in[kv ? I_VPE : I_KPE]; const float* w1 = P.in[kv ? I_VW1 : I_KW1];
            const int n = tid & 127, qd = tid >> 7; float a = 0.f;
            const int kb = sl * 256 + qd * 64;
#pragma unroll 16
            for (int k = 0; k < 64; ++k) a += pe[kb + k] * w1[(size_t)(kb + k) * 128 + n];
            lds[tid] = a; __syncthreads();
            if (tid < 128) ((float*)(ws + WS_BIAS1))[(kv * 8 + sl) * 128 + tid] = (lds[tid] + lds[tid + 128]) + (lds[tid + 256] + lds[tid + 384]);
            __syncthreads();
            continue;
        }
        r -= U_B1;
        static_assert(EXPERT_CONV_IN_SCAN, "the expert weights (fp8) are converted by the scan units' loader waves");
    }
}

__device__ __forceinline__ void phase1(const Params& P) {
    const int lane = tidx() & 63, gw = blockIdx.x * NWAVES + (tidx() >> 6), ngw = gridDim.x * NWAVES;
    const float* ada = (const float*)(P.ws + WS_ADA);
    bf16_t* XN = (bf16_t*)(P.ws + WS_RA);
    for (int row = gw; row < T; row += ngw) {
        const int b = row / S;
        const f32x4* xr = (const f32x4*)(P.in[I_X] + (size_t)row * D) + lane;
        f32x4 v[4]; float s = 0.f;
#pragma unroll
        for (int j = 0; j < 4; ++j) { v[j] = xr[64 * j]; s += v[j].x * v[j].x + v[j].y * v[j].y + v[j].z * v[j].z + v[j].w * v[j].w; }
        const float rstd = rsqrtf(wave_sum(s) * (1.f / D) + 1e-6f);
        unsigned* o = (unsigned*)((unsigned char*)XN + (size_t)row * D) + lane;
        f32x4 h[4]; float am = 0.f;
#pragma unroll
        for (int j = 0; j < 4; ++j) {
            const int c = 4 * (lane + 64 * j);
            const f32x4 g = *(const f32x4*)(P.in[I_MIXPRE] + c), sh = *(const f32x4*)(ada + b * 6144 + c), sc = *(const f32x4*)(ada + b * 6144 + 1024 + c);
            h[j] = v[j] * rstd * g * (sc + 1.f) + sh;
            am = fmaxf(fmaxf(am, fmaxf(fabsf(h[j].x), fabsf(h[j].y))), fmaxf(fabsf(h[j].z), fabsf(h[j].w)));
        }
        am = wave_max(am);
        const float qm = am > 0.f ? 127.f / am : 0.f;
        if (lane == 0) ((float*)(P.ws + WS_SROW))[row] = am * (1.f / 127.f);
#pragma unroll
        for (int j = 0; j < 4; ++j) o[64 * j] = pk4i8(h[j].x * qm, h[j].y * qm, h[j].z * qm, h[j].w * qm);
    }
}

namespace g8 {
constexpr int BM = 256, BK = 64, HALF = 128, HTB = HALF * BK * 2, STAGE_BYTES = 8 * HTB;
__device__ __forceinline__ int lds_byte(int r, int c) { const int st = (r >> 4) * 2 + (c >> 5), rr = r & 15, cc = c & 31, ob = rr * 64 + cc * 2; return st * 1024 + (ob ^ (((ob >> 9) & 1) << 5)); }
__device__ __forceinline__ void stage_rc(int b, int& R, int& C) { const int st = b / 1024, sb = b % 1024, swz = sb ^ (((sb >> 9) & 1) << 5); R = (st >> 1) * 16 + swz / 64; C = (st & 1) * 32 + (swz % 64) / 2; }
__device__ __forceinline__ int perm32(int rho) { const int n = rho >> 4, i = rho & 15; return 8 * (i >> 2) + 4 * n + (i & 3); }
__device__ __forceinline__ i32x8 cat8(bf16x8 a, bf16x8 b) { const s16x16 v = __builtin_shufflevector(a, b, 0, 1, 2, 3, 4, 5, 6, 7, 8, 9, 10, 11, 12, 13, 14, 15); return __builtin_bit_cast(i32x8, v); }
__device__ __forceinline__ unsigned cvt_pk_bf16(float lo, float hi) { unsigned r; asm volatile("v_cvt_pk_bf16_f32 %0, %1, %2" : "=v"(r) : "v"(lo), "v"(hi)); return r; }

__device__ __forceinline__ void mma8(f32x4 (&c)[4][2], const bf16x8 (&At)[4][2], const bf16x8 (&Bt)[2][2]) {
    const i32x8 a0 = cat8(At[0][0], At[0][1]), a1 = cat8(At[1][0], At[1][1]), a2 = cat8(At[2][0], At[2][1]), a3 = cat8(At[3][0], At[3][1]), b0 = cat8(Bt[0][0], Bt[0][1]), b1 = cat8(Bt[1][0], Bt[1][1]);
    const unsigned one = 0x7f7f7f7fu;
    asm volatile("s_setprio 1\n\ts_nop 1\n\t"
                 "v_mfma_scale_f32_16x16x128_f8f6f4 %0, %8, %10, %0, %14, %14 op_sel_hi:[0,0,0]\n\t"
                 "v_mfma_scale_f32_16x16x128_f8f6f4 %1, %9, %10, %1, %14, %14 op_sel_hi:[0,0,0]\n\t"
                 "v_mfma_scale_f32_16x16x128_f8f6f4 %2, %8, %11, %2, %14, %14 op_sel_hi:[0,0,0]\n\t"
                 "v_mfma_scale_f32_16x16x128_f8f6f4 %3, %9, %11, %3, %14, %14 op_sel_hi:[0,0,0]\n\t"
                 "v_mfma_scale_f32_16x16x128_f8f6f4 %4, %8, %12, %4, %14, %14 op_sel_hi:[0,0,0]\n\t"
                 "v_mfma_scale_f32_16x16x128_f8f6f4 %5, %9, %12, %5, %14, %14 op_sel_hi:[0,0,0]\n\t"
                 "v_mfma_scale_f32_16x16x128_f8f6f4 %6, %8, %13, %6, %14, %14 op_sel_hi:[0,0,0]\n\t"
                 "v_mfma_scale_f32_16x16x128_f8f6f4 %7, %9, %13, %7, %14, %14 op_sel_hi:[0,0,0]\n\t"
                 "s_setprio 0"
                 : "+v"(c[0][0]), "+v"(c[0][1]), "+v"(c[1][0]), "+v"(c[1][1]), "+v"(c[2][0]), "+v"(c[2][1]), "+v"(c[3][0]), "+v"(c[3][1])
                 : "v"(b0), "v"(b1), "v"(a0), "v"(a1), "v"(a2), "v"(a3), "v"(one));
}

template <bool NOP>
__device__ __forceinline__ void mma8_settle(f32x4 (&c)[2][4][2]) {
#define G8_PIN16 "+v"(c[0][0][0]), "+v"(c[0][0][1]), "+v"(c[0][1][0]), "+v"(c[0][1][1]), "+v"(c[0][2][0]), "+v"(c[0][2][1]), "+v"(c[0][3][0]), "+v"(c[0][3][1]), \
                 "+v"(c[1][0][0]), "+v"(c[1][0][1]), "+v"(c[1][1][0]), "+v"(c[1][1][1]), "+v"(c[1][2][0]), "+v"(c[1][2][1]), "+v"(c[1][3][0]), "+v"(c[1][3][1])
    if constexpr (NOP) asm volatile("s_nop 15\n\ts_nop 7" : G8_PIN16); else asm volatile("" : G8_PIN16);
#undef G8_PIN16
}

struct Unit { const char* A; const char* B; unsigned va[2][2]; int x0, x1, x2, x3; };

template <bool PERM, int MODE = 0, class Epi, class Sched>
__device__ __forceinline__ void gemm_phase(LAS unsigned char* lds, int K, int ldb, const Sched& S, const Epi& E) {
    const int tid = tidx(), wid = __builtin_amdgcn_readfirstlane(tid >> 6), lane = tid & 63, wr = wid >> 2, wc = wid & 3, fr = lane & 15, fq = lane >> 4;
    int nt = K / BK; asm volatile("" : "+s"(nt));
    unsigned vb[2][2];
    { int R0, C0, R1, C1; stage_rc(tid * 16, R0, C0); stage_rc(tid * 16 + 8192, R1, C1);
      const int Rb0 = PERM ? ((R0 & ~31) + perm32(R0 & 31)) : R0, Rb1 = PERM ? ((R1 & ~31) + perm32(R1 & 31)) : R1;
      vb[0][0] = (unsigned)(Rb0 * ldb + C0) * 2u; vb[0][1] = (unsigned)(Rb1 * ldb + C1) * 2u; vb[1][0] = (unsigned)((Rb0 + HALF) * ldb + C0) * 2u; vb[1][1] = (unsigned)((Rb1 + HALF) * ldb + C1) * 2u; }
    const size_t kstep = (size_t)(BK * 2);
    const unsigned ldsw = (unsigned)wid * 1024u;
    const int aoff = lds_byte(wr * 64 + fr, fq * 8), boff = lds_byte(wc * 32 + fr, fq * 8);
#define G8_SA(b, h) (((b) * 2 + (h)) * HTB)
#define G8_SB(b, h) ((4 + (b) * 2 + (h)) * HTB)
#define G8_STAGE(bufoff, gbase, v0, v1) do { unsigned o0_ = (v0), o1_ = (v1); asm volatile("" : "+v"(o0_), "+v"(o1_));     \
        __builtin_amdgcn_global_load_lds((const unsigned*)((gbase) + o0_), (LAS unsigned*)(lds + (bufoff) + ldsw), 16, 0, 0); \
        __builtin_amdgcn_global_load_lds((const unsigned*)((gbase) + o1_), (LAS unsigned*)(lds + (bufoff) + ldsw + 8192), 16, 0, 0); } while (0)
#define G8_LDA(dst, b, h) do { _Pragma("unroll") for (int m = 0; m < 4; ++m) _Pragma("unroll") for (int k = 0; k < 2; ++k) dst[m][k] = *(const LAS bf16x8*)(lds + G8_SA(b, h) + aoff + m * 2048 + k * 1024); } while (0)
#define G8_LDB(dst, b, h) do { _Pragma("unroll") for (int n = 0; n < 2; ++n) _Pragma("unroll") for (int k = 0; k < 2; ++k) dst[n][k] = *(const LAS bf16x8*)(lds + G8_SB(b, h) + boff + n * 2048 + k * 1024); } while (0)
#define G8_MMA(ai, bj, At, Bt) do { if constexpr (MODE == 1) mma8(acc[ai][bj], At, Bt); else if constexpr (MODE == 2) { __builtin_amdgcn_s_setprio(1); _Pragma("unroll") for (int m = 0; m < 4; ++m) _Pragma("unroll") for (int n = 0; n < 2; ++n) _Pragma("unroll") for (int k = 0; k < 2; ++k) \
        acc[ai][bj][m][n] = __builtin_bit_cast(f32x4, __builtin_amdgcn_mfma_i32_16x16x64_i8(__builtin_bit_cast(i32x4, Bt[n][k]), __builtin_bit_cast(i32x4, At[m][k]), __builtin_bit_cast(i32x4, acc[ai][bj][m][n]), 0, 0, 0)); __builtin_amdgcn_s_setprio(0); } \
        else { __builtin_amdgcn_s_setprio(1); _Pragma("unroll") for (int m = 0; m < 4; ++m) _Pragma("unroll") for (int n = 0; n < 2; ++n) _Pragma("unroll") for (int k = 0; k < 2; ++k) \
        acc[ai][bj][m][n] = __builtin_amdgcn_mfma_f32_16x16x32_bf16(Bt[n][k], At[m][k], acc[ai][bj][m][n], 0, 0, 0); __builtin_amdgcn_s_setprio(0); } } while (0)
#define G8_WAIT_V(n) asm volatile("s_waitcnt vmcnt(" #n ")" ::: "memory")
#define G8_WAIT_L(n) asm volatile("s_waitcnt lgkmcnt(" #n ")" ::: "memory")
#define G8_BAR __builtin_amdgcn_s_barrier()
#define G8_SCHED __builtin_amdgcn_sched_barrier(0)
    Unit cur, nxt; int ui = 0;
#define G8_NEXT(i, u) ({ int R0_, C0_, R1_, C1_; const int t_ = tidx(); stage_rc(t_ * 16, R0_, C0_); stage_rc(t_ * 16 + 8192, R1_, C1_); S.next((i), (u), R0_, C0_, R1_, C1_); })
    if (!G8_NEXT(0, cur)) return;
    f32x4 acc[2][2][4][2];
#pragma unroll
    for (int a = 0; a < 2; ++a)
#pragma unroll
        for (int b = 0; b < 2; ++b)
#pragma unroll
            for (int m = 0; m < 4; ++m)
#pragma unroll
                for (int n = 0; n < 2; ++n) acc[a][b][m][n] = (f32x4){0.f, 0.f, 0.f, 0.f};
    bf16x8 At[4][2], B0[2][2], B1[2][2];
    G8_STAGE(G8_SB(0, 0), cur.B, vb[0][0], vb[0][1]); G8_STAGE(G8_SB(0, 1), cur.B, vb[1][0], vb[1][1]); G8_STAGE(G8_SA(0, 0), cur.A, cur.va[0][0], cur.va[0][1]); G8_STAGE(G8_SA(0, 1), cur.A, cur.va[1][0], cur.va[1][1]);
    if (wr == 1) G8_BAR;
    G8_WAIT_V(2); G8_BAR;
    G8_STAGE(G8_SB(1, 0), cur.B + kstep, vb[0][0], vb[0][1]); G8_STAGE(G8_SA(1, 0), cur.A + kstep, cur.va[0][0], cur.va[0][1]); G8_STAGE(G8_SB(1, 1), cur.B + kstep, vb[1][0], vb[1][1]);
    G8_WAIT_V(6); G8_BAR;
    for (;;) {
        const bool has_next = G8_NEXT(ui + 1, nxt);
        if (!has_next) nxt = cur;
        for (int t = 0; t < nt; t += 2) {
            const bool last = (t == nt - 2);
            const char* a1 = cur.A + (size_t)(t + 1) * kstep;
            const char* a2 = last ? nxt.A : cur.A + (size_t)(t + 2) * kstep; const char* b2 = last ? nxt.B : cur.B + (size_t)(t + 2) * kstep;
            const char* a3 = a2 + kstep; const char* b3 = b2 + kstep;
            const unsigned w00 = last ? nxt.va[0][0] : cur.va[0][0], w01 = last ? nxt.va[0][1] : cur.va[0][1], w10 = last ? nxt.va[1][0] : cur.va[1][0], w11 = last ? nxt.va[1][1] : cur.va[1][1];
            G8_LDB(B0, 0, 0); G8_LDB(B1, 0, 1); G8_SCHED; G8_LDA(At, 0, 0); G8_STAGE(G8_SA(1, 1), a1, cur.va[1][0], cur.va[1][1]);
            G8_WAIT_V(8); G8_WAIT_L(0); G8_BAR; G8_MMA(0, 0, At, B0); G8_MMA(0, 1, At, B1); G8_BAR; G8_SCHED;
            G8_LDA(At, 0, 1); G8_STAGE(G8_SB(0, 0), b2, vb[0][0], vb[0][1]); G8_STAGE(G8_SB(0, 1), b2, vb[1][0], vb[1][1]); G8_STAGE(G8_SA(0, 0), a2, w00, w01);
            G8_WAIT_V(8); G8_WAIT_L(0); G8_BAR; G8_MMA(1, 0, At, B0); G8_MMA(1, 1, At, B1); G8_BAR; G8_SCHED;
            G8_LDB(B0, 1, 0); G8_LDB(B1, 1, 1); G8_SCHED; G8_LDA(At, 1, 0); G8_STAGE(G8_SA(0, 1), a2, w10, w11);
            G8_WAIT_V(8); G8_WAIT_L(0); G8_BAR; G8_MMA(0, 0, At, B0); G8_MMA(0, 1, At, B1); G8_BAR; G8_SCHED;
            G8_LDA(At, 1, 1); G8_STAGE(G8_SB(1, 0), b3, vb[0][0], vb[0][1]); G8_STAGE(G8_SB(1, 1), b3, vb[1][0], vb[1][1]); G8_STAGE(G8_SA(1, 0), a3, w00, w01);
            G8_WAIT_V(8); G8_WAIT_L(0); G8_BAR; G8_MMA(1, 0, At, B0); G8_MMA(1, 1, At, B1); G8_BAR; G8_SCHED;
        }
        if (wr == 0) G8_BAR;
        if constexpr (MODE == 2) {
            const int fr_ = tidx() & 15;
            _Pragma("unroll") for (int a = 0; a < 2; ++a) _Pragma("unroll") for (int m = 0; m < 4; ++m) { const float sc = E.rs(cur, a * 128 + wr * 64 + m * 16 + fr_);
                _Pragma("unroll") for (int b = 0; b < 2; ++b) _Pragma("unroll") for (int n = 0; n < 2; ++n) _Pragma("unroll") for (int i = 0; i < 4; ++i) { const f32x4 t = acc[a][b][m][n]; const i32x4 ti = __builtin_bit_cast(i32x4, t); acc[a][b][m][n][i] = (float)ti[i] * sc; } }
        }
        if constexpr (MODE == 1) {
            mma8_settle<true>(acc[0]); mma8_settle<false>(acc[1]);
            _Pragma("unroll") for (int a = 0; a < 2; ++a) _Pragma("unroll") for (int b = 0; b < 2; ++b) _Pragma("unroll") for (int m = 0; m < 4; ++m) _Pragma("unroll") for (int n = 0; n < 2; ++n) acc[a][b][m][n] *= (1.f / 32.f);
        }
        { const int l_ = tidx() & 63; E(acc, cur, wr, wc, l_ & 15, l_ >> 4); }
        if (!has_next) break;
#pragma unroll
        for (int a = 0; a < 2; ++a)
#pragma unroll
            for (int b = 0; b < 2; ++b)
#pragma unroll
                for (int m = 0; m < 4; ++m)
#pragma unroll
                    for (int n = 0; n < 2; ++n) acc[a][b][m][n] = (f32x4){0.f, 0.f, 0.f, 0.f};
        cur = nxt; ++ui;
        if (wr == 1) G8_BAR;
    }
    G8_WAIT_V(0);
    G8_BAR;
#undef G8_NEXT
#undef G8_SA
#undef G8_SB
#undef G8_STAGE
#undef G8_LDA
#undef G8_LDB
#undef G8_MMA
#undef G8_WAIT_V
#undef G8_WAIT_L
#undef G8_BAR
#undef G8_SCHED
}

__device__ __forceinline__ const char* uptr(const void* p) {
    const unsigned long long v = (unsigned long long)p; const unsigned lo = __builtin_amdgcn_readfirstlane((unsigned)v), hi = __builtin_amdgcn_readfirstlane((unsigned)(v >> 32));
    return (const char*)(((unsigned long long)hi << 32) | lo); }
__device__ __forceinline__ int ui(int v) { return __builtin_amdgcn_readfirstlane(v); }
__device__ __forceinline__ void dense_unit(Unit& u, const bf16_t* A, int lda, const bf16_t* Bt, int ldb, int pm, int pn, int R0, int C0, int R1, int C1) {
    u.A = uptr(A + (size_t)pm * BM * lda); u.B = uptr(Bt + (size_t)pn * BM * ldb);
    u.va[0][0] = (unsigned)(R0 * lda + C0) * 2u; u.va[0][1] = (unsigned)(R1 * lda + C1) * 2u; u.va[1][0] = (unsigned)((R0 + HALF) * lda + C0) * 2u; u.va[1][1] = (unsigned)((R1 + HALF) * lda + C1) * 2u;
    u.x0 = ui(pm); u.x1 = ui(pn); u.x2 = 0; u.x3 = 0;
}
__device__ __forceinline__ bool static_tile(int i, int G, int c, int nM, int nN, int& pm, int& pn) {
    const int nwg = nM * nN; const long L = (long)i * G + c; if (L >= nwg) return false;
    int wgid = (int)L; { const int q = nwg / 8, r = nwg % 8, xcd = wgid % 8, off = wgid / 8; wgid = (xcd < r ? xcd * (q + 1) : r * (q + 1) + (xcd - r) * q) + off; }
    const int nig = 8 * nN, gid = wgid / nig, fm = gid * 8, gsz = (nM - fm) < 8 ? (nM - fm) : 8;
    pm = fm + ((wgid % nig) % gsz); pn = (wgid % nig) / gsz; return true;
}
}

struct SchedDense {
    const bf16_t* A; const bf16_t* Bt; int lda, ldb, nM, nN;
    __device__ __forceinline__ bool next(int i, g8::Unit& u, int R0, int C0, int R1, int C1) const {
        int pm, pn; if (!g8::static_tile(i, (int)gridDim.x, (int)blockIdx.x, nM, nN, pm, pn)) return false;
        g8::dense_unit(u, A, lda, Bt, ldb, pm, pn, R0, C0, R1, C1); return true;
    }
};
struct EpiInProj {
    bf16_t* proj; bf16_t* kvc; unsigned char* kvi; const float* COS; const float* SIN; const float* srow; const float* qs;
    __device__ __forceinline__ float rs(const g8::Unit& u, int r) const { return srow[u.x0 * 256 + r] * qs[0]; }
    __device__ __forceinline__ void operator()(const f32x4 (&acc)[2][2][4][2], const g8::Unit& u, int wr, int wc, int fr, int fq) const {
        const int pm = u.x0, pn = u.x1;
        f32x4 frv;
#pragma unroll
        for (int i = 0; i < 4; ++i) frv[i] = __builtin_amdgcn_exp2f(-(float)(16 * (wc & 1) + 4 * fq + i) * (13.287712379549449f / 32.f)) * 0.15915494309189535f;
#pragma unroll
        for (int ai = 0; ai < 2; ++ai)
#pragma unroll
            for (int m = 0; m < 4; ++m) {
                const int row = pm * 256 + ai * 128 + wr * 64 + m * 16 + fr, t = row & (S - 1);
                f32x4 cs = {0.f, 0.f, 0.f, 0.f}, sn = {0.f, 0.f, 0.f, 0.f};
                if (pn < 5) {
#pragma unroll
                    for (int i = 0; i < 4; ++i) { const float rev = __builtin_amdgcn_fractf((float)t * frv[i]); cs[i] = __builtin_amdgcn_cosf(rev); sn[i] = __builtin_amdgcn_sinf(rev); }
                }
                u32x4 w[2];
#pragma unroll
                for (int bj = 0; bj < 2; ++bj) {
                    f32x4 v0 = acc[ai][bj][m][0], v1 = acc[ai][bj][m][1];
                    if (pn < 2 || (pn < 5 && bj == 0)) { const f32x4 x1 = v0, x2 = v1; v0 = x1 * cs - x2 * sn; v1 = x2 * cs + x1 * sn; }
                    w[bj].x = g8::cvt_pk_bf16(v0[0], v0[1]); w[bj].y = g8::cvt_pk_bf16(v0[2], v0[3]); w[bj].z = g8::cvt_pk_bf16(v1[0], v1[1]); w[bj].w = g8::cvt_pk_bf16(v1[2], v1[3]);
                }
                if (pn == 3 || pn == 4) {
                    const int b = row / S, g = wc >> 1, key = t & 63;
                    unsigned char* ti = kvi + ((size_t)(((pn - 3) * NB + b) * 2 + g) * (S / 64) + (t >> 6)) * 16384;
                    *(u32x4*)(ti + ((wc & 1) * 4 + fq) * 1024 + key * 16) = w[0];
                    *(u32x4*)(ti + 8192 + (wc & 1) * 4096 + (key >> 4) * 1024 + (key & 15) * 64 + fq * 16) = w[1];
                } else {
                    bf16_t* pr = proj + (size_t)row * NP + pn * 256 + wc * 32 + 8 * fq;
                    *(u32x4*)pr = w[0]; *(u32x4*)(pr + 128) = w[1];
                    if (pn == 2) {
                        const int b = row / S, g = wc >> 1;
                        bf16_t* kp = kvc + ((size_t)((b * 2 + g) * S + t)) * 64 + (wc & 1) * 32 + 8 * fq;
                        *(u32x4*)kp = w[0]; *(u32x4*)(kp + KVC_STRIDE) = w[1];
                    }
                }
                asm volatile("" ::: "memory");
            }
    }
};
__device__ __forceinline__ void phase2(const Params& P, LAS unsigned char* lds) {
    unsigned char* ws = P.ws;
    SchedDense Sd{(const bf16_t*)(ws + WS_RA), (const bf16_t*)(ws + WS_WIN), D / 2, D / 2, T / 256, NP / 256};
    EpiInProj E{(bf16_t*)(ws + WS_PROJ), (bf16_t*)(ws + WS_KVC), ws + WS_KVI, (const float*)(ws + WS_COS), (const float*)(ws + WS_SIN), (const float*)(ws + WS_SROW), (const float*)(ws + WS_QS)};
    g8::gemm_phase<true, 2>(lds, D / 2, D / 2, Sd, E);
}

__device__ __forceinline__ float gelu_tanh(float x) { const float u = 0.7978845608028654f * (x + 0.044715f * x * x * x); return 0.5f * x * (1.f + tanhf(u)); }
struct SchedCmp {
    const bf16_t* kvc; const bf16_t* cw1;
    __device__ __forceinline__ bool next(int i, g8::Unit& u, int R0, int C0, int R1, int C1) const {
        const int id = (int)blockIdx.x + i * (int)gridDim.x; if (id >= 32) return false;
        const int kv = id >> 4, mt = id & 15;
        g8::dense_unit(u, kvc + (size_t)kv * KVC_STRIDE, 1024, cw1 + (size_t)kv * 256 * 2048, 2048, mt, 0, R0, C0, R1, C1); u.x2 = g8::ui(kv); return true;
    }
};
struct EpiCmp {
    bf16_t* hid; const float* bias1;
    __device__ __forceinline__ void operator()(const f32x4 (&acc)[2][2][4][2], const g8::Unit& u, int wr, int wc, int fr, int fq) const {
        const int kv = u.x2, col = wc * 32 + 8 * fq;
        f32x4 b0 = {0.f, 0.f, 0.f, 0.f}, b1 = {0.f, 0.f, 0.f, 0.f};
#pragma unroll
        for (int sl = 0; sl < 8; ++sl) { b0 += *(const f32x4*)(bias1 + (kv * 8 + sl) * 128 + col); b1 += *(const f32x4*)(bias1 + (kv * 8 + sl) * 128 + col + 4); }
#pragma unroll
        for (int ai = 0; ai < 2; ++ai)
#pragma unroll
            for (int m = 0; m < 4; ++m) {
                const int row = u.x0 * 256 + ai * 128 + wr * 64 + m * 16 + fr;
                const f32x4 v0 = acc[ai][0][m][0] + b0, v1 = acc[ai][0][m][1] + b1;
                u32x4 w; w.x = pk2(gelu_tanh(v0[0]), gelu_tanh(v0[1])); w.y = pk2(gelu_tanh(v0[2]), gelu_tanh(v0[3])); w.z = pk2(gelu_tanh(v1[0]), gelu_tanh(v1[1])); w.w = pk2(gelu_tanh(v1[2]), gelu_tanh(v1[3]));
                *(u32x4*)(hid + ((size_t)kv * 4096 + row) * 128 + col) = w;
            }
    }
};
__device__ __forceinline__ void phase3(const Params& P, LAS unsigned char* lds) {
    unsigned char* ws = P.ws;
    {
        SchedCmp Sc{(const bf16_t*)(ws + WS_KVC), (const bf16_t*)(ws + WS_CW1)};
        EpiCmp E{(bf16_t*)(ws + WS_HID), (const float*)(ws + WS_BIAS1)};
        g8::gemm_phase<true>(lds, 2048, 2048, Sc, E);
    }
    const bf16_t* proj = (const bf16_t*)(ws + WS_PROJ);
    const float* mu = P.in[I_MU];
    bf16_t* LX = (bf16_t*)(ws + WS_LX);
    for (int e = blockIdx.x * NTHREADS + tidx(); e < T * 32; e += gridDim.x * NTHREADS) {
        const int row = e >> 5, c0 = (e & 31) * 8, t = row & (S - 1);
        u32x4 o = {0u, 0u, 0u, 0u};
        if (c0 < 160) {
            const u32x4 cu = *(const u32x4*)(proj + (size_t)row * NP + WD0 + c0);
            u32x4 pu = {0u, 0u, 0u, 0u}; if (t > 0) pu = *(const u32x4*)(proj + (size_t)(row - 1) * NP + WD0 + c0);
            float cv[8], pv_[8], xs[8]; unpack8(cu, cv); unpack8(pu, pv_);
#pragma unroll
            for (int i = 0; i < 8; ++i) {
                float x = cv[i] + (pv_[i] - cv[i]) * mu[1536 + c0 + i];
                xs[i] = c0 < 32 ? tanhf(x) : (c0 >= 64 ? sigmoidf_(x) : x);
            }
            o = pack8(xs);
        }
        *(u32x4*)(LX + (size_t)row * 256 + c0) = o;
    }
}

struct EpiBf16 {
    bf16_t* O; int ldc;
    __device__ __forceinline__ void operator()(const f32x4 (&acc)[2][2][4][2], const g8::Unit& u, int wr, int wc, int fr, int fq) const {
#pragma unroll
        for (int ai = 0; ai < 2; ++ai)
#pragma unroll
            for (int m = 0; m < 4; ++m) {
                bf16_t* rowp = O + (size_t)(u.x0 * 256 + ai * 128 + wr * 64 + m * 16 + fr) * ldc + u.x1 * 256 + wc * 32 + 8 * fq;
#pragma unroll
                for (int bj = 0; bj < 2; ++bj) {
                    const f32x4 v0 = acc[ai][bj][m][0], v1 = acc[ai][bj][m][1];
                    u32x4 w; w.x = g8::cvt_pk_bf16(v0[0], v0[1]); w.y = g8::cvt_pk_bf16(v0[2], v0[3]); w.z = g8::cvt_pk_bf16(v1[0], v1[1]); w.w = g8::cvt_pk_bf16(v1[2], v1[3]);
                    *(u32x4*)(rowp + bj * 128) = w;
                }
            }
    }
};
__device__ __forceinline__ void phase4(const Params& P, LAS unsigned char* lds, float* ldsf) {
    unsigned char* ws = P.ws;
    {
        SchedDense Sd{(const bf16_t*)(ws + WS_LX), (const bf16_t*)(ws + WS_WLORA), 256, 256, T / 256, 1536 / 256};
        EpiBf16 E{(bf16_t*)(ws + WS_WAG), 1536};
        g8::gemm_phase<true>(lds, 256, 256, Sd, E);
    }
    __syncthreads();
    float* w2s = ldsf;
    float* hs = ldsf + 2 * 128 * 64 + (tidx() >> 6) * 128;
    for (int i = tidx(); i < 2 * 128 * 64 / 4; i += NTHREADS) { const int kv = i >> 11, j = i & 2047; ((f32x4*)w2s)[i] = ((const f32x4*)P.in[kv ? I_VW2 : I_KW2])[j]; }
    __syncthreads();
    const int lane = tidx() & 63, gw = blockIdx.x * NWAVES + (tidx() >> 6), ngw = gridDim.x * NWAVES;
    for (int item = gw; item < 2 * 4096; item += ngw) {
        const int kv = item >> 12, row = item & 4095;
        const unsigned hw = ((const unsigned*)((const bf16_t*)(ws + WS_HID) + ((size_t)kv * 4096 + row) * 128))[lane];
        hs[2 * lane] = __builtin_bit_cast(float, hw << 16); hs[2 * lane + 1] = __builtin_bit_cast(float, hw & 0xffff0000u);
        asm volatile("s_waitcnt lgkmcnt(0)" ::: "memory");
        const int ns = kv ? lane : rope_d(lane);
        const float* wc = w2s + kv * 8192 + ns;
        float a0 = 0.f, a1 = 0.f;
#pragma unroll 8
        for (int c = 0; c < 128; c += 4) { const f32x4 h4 = *(const f32x4*)(hs + c); a0 += h4.x * wc[c * 64] + h4.z * wc[(c + 2) * 64]; a1 += h4.y * wc[(c + 1) * 64] + h4.w * wc[(c + 3) * 64]; }
        const float a = a0 + a1;
        { const int bg = row >> 9, i = row & 511, key = i & 63, n = lane; unsigned char* ti = ws + WS_CMPI + ((size_t)bg * 8 + (i >> 6)) * 16384;
          if (kv == 0) *(bf16_t*)(ti + (n >> 3) * 1024 + key * 16 + (n & 7) * 2) = (bf16_t)f2bf(a);
          else *(bf16_t*)(ti + 8192 + (n >> 5) * 4096 + (key >> 4) * 1024 + (key & 15) * 64 + (n & 31) * 2) = (bf16_t)f2bf(a); }
        asm volatile("s_waitcnt lgkmcnt(0)" ::: "memory");
    }
}

__device__ __forceinline__ void phase5p(const Params& P) {
    unsigned char* ws = P.ws;
    const int lane = tidx() & 63, gw = blockIdx.x * NWAVES + (tidx() >> 6), ngw = gridDim.x * NWAVES, c0 = 8 * lane;
    const bf16_t* proj = (const bf16_t*)(ws + WS_PROJ); const bf16_t* wag = (const bf16_t*)(ws + WS_WAG);
    const float* mu = P.in[I_MU];
    float w0[8], a0v[8], kkw[8], kaw[8], mur[8], muk[8], muv[8];
#pragma unroll
    for (int i = 0; i < 8; ++i) { w0[i] = P.in[I_W0][c0 + i]; a0v[i] = P.in[I_A0][c0 + i]; kkw[i] = P.in[I_KK][c0 + i]; kaw[i] = P.in[I_KA][c0 + i]; mur[i] = mu[c0 + i]; muk[i] = mu[512 + c0 + i]; muv[i] = mu[1024 + c0 + i]; }
    for (int row = gw; row < T; row += ngw) {
        const bool has_prev = (row & (S - 1)) != 0;
        const bf16_t* pr = proj + (size_t)row * NP + c0; const bf16_t* pp = has_prev ? pr - NP : pr; const bf16_t* wg = wag + (size_t)row * 1536 + c0;
        const u32x4 r8 = *(const u32x4*)(pr + R0), k8 = *(const u32x4*)(pr + K0), v8 = *(const u32x4*)(pr + V0);
        const u32x4 rp8 = *(const u32x4*)(pp + R0), kp8 = *(const u32x4*)(pp + K0), vp8 = *(const u32x4*)(pp + V0);
        const u32x4 wl8 = *(const u32x4*)(wg), al8 = *(const u32x4*)(wg + 512), gg8 = *(const u32x4*)(wg + 1024);
        float rc[8], kc[8], vc[8], rp[8], kp[8], vp[8], wl[8], al[8];
        unpack8(r8, rc); unpack8(k8, kc); unpack8(v8, vc); unpack8(rp8, rp); unpack8(kp8, kp); unpack8(vp8, vp); unpack8(wl8, wl); unpack8(al8, al);
        float ro[8], ko[8], vo[8], wo[8], kk[8], kka[8], av[8]; float ss = 0.f;
#pragma unroll
        for (int i = 0; i < 8; ++i) {
            const float pr_ = has_prev ? rp[i] : 0.f, pk_ = has_prev ? kp[i] : 0.f, pv_ = has_prev ? vp[i] : 0.f;
            ro[i] = rc[i] + (pr_ - rc[i]) * mur[i]; const float k = kc[i] + (pk_ - kc[i]) * muk[i]; vo[i] = vc[i] + (pv_ - vc[i]) * muv[i];
            av[i] = sigmoidf_(a0v[i] + al[i]);
            wo[i] = __expf(-0.6065306597126334f * sigmoidf_(w0[i] + wl[i]));
            kk[i] = k * kkw[i]; ss += kk[i] * kk[i];
            ko[i] = k * (1.f + (av[i] - 1.f) * kaw[i]);
        }
        ss += __shfl_xor(ss, 1); ss += __shfl_xor(ss, 2); ss += __shfl_xor(ss, 4);
        const float inv = 1.f / fmaxf(sqrtf(ss), 1e-12f);
#pragma unroll
        for (int i = 0; i < 8; ++i) { kk[i] *= inv; kka[i] = kk[i] * av[i]; }
        const size_t o = (size_t)row * 512 + c0;
        *(f32x4*)((float*)(ws + WS_RW_W) + o) = (f32x4){wo[0], wo[1], wo[2], wo[3]}; *(f32x4*)((float*)(ws + WS_RW_W) + o + 4) = (f32x4){wo[4], wo[5], wo[6], wo[7]};
        *(u32x4*)((bf16_t*)(ws + WS_RW_R) + o) = pack8(ro); *(u32x4*)((bf16_t*)(ws + WS_RW_K) + o) = pack8(ko); *(u32x4*)((bf16_t*)(ws + WS_RW_V) + o) = pack8(vo);
        *(u32x4*)((bf16_t*)(ws + WS_RW_KK) + o) = pack8(kk); *(u32x4*)((bf16_t*)(ws + WS_RW_KKA) + o) = pack8(kka); *(u32x4*)((bf16_t*)(ws + WS_RW_G) + o) = gg8;
    }
}

namespace att {
typedef float f32x16 __attribute__((ext_vector_type(16)));
typedef short s16x4 __attribute__((ext_vector_type(4)));
typedef float f32x2_t __attribute__((ext_vector_type(2)));
typedef __bf16 bf16x2_t __attribute__((ext_vector_type(2)));
constexpr float C2 = 0.125f * 1.4426950408889634f;
constexpr int SLOT = 16384;
constexpr int GROUP = 3, NSLOT = 2 * GROUP;
constexpr int IMP_STRIDE = 136;
constexpr int WAVE_LDS = 256 + 8 * IMP_STRIDE * 4 + 128;
constexpr int WAVE_OFF = NSLOT * SLOT;
constexpr int LDS_NEED = WAVE_OFF + NWAVES * WAVE_LDS;
constexpr int QT = 8 * NWAVES;
constexpr float THR = 8.f;

__device__ __forceinline__ int crow(int r, int hi) { return (r & 3) + 8 * (r >> 2) + 4 * hi; }
__device__ __forceinline__ unsigned cvtpk(float lo, float hi) { f32x2_t v = {lo, hi}; bf16x2_t b = __builtin_convertvector(v, bf16x2_t); return __builtin_bit_cast(unsigned, b); }
__device__ __forceinline__ float ex2(float x) { return __builtin_amdgcn_exp2f(x); }

__device__ __forceinline__ void tile_dma(const unsigned char* gt, LAS unsigned char* slot, int wid, int lane) {
    const unsigned char* src = gt + wid * 2048 + lane * 16;
    __builtin_amdgcn_global_load_lds((const unsigned*)src, (LAS unsigned*)(slot + wid * 2048), 16, 0, 0);
    __builtin_amdgcn_global_load_lds((const unsigned*)(src + 1024), (LAS unsigned*)(slot + wid * 2048 + 1024), 16, 0, 0);
}
__device__ __forceinline__ void qkt(f32x16& p0, f32x16& p1, const LAS unsigned char* Kslot, const bf16x8 (&qr)[4], float cinit, int r32, int hi) {
    const LAS unsigned char* kb = Kslot + hi * 1024 + r32 * 16;
#pragma unroll
    for (int r = 0; r < 16; ++r) { p0[r] = cinit; p1[r] = cinit; }
#pragma unroll
    for (int d0 = 0; d0 < 4; ++d0) {
        const bf16x8 b0 = *(const LAS bf16x8*)(kb + d0 * 2048);
        const bf16x8 b1 = *(const LAS bf16x8*)(kb + d0 * 2048 + 512);
        p0 = __builtin_amdgcn_mfma_f32_32x32x16_bf16(b0, qr[d0], p0, 0, 0, 0);
        p1 = __builtin_amdgcn_mfma_f32_32x32x16_bf16(b1, qr[d0], p1, 0, 0, 0);
    }
}
struct VFrag { s16x4 lo[2][4], hi[2][4]; };
__device__ __forceinline__ void pv_read(VFrag& v, int vb) {
#pragma unroll
    for (int d0 = 0; d0 < 2; ++d0)
#pragma unroll
        for (int ks = 0; ks < 4; ++ks) {
            asm volatile("ds_read_b64_tr_b16 %0,%1 offset:%c2" : "=&v"(v.lo[d0][ks]) : "v"(vb), "i"(d0 * 4096 + ks * 1024) : "memory");
            asm volatile("ds_read_b64_tr_b16 %0,%1 offset:%c2" : "=&v"(v.hi[d0][ks]) : "v"(vb), "i"(d0 * 4096 + ks * 1024 + 512) : "memory");
        }
}
__device__ __forceinline__ void pv_mma(f32x16 (&o)[2], VFrag& v, bf16x8 pa0, bf16x8 pa1, bf16x8 pa2, bf16x8 pa3) {
    asm volatile("s_waitcnt lgkmcnt(0)" : "+v"(v.lo[0][0]), "+v"(v.lo[0][1]), "+v"(v.lo[0][2]), "+v"(v.lo[0][3]), "+v"(v.hi[0][0]), "+v"(v.hi[0][1]), "+v"(v.hi[0][2]), "+v"(v.hi[0][3]) :: "memory");
    asm volatile("" : "+v"(v.lo[1][0]), "+v"(v.lo[1][1]), "+v"(v.lo[1][2]), "+v"(v.lo[1][3]), "+v"(v.hi[1][0]), "+v"(v.hi[1][1]), "+v"(v.hi[1][2]), "+v"(v.hi[1][3]));
#pragma unroll
    for (int d0 = 0; d0 < 2; ++d0) {
#define ATT_PK(k) (bf16x8){v.lo[d0][k][0], v.lo[d0][k][1], v.lo[d0][k][2], v.lo[d0][k][3], v.hi[d0][k][0], v.hi[d0][k][1], v.hi[d0][k][2], v.hi[d0][k][3]}
        o[d0] = __builtin_amdgcn_mfma_f32_32x32x16_bf16(pa0, ATT_PK(0), o[d0], 0, 0, 0);
        o[d0] = __builtin_amdgcn_mfma_f32_32x32x16_bf16(pa1, ATT_PK(1), o[d0], 0, 0, 0);
        o[d0] = __builtin_amdgcn_mfma_f32_32x32x16_bf16(pa2, ATT_PK(2), o[d0], 0, 0, 0);
        o[d0] = __builtin_amdgcn_mfma_f32_32x32x16_bf16(pa3, ATT_PK(3), o[d0], 0, 0, 0);
#undef ATT_PK
    }
}
__device__ __forceinline__ float max3f(float a, float b, float c) { float r; asm("v_max3_f32 %0, %1, %2, %3" : "=v"(r) : "v"(a), "v"(b), "v"(c)); return r; }
__device__ __forceinline__ float max32(const f32x16& p0, const f32x16& p1) {
    float a = max3f(p0[0], p0[1], p1[0]), b = max3f(p0[2], p0[3], p1[1]); a = max3f(a, p1[2], p1[3]);
#pragma unroll
    for (int r = 4; r < 16; r += 4) { a = max3f(a, p0[r], p0[r + 1]); b = max3f(b, p0[r + 2], p0[r + 3]); a = max3f(a, p1[r], p1[r + 1]); b = max3f(b, p1[r + 2], p1[r + 3]); }
    a = fmaxf(a, b);
    return fmaxf(a, __shfl_xor(a, 32));
}
__device__ __forceinline__ void pack_p(const f32x16& p0, const f32x16& p1, bf16x8& a0, bf16x8& a1, bf16x8& a2, bf16x8& a3) {
    u32x4 w0 = {cvtpk(p0[0], p0[1]), cvtpk(p0[2], p0[3]), cvtpk(p0[4], p0[5]), cvtpk(p0[6], p0[7])};
    u32x4 w1 = {cvtpk(p0[8], p0[9]), cvtpk(p0[10], p0[11]), cvtpk(p0[12], p0[13]), cvtpk(p0[14], p0[15])};
    u32x4 w2 = {cvtpk(p1[0], p1[1]), cvtpk(p1[2], p1[3]), cvtpk(p1[4], p1[5]), cvtpk(p1[6], p1[7])};
    u32x4 w3 = {cvtpk(p1[8], p1[9]), cvtpk(p1[10], p1[11]), cvtpk(p1[12], p1[13]), cvtpk(p1[14], p1[15])};
    a0 = __builtin_bit_cast(bf16x8, w0); a1 = __builtin_bit_cast(bf16x8, w1); a2 = __builtin_bit_cast(bf16x8, w2); a3 = __builtin_bit_cast(bf16x8, w3);
}
__device__ __forceinline__ void bcast_rows(LAS float* wsf, float v, int r32, int hi, float (&f)[16]) {
    if (hi == 0) wsf[r32] = v;
    asm volatile("s_waitcnt lgkmcnt(0)" ::: "memory");
#pragma unroll
    for (int r = 0; r < 16; ++r) f[r] = wsf[crow(r, hi)];
    asm volatile("s_waitcnt lgkmcnt(0)" ::: "memory");
}

template <int MODE, class PreF, class MaskF>
__device__ __forceinline__ void flash_pass(LAS unsigned char* lds, LAS float* wsf, LAS float* imp, const unsigned char* img, int t_lo, int t_hi,
                                           const bf16x8 (&qr)[4], PreF pref, MaskF maskf, float& m, float& l, f32x16 (&o)[2], int r32, int hi) {
    if (t_lo > t_hi) return;
    const int tid = tidx(), wid = __builtin_amdgcn_readfirstlane(tid >> 6), lane = tid & 63;
    const int ngroups = (t_hi - t_lo + GROUP) / GROUP;
    for (int tt = 0; tt < GROUP; ++tt) if (t_lo + tt <= t_hi) tile_dma(img + (size_t)(t_lo + tt) * SLOT, lds + tt * SLOT, wid, lane);
    asm volatile("s_waitcnt vmcnt(0)" ::: "memory");
    __syncthreads();
    const int vbl = (int)(unsigned)(uintptr_t)(lds + 8192) + ((tid >> 4) & 1) * 32 + (tid & 3) * 8 + (4 * hi + ((tid & 15) >> 2)) * 64;
    float carry_prev = 0.f; bool fresh = (MODE != 1);
    for (int gi = 0; gi < ngroups; ++gi) {
        const int half = (gi & 1) * GROUP;
        if (gi + 1 < ngroups) {
            for (int tt = 0; tt < GROUP; ++tt) { const int t = t_lo + (gi + 1) * GROUP + tt; if (t <= t_hi) tile_dma(img + (size_t)t * SLOT, lds + ((GROUP - half) + tt) * SLOT, wid, lane); }
        }
#pragma unroll 1
        for (int tt = 0; tt < GROUP; ++tt) {
            const int t = t_lo + gi * GROUP + tt;
            if (t > t_hi) break;
            bool sel = true;
            const bool act = pref(t, sel);
            if (!act) { if (MODE == 1) carry_prev = 0.f; continue; }
            LAS unsigned char* buf = lds + (half + tt) * SLOT;
            f32x16 p0, p1;
            qkt(p0, p1, buf, qr, sel ? -m : -__builtin_inff(), r32, hi);
            VFrag vf;
            if (MODE != 0) pv_read(vf, vbl + (half + tt) * SLOT);
            maskf(t, p0, p1);
            if (MODE == 0 || MODE == 2) {
                const float rm = max32(p0, p1);
                const float dl = ((fresh || rm > THR) && rm > -3.0e38f) ? rm : 0.f;
                if (__any(dl != 0.f)) {
#pragma unroll
                    for (int r = 0; r < 16; ++r) { p0[r] -= dl; p1[r] -= dl; }
                    m += dl; const float alpha = ex2(-dl); l *= alpha;
                    if (MODE == 2 && !fresh) {
                        float f[16]; bcast_rows(wsf, alpha, r32, hi, f);
#pragma unroll
                        for (int r = 0; r < 16; ++r) { o[0][r] *= f[r]; o[1][r] *= f[r]; }
                    }
                }
                fresh = false;
                float sum = 0.f;
#pragma unroll
                for (int r = 0; r < 16; ++r) { p0[r] = ex2(p0[r]); p1[r] = ex2(p1[r]); sum += p0[r] + p1[r]; }
                l += sum;
            } else {
#pragma unroll
                for (int r = 0; r < 16; ++r) { p0[r] = ex2(p0[r]) * l; p1[r] = ex2(p1[r]) * l; }
                float a[8], cy[8];
#pragma unroll
                for (int k = 0; k < 4; ++k) {
                    a[k] = (p0[4 * k] + p0[4 * k + 1]) + (p0[4 * k + 2] + 0.5f * p0[4 * k + 3]); cy[k] = 0.5f * p0[4 * k + 3];
                    a[4 + k] = (p1[4 * k] + p1[4 * k + 1]) + (p1[4 * k + 2] + 0.5f * p1[4 * k + 3]); cy[4 + k] = 0.5f * p1[4 * k + 3];
                }
                float cx[8];
#pragma unroll
                for (int q8 = 0; q8 < 8; ++q8) cx[q8] = __shfl_xor(cy[q8], 32);
#pragma unroll
                for (int q8 = 0; q8 < 8; ++q8) {
                    float v = a[q8] + (hi ? cx[q8] : (q8 > 0 ? cx[q8 - 1] : carry_prev));
                    v += __shfl_xor(v, 1); v += __shfl_xor(v, 2);
                    if ((r32 & 3) == 0) imp[(r32 >> 2) * IMP_STRIDE + 16 * t + 2 * q8 + hi] = v;
                }
                carry_prev = cx[7];
            }
            if (MODE != 0) {
                bf16x8 a0, a1, a2, a3; pack_p(p0, p1, a0, a1, a2, a3);
                pv_mma(o, vf, a0, a1, a2, a3);
            }
        }
        asm volatile("s_waitcnt vmcnt(0)" ::: "memory");
        __syncthreads();
    }
}

__device__ __forceinline__ void nsa_unit(const Params& P, int b, int g, int t0, LAS unsigned char* lds) {
    unsigned char* ws = P.ws;
    const bf16_t* proj = (const bf16_t*)(ws + WS_PROJ);
    const int tid = tidx(), wid = tid >> 6, lane = tid & 63, r32 = lane & 31, hi = lane >> 5;
    LAS unsigned char* wl = lds + WAVE_OFF + wid * WAVE_LDS;
    LAS float* wsf = (LAS float*)wl; LAS float* imp = (LAS float*)(wl + 256); LAS unsigned* selm = (LAS unsigned*)(wl + 256 + 8 * IMP_STRIDE * 4);
    const int tq = t0 + 8 * wid + (r32 >> 2), head = g * 4 + (r32 & 3);
    const int tq_lo = __builtin_amdgcn_readfirstlane(t0 + 8 * wid);
    const size_t row = (size_t)b * S + tq;
    bf16x8 qr[4];
#pragma unroll
    for (int d0 = 0; d0 < 4; ++d0) {
        const u32x4 raw = *(const u32x4*)(proj + row * NP + Q0 + head * 64 + d0 * 16 + hi * 8);
        u32x4 sc;
        sc.x = cvtpk(__builtin_bit_cast(float, raw.x << 16) * C2, __builtin_bit_cast(float, raw.x & 0xffff0000u) * C2); sc.y = cvtpk(__builtin_bit_cast(float, raw.y << 16) * C2, __builtin_bit_cast(float, raw.y & 0xffff0000u) * C2);
        sc.z = cvtpk(__builtin_bit_cast(float, raw.z << 16) * C2, __builtin_bit_cast(float, raw.z & 0xffff0000u) * C2); sc.w = cvtpk(__builtin_bit_cast(float, raw.w << 16) * C2, __builtin_bit_cast(float, raw.w & 0xffff0000u) * C2);
        qr[d0] = __builtin_bit_cast(bf16x8, sc);
    }
    const bf16_t* gl = proj + row * NP + GL0 + head * 3;
    const float g0 = sigmoidf_(bf2f(gl[0])), g1 = sigmoidf_(bf2f(gl[1])), g2 = sigmoidf_(bf2f(gl[2]));
    f32x16 o[2], out[2];
    auto emit = [&](float fac, bool first) {
        if (hi == 0) wsf[r32] = fac;
        asm volatile("s_waitcnt lgkmcnt(0)" ::: "memory");
#pragma unroll
        for (int r = 0; r < 16; ++r) {
            const float f = wsf[crow(r, hi)];
            if (first) { out[0][r] = o[0][r] * f; out[1][r] = o[1][r] * f; } else { out[0][r] += o[0][r] * f; out[1][r] += o[1][r] * f; }
        }
        asm volatile("s_waitcnt lgkmcnt(0)" ::: "memory");
    };
    const float NINF = -__builtin_inff();
    auto pre_all = [&](int, bool&) -> bool { return true; };
    for (int i = lane; i < 8 * IMP_STRIDE; i += 64) imp[i] = 0.f;
    {
        const unsigned char* img = ws + WS_CMPI + (size_t)(b * 2 + g) * 8 * SLOT;
        const int c_hi = (t0 + QT - 32) >> 10;
        const int ivis = tq >= 31 ? ((tq - 31) >> 4) : -1;
        const int ivis_lo = tq_lo >= 31 ? ((tq_lo - 31) >> 4) : -1;
        auto maskc = [&](int t, f32x16& p0, f32x16& p1) {
            if (64 * t + 63 > ivis_lo) {
                const int kb = 64 * t + 4 * hi;
#pragma unroll
                for (int r = 0; r < 16; ++r) { const int i = kb + (r & 3) + 8 * (r >> 2); if (i > ivis) p0[r] = NINF; if (i + 32 > ivis) p1[r] = NINF; }
            }
        };
        float m = 0.f, l = 0.f;
        flash_pass<0>(lds, wsf, imp, img, 0, c_hi, qr, pre_all, maskc, m, l, o, r32, hi);
        l += __shfl_xor(l, 32);
        float linv = l > 0.f ? 1.f / l : 0.f;
        o[0] = (f32x16){0.f}; o[1] = (f32x16){0.f};
        flash_pass<1>(lds, wsf, imp, img, 0, c_hi, qr, pre_all, maskc, m, linv, o, r32, hi);
        emit(g0, true);
    }
    unsigned sw0, sw1, sw2, sw3;
    {
        const int tok = lane >> 3, sub = lane & 7, tqs = t0 + 8 * wid + tok, cur = tqs >> 6;
        float val[16];
#pragma unroll
        for (int e = 0; e < 16; ++e) {
            const int j = 8 * e + sub; float x = imp[tok * IMP_STRIDE + j];
            if (j * 64 > tqs) x = -1.0e30f; else if (j == 0 || j == cur || j == cur - 1) x = 1.0e9f;
            val[e] = x;
        }
        unsigned m0 = 0u, m1 = 0u, m2 = 0u, m3 = 0u;
#pragma unroll 1
        for (int r = 0; r < 16; ++r) {
            float bv = val[0]; int bj = sub;
#pragma unroll
            for (int e = 1; e < 16; ++e) if (val[e] > bv) { bv = val[e]; bj = 8 * e + sub; }
#pragma unroll
            for (int o2 = 1; o2 < 8; o2 <<= 1) { const float ov = __shfl_xor(bv, o2); const int oj = __shfl_xor(bj, o2); if (ov > bv || (ov == bv && oj < bj)) { bv = ov; bj = oj; } }
            if (bv > -1.0e29f) {
                const unsigned bit = 1u << (bj & 31); const int wq = bj >> 5;
                m0 |= wq == 0 ? bit : 0u; m1 |= wq == 1 ? bit : 0u; m2 |= wq == 2 ? bit : 0u; m3 |= wq == 3 ? bit : 0u;
#pragma unroll
                for (int e = 0; e < 16; ++e) if (bj == 8 * e + sub) val[e] = -3.0e38f;
            }
        }
        if (sub == 0) { selm[tok * 4 + 0] = m0; selm[tok * 4 + 1] = m1; selm[tok * 4 + 2] = m2; selm[tok * 4 + 3] = m3; }
        asm volatile("s_waitcnt lgkmcnt(0)" ::: "memory");
        sw0 = selm[(r32 >> 2) * 4 + 0]; sw1 = selm[(r32 >> 2) * 4 + 1]; sw2 = selm[(r32 >> 2) * 4 + 2]; sw3 = selm[(r32 >> 2) * 4 + 3];
        asm volatile("s_waitcnt lgkmcnt(0)" ::: "memory");
    }
    {
        const unsigned char* img = ws + WS_KVI + (size_t)((0 * NB + b) * 2 + g) * (S / 64) * SLOT;
        auto pres = [&](int t, bool& sel) -> bool {
            const unsigned w = t < 32 ? sw0 : (t < 64 ? sw1 : (t < 96 ? sw2 : sw3));
            sel = (w >> (t & 31)) & 1u;
            return __any(sel);
        };
        auto masks = [&](int t, f32x16& p0, f32x16& p1) {
            if (64 * t + 63 > tq_lo) {
                const int kb0 = 64 * t + 4 * hi;
#pragma unroll
                for (int r = 0; r < 16; ++r) { const int pos = kb0 + (r & 3) + 8 * (r >> 2); if (pos > tq) p0[r] = NINF; if (pos + 32 > tq) p1[r] = NINF; }
            }
        };
        float m = 0.f, l = 0.f; o[0] = (f32x16){0.f}; o[1] = (f32x16){0.f};
        flash_pass<2>(lds, wsf, imp, img, 0, (t0 + QT - 1) >> 6, qr, pres, masks, m, l, o, r32, hi);
        l += __shfl_xor(l, 32);
        emit(l > 0.f ? g1 / l : 0.f, false);
    }
    {
        const unsigned char* img = ws + WS_KVI + (size_t)((1 * NB + b) * 2 + g) * (S / 64) * SLOT;
        auto maskw = [&](int t, f32x16& p0, f32x16& p1) {
            if (64 * t + 63 > tq_lo || 64 * t < tq_lo + 7 - 511) {
                const int kb0 = 64 * t + 4 * hi;
#pragma unroll
                for (int r = 0; r < 16; ++r) { const int pos = kb0 + (r & 3) + 8 * (r >> 2); if (pos > tq || pos < tq - 511) p0[r] = NINF; if (pos + 32 > tq || pos + 32 < tq - 511) p1[r] = NINF; }
            }
        };
        float m = 0.f, l = 0.f; o[0] = (f32x16){0.f}; o[1] = (f32x16){0.f};
        const int lo = t0 - 511 > 0 ? (t0 - 511) >> 6 : 0;
        flash_pass<2>(lds, wsf, imp, img, lo, (t0 + QT - 1) >> 6, qr, pre_all, maskw, m, l, o, r32, hi);
        l += __shfl_xor(l, 32);
        emit(l > 0.f ? g2 / l : 0.f, false);
    }
    bf16_t* on = (bf16_t*)(ws + WS_ONSA) + ((size_t)b * S + t0 + 8 * wid) * 512 + g * 256 + r32;
#pragma unroll
    for (int r = 0; r < 16; ++r) {
        const int q = crow(r, hi); bf16_t* op = on + (size_t)(q >> 2) * 512 + (q & 3) * 64;
        op[0] = (bf16_t)f2bf(out[0][r]); op[32] = (bf16_t)f2bf(out[1][r]);
    }
}
}

template <int CTRL> __device__ __forceinline__ float dppf(float v) { return __builtin_bit_cast(float, __builtin_amdgcn_update_dpp(0, __builtin_bit_cast(int, v), CTRL, 0xf, 0xf, true)); }
__device__ __forceinline__ float sum16(float v) { v += dppf<0x128>(v); v += dppf<0x124>(v); v += dppf<0x122>(v); v += dppf<0x121>(v); return v; }
struct ScanRegs { f32x4 w0, w1; u32x4 kk, ka, k, r; unsigned v; };
__device__ __forceinline__ f32x4 bflo(u32x4 u) { return (f32x4){__builtin_bit_cast(float, u.x << 16), __builtin_bit_cast(float, u.x & 0xffff0000u), __builtin_bit_cast(float, u.y << 16), __builtin_bit_cast(float, u.y & 0xffff0000u)}; }
__device__ __forceinline__ f32x4 bfhi(u32x4 u) { return (f32x4){__builtin_bit_cast(float, u.z << 16), __builtin_bit_cast(float, u.z & 0xffff0000u), __builtin_bit_cast(float, u.w << 16), __builtin_bit_cast(float, u.w & 0xffff0000u)}; }
__device__ __forceinline__ void rwkv_scan_unit(const Params& P, int b, int h, int qr, int unit, float* sm  ) {
    unsigned char* ws = P.ws;
    const int tid = tidx(); const bool comp = tid < 256;
    const int rowl = (tid & 255) >> 4, l16 = tid & 15;
    const int lst = (tid & 255) >> 3, j8 = tid & 7;
    float s0 = 0.f, s1 = 0.f, s2 = 0.f, s3 = 0.f;
    const float* Ww = (const float*)(ws + WS_RW_W);
    const bf16_t* Rr = (const bf16_t*)(ws + WS_RW_R); const bf16_t* Kk = (const bf16_t*)(ws + WS_RW_K); const bf16_t* Vv = (const bf16_t*)(ws + WS_RW_V);
    const bf16_t* KK = (const bf16_t*)(ws + WS_RW_KK); const bf16_t* KA = (const bf16_t*)(ws + WS_RW_KKA);
    float* Y = (float*)(ws + WS_Y);
    constexpr int SR = 336, CH = 32 * SR;
    auto gload = [&](ScanRegs& R, int t0) {
        const size_t base = ((size_t)b * S + t0 + lst) * 512 + h * 64 + 8 * j8;
        R.w0 = *(const f32x4*)(Ww + base); R.w1 = *(const f32x4*)(Ww + base + 4); R.kk = *(const u32x4*)(KK + base); R.ka = *(const u32x4*)(KA + base);
        R.k = *(const u32x4*)(Kk + base); R.r = *(const u32x4*)(Rr + base); R.v = *(const unsigned*)(Vv + base - 8 * j8 + qr * 16 + 2 * j8);
    };
    auto lstore = [&](const ScanRegs& R, float* buf) {
        float* q = buf + lst * SR + 8 * j8;
        *(f32x4*)q = R.w0; *(f32x4*)(q + 4) = R.w1; *(f32x4*)(q + 64) = bflo(R.kk); *(f32x4*)(q + 68) = bfhi(R.kk); *(f32x4*)(q + 128) = bflo(R.ka); *(f32x4*)(q + 132) = bfhi(R.ka);
        *(f32x4*)(q + 192) = bflo(R.k); *(f32x4*)(q + 196) = bfhi(R.k); *(f32x4*)(q + 256) = bflo(R.r); *(f32x4*)(q + 260) = bfhi(R.r);
        buf[lst * SR + 320 + 2 * j8] = __builtin_bit_cast(float, R.v << 16); buf[lst * SR + 321 + 2 * j8] = __builtin_bit_cast(float, R.v & 0xffff0000u);
    };
    typedef float f2 __attribute__((ext_vector_type(2)));
    auto compute16 = [&](const float* buf) -> float {
        const float* q0 = buf + l16 * 4; const float* qv = buf + 320 + rowl;
        f2 sa_ = {s0, s1}, sb_ = {s2, s3};
        f32x4 w = *(const f32x4*)(q0), kk = *(const f32x4*)(q0 + 64), ka = *(const f32x4*)(q0 + 128), k = *(const f32x4*)(q0 + 192), r = *(const f32x4*)(q0 + 256);
        float v = qv[0];
        float ep[16];
#pragma unroll
        for (int st = 0; st < 16; ++st) {
            f32x4 wn, kkn, kan, kn, rn; float vn;
            if (st < 15) { const float* q = q0 + (st + 1) * SR; wn = *(const f32x4*)(q); kkn = *(const f32x4*)(q + 64); kan = *(const f32x4*)(q + 128); kn = *(const f32x4*)(q + 192); rn = *(const f32x4*)(q + 256); vn = qv[(st + 1) * SR]; }
            const f2 d = sa_ * (f2){kk.x, kk.y} + sb_ * (f2){kk.z, kk.w};
            const float sa = -sum16(d.x + d.y);
            const f2 vv = {v, v}, ss = {sa, sa};
            const f2 ta = sa_ * (f2){w.x, w.y} + vv * (f2){k.x, k.y}, tb = sb_ * (f2){w.z, w.w} + vv * (f2){k.z, k.w};
            sa_ = ta + ss * (f2){ka.x, ka.y}; sb_ = tb + ss * (f2){ka.z, ka.w};
            const f2 e = sa_ * (f2){r.x, r.y} + sb_ * (f2){r.z, r.w};
            ep[st] = e.x + e.y;
            asm volatile("" : "+v"(ep[st]));
            if (st < 15) { w = wn; kk = kkn; ka = kan; k = kn; r = rn; v = vn; }
        }
        s0 = sa_.x; s1 = sa_.y; s2 = sb_.x; s3 = sb_.y;
        const bool b3 = (l16 & 8) != 0, b2 = (l16 & 4) != 0, b1 = (l16 & 2) != 0, b0 = (l16 & 1) != 0;
        float e8[8], e4[4], e2[2];
#pragma unroll
        for (int i = 0; i < 8; ++i) { const float keep = b3 ? ep[i + 8] : ep[i], send = b3 ? ep[i] : ep[i + 8]; e8[i] = keep + dppf<0x128>(send); }
#pragma unroll
        for (int i = 0; i < 4; ++i) { const float keep = b2 ? e8[i + 4] : e8[i], send = b2 ? e8[i] : e8[i + 4]; e4[i] = keep + dppf<0x141>(send); }
#pragma unroll
        for (int i = 0; i < 2; ++i) { const float keep = b1 ? e4[i + 2] : e4[i], send = b1 ? e4[i] : e4[i + 2]; e2[i] = keep + dppf<0x4E>(send); }
        { const float keep = b0 ? e2[1] : e2[0], send = b0 ? e2[0] : e2[1]; return keep + dppf<0xB1>(send); }
    };
    auto ystore = [&](float yk, int t0) { Y[((size_t)b * S + t0 + l16) * 512 + h * 64 + qr * 16 + rowl] = yk; };
    float* ct = sm + 2 * CH;
    constexpr int CT = 64 * 65;
    const int lt = tid & 255, ctx = lt & 63, cty = lt >> 6, cpp = lt >> 2, ckq = lt & 3;
    float cva[16], cvb[16];
    auto conv_src = [&](int tile, const float*& src, int& nsrc, unsigned char*& dst, int& p0, int& k0, int& col) {
        if (tile < 16384) { const int e = tile >> 9, q = tile & 511; src = P.in[I_EGU] + (size_t)e * 1024 * 2048; nsrc = 2048; dst = ws + WS_GU + (size_t)e * 2048 * 1024; p0 = (q >> 4) * 64; k0 = (q & 15) * 64; col = MapGU()(p0 + ctx); }
        else { const int t2 = tile - 16384, e = t2 >> 8, q = t2 & 255; src = P.in[I_EDN] + (size_t)e * 1024 * 1024; nsrc = 1024; dst = ws + WS_DN + (size_t)e * 1024 * 1024; p0 = (q >> 4) * 64; k0 = (q & 15) * 64; col = p0 + ctx; }
    };
    auto conv_load = [&](float (&cv)[16], int iv) {
        const int tile = unit * 192 + iv; if (iv >= 192 || !EXPERT_CONV_IN_SCAN) return;
        const float* src; int nsrc, p0, k0, col; unsigned char* dst; conv_src(tile, src, nsrc, dst, p0, k0, col);
#pragma unroll
        for (int i = 0; i < 16; ++i) cv[i] = src[(size_t)(k0 + cty + 4 * i) * nsrc + col];
    };
    auto conv_lds = [&](const float (&cv)[16], float* buf, int iv) {
        if (iv >= 192 || !EXPERT_CONV_IN_SCAN) return;
#pragma unroll
        for (int i = 0; i < 16; ++i) buf[(cty + 4 * i) * 65 + ctx] = cv[i];
    };
    auto conv_out = [&](const float* buf, int iv) {
        const int tile = unit * 192 + iv; if (iv >= 192 || !EXPERT_CONV_IN_SCAN) return;
        const float* src; int nsrc, p0, k0, col; unsigned char* dst; conv_src(tile, src, nsrc, dst, p0, k0, col);
        const float* tp = buf + (16 * ckq) * 65 + cpp;
        u32x4 o0;
        o0.x = pk4f8(32.f * tp[0], 32.f * tp[65], 32.f * tp[2 * 65], 32.f * tp[3 * 65]); o0.y = pk4f8(32.f * tp[4 * 65], 32.f * tp[5 * 65], 32.f * tp[6 * 65], 32.f * tp[7 * 65]);
        o0.z = pk4f8(32.f * tp[8 * 65], 32.f * tp[9 * 65], 32.f * tp[10 * 65], 32.f * tp[11 * 65]); o0.w = pk4f8(32.f * tp[12 * 65], 32.f * tp[13 * 65], 32.f * tp[14 * 65], 32.f * tp[15 * 65]);
        *(u32x4*)(dst + (size_t)(p0 + cpp) * 1024 + k0 + 16 * ckq) = o0;
    };
    ScanRegs RA, RB;
    __syncthreads();
    if (!comp) { gload(RA, 0); lstore(RA, sm); gload(RA, 32); gload(RB, 64); conv_load(cva, 0); conv_load(cvb, 1); }
    __syncthreads();
    if (comp) __builtin_amdgcn_s_setprio(3);
    for (int c = 0; c < S / 32; c += 2) {
        if (comp) { const float y0 = compute16(sm), y1 = compute16(sm + 16 * SR); ystore(y0, 32 * c); ystore(y1, 32 * c + 16); }
        else { lstore(RA, sm + CH); if (32 * (c + 3) < S) gload(RA, 32 * (c + 3)); conv_lds(cva, ct, c); }
        __syncthreads();
        if (comp) { const float y2 = compute16(sm + CH), y3 = compute16(sm + CH + 16 * SR); ystore(y2, 32 * (c + 1)); ystore(y3, 32 * (c + 1) + 16); }
        else { if (32 * (c + 2) < S) lstore(RB, sm); if (32 * (c + 4) < S) gload(RB, 32 * (c + 4)); conv_out(ct, c); conv_load(cva, c + 2); conv_lds(cvb, ct + CT, c + 1); }
        __syncthreads();
        if (!comp) { conv_out(ct + CT, c + 1); conv_load(cvb, c + 3); }
    }
    __builtin_amdgcn_s_setprio(0);
    __syncthreads();
}

__device__ __forceinline__ void phase5(const Params& P, LAS unsigned char* lds, float* ldsf) {
    constexpr int U_SCAN = NB * 8 * 4, U_ATT = NB * 2 * (S / att::QT);
    for (int u = blockIdx.x; u < U_SCAN; u += gridDim.x) rwkv_scan_unit(P, u >> 5, (u >> 2) & 7, u & 3, u, ldsf);
    unsigned* qhead = (unsigned*)(P.ws + WS_CTL) + 64;
    LAS int* slot = (LAS int*)(lds + LDS_RING + 64);
    for (;;) {
        __syncthreads();
        if (tidx() == 0) *slot = (int)atomicAdd(qhead, 1u);
        __syncthreads();
        const int a = *slot;
        if (a >= U_ATT) break;
        const int qt = (S / att::QT - 1) - (a >> 3), b = (a >> 1) & 3, g = a & 1;
        att::nsa_unit(P, b, g, qt * att::QT, lds);
    }
}


__device__ __forceinline__ void phase6(const Params& P) {
    unsigned char* ws = P.ws;
    const int lane = tidx() & 63, gw = blockIdx.x * NWAVES + (tidx() >> 6), ngw = gridDim.x * NWAVES, c0 = 8 * lane;
    bf16_t* amix = (bf16_t*)(ws + WS_RA);
    float gn[8], lw[8], lb[8], rk[8];
#pragma unroll
    for (int i = 0; i < 8; ++i) { gn[i] = P.in[I_NSANORM][c0 + i]; lw[i] = P.in[I_LNW][c0 + i]; lb[i] = P.in[I_LNB][c0 + i]; rk[i] = P.in[I_RK][c0 + i]; }
    for (int row = gw; row < T; row += ngw) {
        const size_t o = (size_t)row * 512 + c0;
        const u32x4 n8 = *(const u32x4*)((const bf16_t*)(ws + WS_ONSA) + o);
        const f32x4 y0 = *(const f32x4*)((const float*)(ws + WS_Y) + o), y1 = *(const f32x4*)((const float*)(ws + WS_Y) + o + 4);
        const u32x4 r8 = *(const u32x4*)((const bf16_t*)(ws + WS_RW_R) + o), k8 = *(const u32x4*)((const bf16_t*)(ws + WS_RW_K) + o), v8 = *(const u32x4*)((const bf16_t*)(ws + WS_RW_V) + o), g8 = *(const u32x4*)((const bf16_t*)(ws + WS_RW_G) + o);
        float nv[8]; unpack8(n8, nv); const float yv[8] = {y0.x, y0.y, y0.z, y0.w, y1.x, y1.y, y1.z, y1.w};
        float s = 0.f;
#pragma unroll
        for (int i = 0; i < 8; ++i) s += nv[i] * nv[i];
        const float rstd = rsqrtf(wave_sum(s) * (1.f / 512.f) + 1e-6f);
        float on[8];
#pragma unroll
        for (int i = 0; i < 8; ++i) on[i] = nv[i] * rstd * gn[i];
        *(u32x4*)(amix + (size_t)row * D + c0) = pack8(on);
        float rr[8], kk[8], vv[8], gg[8]; unpack8(r8, rr); unpack8(k8, kk); unpack8(v8, vv); unpack8(g8, gg);
        float sm = 0.f, bs = 0.f;
#pragma unroll
        for (int i = 0; i < 8; ++i) { sm += yv[i]; bs += rr[i] * kk[i] * rk[i]; }
        sm += __shfl_xor(sm, 1); sm += __shfl_xor(sm, 2); sm += __shfl_xor(sm, 4);
        bs += __shfl_xor(bs, 1); bs += __shfl_xor(bs, 2); bs += __shfl_xor(bs, 4);
        const float mean = sm * (1.f / 64.f); float vs = 0.f;
#pragma unroll
        for (int i = 0; i < 8; ++i) { const float d = yv[i] - mean; vs += d * d; }
        vs += __shfl_xor(vs, 1); vs += __shfl_xor(vs, 2); vs += __shfl_xor(vs, 4);
        const float rs = rsqrtf(vs * (1.f / 64.f) + 64e-5f);
        float oo[8];
#pragma unroll
        for (int i = 0; i < 8; ++i) oo[i] = ((yv[i] - mean) * rs * lw[i] + lb[i] + bs * vv[i]) * gg[i];
        *(u32x4*)(amix + (size_t)row * D + 512 + c0) = pack8(oo);
    }
}

struct EpiF32 {
    float* C; int ldc;
    __device__ __forceinline__ void operator()(const f32x4 (&acc)[2][2][4][2], const g8::Unit& u, int wr, int wc, int fr, int fq) const {
        const int row0 = u.x0 * 256 + wr * 64 + fr, col0 = u.x1 * 256 + wc * 32 + 4 * fq;
#pragma unroll
        for (int ai = 0; ai < 2; ++ai)
#pragma unroll
            for (int m = 0; m < 4; ++m) { float* rowp = C + (size_t)(row0 + ai * 128 + m * 16) * ldc + col0;
#pragma unroll
                for (int bj = 0; bj < 2; ++bj)
#pragma unroll
                    for (int n = 0; n < 2; ++n) *(f32x4*)(rowp + bj * 128 + n * 16) = acc[ai][bj][m][n]; }
    }
};
__device__ __forceinline__ void phase7(const Params& P, LAS unsigned char* lds) {
    unsigned char* ws = P.ws;
    SchedDense Sd{(const bf16_t*)(ws + WS_RA), (const bf16_t*)(ws + WS_WOUT), D, D, T / 256, D / 256};
    EpiBf16 E{(bf16_t*)(ws + WS_MIXED), D};
    g8::gemm_phase<true>(lds, D, D, Sd, E);
}

constexpr int LGS = 33;
__device__ __forceinline__ void phase9f(const Params& P, LAS unsigned char* lds) {
    unsigned char* ws = P.ws;
    const int tid = tidx(), wid = tid >> 6, lane = tid & 63;
    const float* ada = (const float*)(ws + WS_ADA);
    unsigned* cnt = (unsigned*)(ws + WS_CTL);
    LAS float* Wl = (LAS float*)lds;
    auto lgrow = [&](int tok) -> LAS float* { return tok < 62 ? (LAS float*)(lds + 131072) + tok * LGS : (LAS float*)(lds + LDS_RING + 1024) + (tok - 62) * LGS; };
    LAS unsigned* lcnt = (LAS unsigned*)(lds + LDS_RING + 1024 + 66 * LGS * 4);
    static_assert(131072 + 62 * LGS * 4 <= LDS_RING && LDS_RING + 1024 + 66 * LGS * 4 + 256 <= LDS_TOTAL, "phase 9 LDS layout");
    for (int q = tid; q < 8192; q += NTHREADS) {
        const int c = q >> 3, eq = q & 7; const f32x4 w = *(const f32x4*)(P.in[I_RW] + c * 32 + 4 * eq);
        *(LAS f32x4*)(Wl + ((((c >> 8) * 4 + (c & 3)) * 8 + eq) * 64 + ((c >> 2) & 63)) * 4) = w;
    }
    const bool b5 = (lane & 32) != 0, b4 = (lane & 16) != 0, b3 = (lane & 8) != 0, b2 = (lane & 4) != 0, b1 = (lane & 2) != 0, b0 = (lane & 1) != 0;
    for (int blk = blockIdx.x; blk < T / 128; blk += gridDim.x) {
        __syncthreads();
        if (tid < 64) lcnt[tid] = 0u;
        for (int pr = 0; pr < 8; ++pr) {
            float hh[2][16];
#pragma unroll
            for (int tk = 0; tk < 2; ++tk) {
                const int row = blk * 128 + wid * 16 + pr * 2 + tk, b = row / S;
                const u32x2* mr = (const u32x2*)((const bf16_t*)(ws + WS_MIXED) + (size_t)row * D) + lane;
                const f32x4* xr = (const f32x4*)(P.in[I_X] + (size_t)row * D) + lane;
                f32x4 m[4]; float sq = 0.f;
#pragma unroll
                for (int j = 0; j < 4; ++j) { const u32x2 w = mr[64 * j]; m[j] = (f32x4){__builtin_bit_cast(float, w.x << 16), __builtin_bit_cast(float, w.x & 0xffff0000u), __builtin_bit_cast(float, w.y << 16), __builtin_bit_cast(float, w.y & 0xffff0000u)};
                    sq += m[j].x * m[j].x + m[j].y * m[j].y + m[j].z * m[j].z + m[j].w * m[j].w; }
                const float rstd = rsqrtf(wave_sum(sq) * (1.f / D) + 1e-6f);
                f32x4 x1[4]; float s2 = 0.f;
#pragma unroll
                for (int j = 0; j < 4; ++j) {
                    const int c = 4 * (lane + 64 * j);
                    const f32x4 g = *(const f32x4*)(P.in[I_MIXPOST] + c), gm = *(const f32x4*)(ada + b * 6144 + 2048 + c);
                    x1[j] = xr[64 * j] + gm * (m[j] * rstd * g);
                    s2 += x1[j].x * x1[j].x + x1[j].y * x1[j].y + x1[j].z * x1[j].z + x1[j].w * x1[j].w;
                    ((f32x4*)((float*)(ws + WS_X1) + (size_t)row * D))[lane + 64 * j] = x1[j];
                }
                const float rstd2 = rsqrtf(wave_sum(s2) * (1.f / D) + 1e-6f);
#pragma unroll
                for (int j = 0; j < 4; ++j) {
                    const int c = 4 * (lane + 64 * j);
                    const f32x4 g = *(const f32x4*)(P.in[I_FFNPRE] + c), sh = *(const f32x4*)(ada + b * 6144 + 3072 + c), sc = *(const f32x4*)(ada + b * 6144 + 4096 + c);
                    const f32x4 h = x1[j] * rstd2 * g * (sc + 1.f) + sh;
                    hh[tk][4 * j] = h.x; hh[tk][4 * j + 1] = h.y; hh[tk][4 * j + 2] = h.z; hh[tk][4 * j + 3] = h.w;
                    ((unsigned*)(ws + WS_H8 + (size_t)row * 1024))[lane + 64 * j] = pk4f8(__builtin_amdgcn_fmed3f(h.x, -448.f, 448.f), __builtin_amdgcn_fmed3f(h.y, -448.f, 448.f), __builtin_amdgcn_fmed3f(h.z, -448.f, 448.f), __builtin_amdgcn_fmed3f(h.w, -448.f, 448.f));
                }
            }
            typedef float f2 __attribute__((ext_vector_type(2)));
            f2 ac[2][16];
#pragma unroll
            for (int v = 0; v < 16; ++v) { ac[0][v] = (f2){0.f, 0.f}; ac[1][v] = (f2){0.f, 0.f}; }
            const LAS f32x4* wp = (const LAS f32x4*)Wl + lane;
            f32x4 wa[4], wb[4];
#define P9_LDW(dst, g) do { _Pragma("unroll") for (int q = 0; q < 4; ++q) dst[q] = wp[((g) * 4 + q) * 64]; } while (0)
#define P9_FMW(src, g) do { const float h0 = hh[0][(g) >> 1], h1 = hh[1][(g) >> 1]; _Pragma("unroll") for (int q = 0; q < 4; ++q) { const int eq = 4 * ((g) & 1) + q; const f2 w01 = {src[q].x, src[q].y}, w23 = {src[q].z, src[q].w}; \
                ac[0][2 * eq] += w01 * h0; ac[0][2 * eq + 1] += w23 * h0; ac[1][2 * eq] += w01 * h1; ac[1][2 * eq + 1] += w23 * h1; } } while (0)
            P9_LDW(wa, 0);
#pragma unroll
            for (int g = 0; g < 32; g += 2) {
                P9_LDW(wb, g + 1); __builtin_amdgcn_sched_barrier(0);
                P9_FMW(wa, g); __builtin_amdgcn_sched_barrier(0);
                if (g + 2 < 32) P9_LDW(wa, g + 2);
                __builtin_amdgcn_sched_barrier(0);
                P9_FMW(wb, g + 1); __builtin_amdgcn_sched_barrier(0);
            }
#undef P9_LDW
#undef P9_FMW
            float a64[64];
#pragma unroll
            for (int v = 0; v < 16; ++v) { a64[2 * v] = ac[0][v].x; a64[2 * v + 1] = ac[0][v].y; a64[32 + 2 * v] = ac[1][v].x; a64[32 + 2 * v + 1] = ac[1][v].y; }
            float a32[32], a16[16], a8[8], a4[4], a2[2];
#pragma unroll
            for (int i = 0; i < 32; ++i) { const float keep = b5 ? a64[i + 32] : a64[i], send = b5 ? a64[i] : a64[i + 32]; a32[i] = keep + __shfl_xor(send, 32); }
#pragma unroll
            for (int i = 0; i < 16; ++i) { const float keep = b4 ? a32[i + 16] : a32[i], send = b4 ? a32[i] : a32[i + 16]; a16[i] = keep + __shfl_xor(send, 16); }
#pragma unroll
            for (int i = 0; i < 8; ++i) { const float keep = b3 ? a16[i + 8] : a16[i], send = b3 ? a16[i] : a16[i + 8]; a8[i] = keep + __shfl_xor(send, 8); }
#pragma unroll
            for (int i = 0; i < 4; ++i) { const float keep = b2 ? a8[i + 4] : a8[i], send = b2 ? a8[i] : a8[i + 4]; a4[i] = keep + __shfl_xor(send, 4); }
#pragma unroll
            for (int i = 0; i < 2; ++i) { const float keep = b1 ? a4[i + 2] : a4[i], send = b1 ? a4[i] : a4[i + 2]; a2[i] = keep + __shfl_xor(send, 2); }
            { const float keep = b0 ? a2[1] : a2[0], send = b0 ? a2[0] : a2[1];
              lgrow(wid * 16 + pr * 2 + (lane >> 5))[lane & 31] = keep + __shfl_xor(send, 1); }
        }
        __syncthreads();
        const int t2 = tidx();
        int ti[4] = {0, 0, 0, 0}; float wv[4] = {0.f, 0.f, 0.f, 0.f}; unsigned rk[4] = {0u, 0u, 0u, 0u};
        const int row = blk * 128 + t2;
        if (t2 < 128) {
            float lg[32];
            { const LAS float* lr = lgrow(t2);
#pragma unroll
              for (int e = 0; e < 32; ++e) lg[e] = lr[e] + P.in[I_RB][e]; }
            float tv[4];
#pragma unroll
            for (int r = 0; r < 4; ++r) {
                float bv = lg[0]; int bi = 0;
#pragma unroll
                for (int e = 1; e < 32; ++e) if (lg[e] > bv) { bv = lg[e]; bi = e; }
                tv[r] = bv; ti[r] = bi;
#pragma unroll
                for (int e = 0; e < 32; ++e) if (e == bi) lg[e] = -3.0e38f;
            }
            const float e1 = __expf(tv[1] - tv[0]), e2 = __expf(tv[2] - tv[0]), e3 = __expf(tv[3] - tv[0]);
            const float inv = 1.f / (1.f + e1 + e2 + e3);
            wv[0] = inv; wv[1] = e1 * inv; wv[2] = e2 * inv; wv[3] = e3 * inv;
#pragma unroll
            for (int r = 0; r < 4; ++r) rk[r] = atomicAdd((unsigned*)(lcnt + ti[r]), 1u);
        }
        __syncthreads();
        if (t2 < 32) lcnt[32 + t2] = atomicAdd(cnt + t2, lcnt[t2]);
        __syncthreads();
        if (t2 < 128) {
#pragma unroll
            for (int r = 0; r < 4; ++r) {
                const unsigned pos = lcnt[32 + ti[r]] + rk[r];
                ((u32x2*)(ws + WS_LIST))[(size_t)ti[r] * T + pos] = (u32x2){(unsigned)(row * 4 + r), 0u};
                ((unsigned*)(ws + WS_TOKW))[row * 4 + r] = ((unsigned)ti[r] << 20) | pos;
                ((float*)(ws + WS_TOKW + 524288))[row * 4 + r] = wv[r];
            }
        }
    }
}

constexpr int MOE_TAB_OFF = LDS_RING + 256;
__device__ __forceinline__ void moe_table(const unsigned* cnt, int ntn, LAS unsigned char* lds) {
    LAS int* tab = (LAS int*)(lds + MOE_TAB_OFF);
    __syncthreads();
    if (tidx() < 64) {
        const int lane = tidx(); const int c = lane < NE ? (int)cnt[lane] : 0, m = (c + 255) >> 8;
        int inc = m;
#pragma unroll
        for (int o = 1; o < 32; o <<= 1) { const int t = __shfl_up(inc, o); if (lane >= o) inc += t; }
        if (lane < NE) { tab[lane] = (inc - m) * ntn; tab[64 + lane] = (inc - m) * 256; tab[128 + lane] = c; }
        if (lane == NE - 1) tab[NE] = inc * ntn;
    }
    __syncthreads();
}
__device__ __forceinline__ bool moe_unit(LAS unsigned char* lds, int u, int ntn, int& e, int& mt, int& nt, int& base_rows, int& ce) {
    const LAS int* tab = (const LAS int*)(lds + MOE_TAB_OFF);
    const int lane = tidx() & 63;
    if (u >= tab[NE]) return false;
    const int st = lane < NE ? tab[lane] : 0x7fffffff;
    const unsigned long long bal = __ballot(u >= st);
    e = __builtin_popcountll(bal) - 1;
    const int r = u - tab[e]; mt = r / ntn; nt = r % ntn; base_rows = tab[64 + e]; ce = tab[128 + e];
    return true;
}
struct SchedGU {
    LAS unsigned char* lds; const u32x2* list; const unsigned char* H8; const unsigned char* W;
    __device__ __forceinline__ bool next(int i, g8::Unit& u, int R0, int C0, int R1, int C1) const {
        int e, mt, nt, base, ce; if (!moe_unit(lds, (int)((blockIdx.x & 7) * (gridDim.x >> 3) + (blockIdx.x >> 3)) + i * (int)gridDim.x, 8, e, mt, nt, base, ce)) return false;
        const u32x2* le = list + (size_t)e * T;
        const int i00 = mt * 256 + R0, i01 = mt * 256 + R1, i10 = i00 + 128, i11 = i01 + 128;
        const int t00 = (int)(i00 < ce ? le[i00].x : 0u) >> 2, t01 = (int)(i01 < ce ? le[i01].x : 0u) >> 2, t10 = (int)(i10 < ce ? le[i10].x : 0u) >> 2, t11 = (int)(i11 < ce ? le[i11].x : 0u) >> 2;
        u.A = g8::uptr(H8); u.B = g8::uptr(W + ((size_t)e * 2048 + nt * 256) * 1024);
        u.va[0][0] = (unsigned)(t00 * 512 + C0) * 2u; u.va[0][1] = (unsigned)(t01 * 512 + C1) * 2u; u.va[1][0] = (unsigned)(t10 * 512 + C0) * 2u; u.va[1][1] = (unsigned)(t11 * 512 + C1) * 2u;
        u.x0 = g8::ui(base + mt * 256); u.x1 = g8::ui(nt); u.x2 = g8::ui(e); u.x3 = g8::ui(ce - mt * 256); return true;
    }
};
struct EpiGU {
    unsigned char* act; const float* bgu;
    __device__ __forceinline__ void operator()(const f32x4 (&acc)[2][2][4][2], const g8::Unit& u, int wr, int wc, int fr, int fq) const {
        const int col = u.x1 * 128 + wc * 32 + 8 * fq; const float* bg = bgu + (size_t)u.x2 * 2048 + col;
        const f32x4 bg0 = *(const f32x4*)bg, bg1 = *(const f32x4*)(bg + 4), bu0 = *(const f32x4*)(bg + 1024), bu1 = *(const f32x4*)(bg + 1028);
#pragma unroll
        for (int ai = 0; ai < 2; ++ai)
#pragma unroll
            for (int m = 0; m < 4; ++m) {
                const int r = ai * 128 + wr * 64 + m * 16 + fr;
                f32x4 o[2];
#pragma unroll
                for (int n = 0; n < 2; ++n) {
                    const f32x4 gv = acc[ai][0][m][n] + (n ? bg1 : bg0), uv = acc[ai][1][m][n] + (n ? bu1 : bu0);
#pragma unroll
                    for (int i = 0; i < 4; ++i) { const float gate = fminf(gv[i], 7.f), up = fminf(fmaxf(uv[i], -7.f), 7.f); o[n][i] = (up + 1.f) * (gate * sigmoidf_(1.702f * gate)); }
                }
                u32x2 w; w.x = pk4f8(o[0][0], o[0][1], o[0][2], o[0][3]); w.y = pk4f8(o[1][0], o[1][1], o[1][2], o[1][3]);
                *(u32x2*)(act + (size_t)(u.x0 + r) * D + col) = w;
                asm volatile("" ::: "memory");
            }
    }
};
__device__ __forceinline__ void phase9(const Params& P, LAS unsigned char* lds) {
    unsigned char* ws = P.ws;
    moe_table((const unsigned*)(ws + WS_CTL), 8, lds);
    SchedGU Sg{lds, (const u32x2*)(ws + WS_LIST), ws + WS_H8, ws + WS_GU};
    EpiGU E{ws + WS_ACT, P.in[I_EBGU]};
    g8::gemm_phase<true, true>(lds, D / 2, D / 2, Sg, E);
}
struct SchedDN {
    LAS unsigned char* lds; const unsigned char* act; const unsigned char* W;
    __device__ __forceinline__ bool next(int i, g8::Unit& u, int R0, int C0, int R1, int C1) const {
        int e, mt, nt, base, ce; if (!moe_unit(lds, (int)((blockIdx.x & 7) * (gridDim.x >> 3) + (blockIdx.x >> 3)) + i * (int)gridDim.x, 4, e, mt, nt, base, ce)) return false;
        g8::dense_unit(u, (const bf16_t*)(act + (size_t)(base + mt * 256) * D), D / 2, (const bf16_t*)(W + ((size_t)e * 1024 + nt * 256) * 1024), D / 2, 0, 0, R0, C0, R1, C1);
        u.x0 = g8::ui(base + mt * 256); u.x1 = g8::ui(nt); u.x2 = g8::ui(e); u.x3 = 0; return true;
    }
};
struct EpiDN {
    bf16_t* yk; const float* bdn;
    __device__ __forceinline__ void operator()(const f32x4 (&acc)[2][2][4][2], const g8::Unit& u, int wr, int wc, int fr, int fq) const {
        f32x4 bd[2][2];
#pragma unroll
        for (int bj = 0; bj < 2; ++bj) { const float* bp = bdn + (size_t)u.x2 * 1024 + u.x1 * 256 + bj * 128 + wc * 32 + 8 * fq; bd[bj][0] = *(const f32x4*)bp; bd[bj][1] = *(const f32x4*)(bp + 4); }
#pragma unroll
        for (int ai = 0; ai < 2; ++ai)
#pragma unroll
            for (int m = 0; m < 4; ++m) {
                bf16_t* rowp = yk + (size_t)(u.x0 + ai * 128 + wr * 64 + m * 16 + fr) * D + u.x1 * 256 + wc * 32 + 8 * fq;
#pragma unroll
                for (int bj = 0; bj < 2; ++bj) {
                    const f32x4 v0 = acc[ai][bj][m][0] + bd[bj][0], v1 = acc[ai][bj][m][1] + bd[bj][1];
                    u32x4 o; o.x = g8::cvt_pk_bf16(v0[0], v0[1]); o.y = g8::cvt_pk_bf16(v0[2], v0[3]); o.z = g8::cvt_pk_bf16(v1[0], v1[1]); o.w = g8::cvt_pk_bf16(v1[2], v1[3]);
                    *(u32x4*)(rowp + bj * 128) = o;
                }
            }
    }
};
__device__ __forceinline__ void phase10(const Params& P, LAS unsigned char* lds) {
    unsigned char* ws = P.ws;
    moe_table((const unsigned*)(ws + WS_CTL), 4, lds);
    SchedDN Sn{lds, ws + WS_ACT, ws + WS_DN};
    EpiDN E{(bf16_t*)(ws + WS_YK), P.in[I_EBDN]};
    g8::gemm_phase<true, true>(lds, D / 2, D / 2, Sn, E);
}

__device__ __forceinline__ void phase11(const Params& P, LAS unsigned char* lds) {
    unsigned char* ws = P.ws;
    const int lane = tidx() & 63, gw = blockIdx.x * NWAVES + (tidx() >> 6), ngw = gridDim.x * NWAVES;
    const float* ada = (const float*)(ws + WS_ADA);
    LAS int* ebase = (LAS int*)lds;
    if (tidx() == 0) { const unsigned* cnt = (const unsigned*)(ws + WS_CTL); int rows = 0; for (int i = 0; i < NE; ++i) { ebase[i] = rows; rows += (((int)cnt[i] + 255) >> 8) * 256; } }
    __syncthreads();
    for (int row = gw; row < T; row += ngw) {
        const int b = row / S;
        const u32x4 tp0 = *(const u32x4*)((const unsigned*)(ws + WS_TOKW) + (size_t)row * 4); const f32x4 tw0 = *(const f32x4*)((const float*)(ws + WS_TOKW + 524288) + (size_t)row * 4);
        const unsigned ep[4] = {tp0.x, tp0.y, tp0.z, tp0.w}; const float wk[4] = {tw0.x, tw0.y, tw0.z, tw0.w};
        f32x4 y[4]; float s = 0.f;
#pragma unroll
        for (int j = 0; j < 4; ++j) y[j] = (f32x4){0.f, 0.f, 0.f, 0.f};
#pragma unroll
        for (int k = 0; k < 4; ++k) {
            const size_t prow = (size_t)(ebase[ep[k] >> 20] + (int)(ep[k] & 0xfffffu));
            const u32x2* yr = (const u32x2*)((const bf16_t*)(ws + WS_YK) + prow * D);
#pragma unroll
            for (int j = 0; j < 4; ++j) { const u32x2 w = yr[lane + 64 * j];
                y[j].x += wk[k] * __builtin_bit_cast(float, w.x << 16); y[j].y += wk[k] * __builtin_bit_cast(float, w.x & 0xffff0000u); y[j].z += wk[k] * __builtin_bit_cast(float, w.y << 16); y[j].w += wk[k] * __builtin_bit_cast(float, w.y & 0xffff0000u); }
        }
#pragma unroll
        for (int j = 0; j < 4; ++j) s += y[j].x * y[j].x + y[j].y * y[j].y + y[j].z * y[j].z + y[j].w * y[j].w;
        const float rstd = rsqrtf(wave_sum(s) * (1.f / D) + 1e-6f);
#pragma unroll
        for (int j = 0; j < 4; ++j) {
            const int c = 4 * (lane + 64 * j);
            const f32x4 g = *(const f32x4*)(P.in[I_FFNPOST] + c), gf = *(const f32x4*)(ada + b * 6144 + 5120 + c);
            const f32x4 x1 = ((const f32x4*)((const float*)(ws + WS_X1) + (size_t)row * D))[lane + 64 * j];
            ((f32x4*)(P.out + (size_t)row * D))[lane + 64 * j] = x1 + gf * (y[j] * rstd * g);
        }
    }
}

#define RLX_AGENT __ATOMIC_RELAXED, __HIP_MEMORY_SCOPE_AGENT
#define XB_TMO      128
#define XB_XCNT(j)  (256  + 64 * (j))
#define XB_XSUB(j)  (1280 + 64 * (j))
#define XB_XGEN(j)  (2304 + 64 * (j))
#define XB_TOP      3328
#define XB_TOPGEN   3392
#define XCD_BAR_WORDS 3456
#define XB_SPIN_CAP (1u << 18)

__device__ __forceinline__ unsigned xb_ld(unsigned* p)              { return __hip_atomic_load(p, __ATOMIC_RELAXED, __HIP_MEMORY_SCOPE_AGENT); }
__device__ __forceinline__ unsigned xb_add(unsigned* p, unsigned v) { return __hip_atomic_fetch_add(p, v, __ATOMIC_RELAXED, __HIP_MEMORY_SCOPE_AGENT); }
__device__ __forceinline__ unsigned xb_xcc_id() { return (unsigned)__builtin_amdgcn_s_getreg((3 << 11) | 20) & 0xFu; }
#define XB_SPIN(cond, bar) do { unsigned _sp = 0; while (cond) { __builtin_amdgcn_s_sleep(1); \
    if ((++_sp & 255u) == 0u) { if (xb_ld(&(bar)[XB_TMO])) break; if (_sp > XB_SPIN_CAP) { atomicAdd(&(bar)[XB_TMO], 1u); break; } } } } while (0)

struct XcdBarrier {
    unsigned* bar; unsigned x;
    volatile LAS unsigned* st;
};

__device__ __forceinline__ XcdBarrier xcd_barrier_post(unsigned* bar, volatile LAS unsigned* st) {
    XcdBarrier b; b.bar = bar; b.x = xb_xcc_id(); b.st = st;
    if (threadIdx.x == 0) (void)xb_add(&bar[XB_XCNT(b.x)], 1u);
    return b;
}
__device__ __forceinline__ void xcd_barrier_complete(unsigned* bar, unsigned x, unsigned& nloc, unsigned& nx) {
    const unsigned G = gridDim.x * gridDim.y * gridDim.z;
    unsigned sum, cnt, mine, sp = 0u;
    for (;;) {
        sum = 0u; cnt = 0u; mine = 0u;
#pragma unroll
        for (unsigned j = 0; j < 16; ++j) { const unsigned c = xb_ld(&bar[XB_XCNT(j)]); sum += c; cnt += (c > 0u) ? 1u : 0u; mine = (j == x) ? c : mine; }
        if (sum == G) break;
        __builtin_amdgcn_s_sleep(1);
        if ((++sp & 255u) == 0u) { if (xb_ld(&bar[XB_TMO])) break; if (sp > XB_SPIN_CAP) { atomicAdd(&bar[XB_TMO], 1u); break; } }
    }
    nloc = mine > 0u ? mine : 1u; nx = cnt > 0u ? cnt : 1u;
}

__device__ __forceinline__ void xcd_barrier(const XcdBarrier& b) {
    asm volatile("s_waitcnt vmcnt(0)" ::: "memory");
    __syncthreads();
    if (threadIdx.x == 0) {
        unsigned* bar = b.bar;
        __builtin_amdgcn_s_waitcnt(0);
        unsigned nloc = b.st[0], nx = b.st[1];
        if (nloc == 0u) { xcd_barrier_complete(bar, b.x, nloc, nx); b.st[0] = nloc; b.st[1] = nx; }
        const unsigned old = xb_add(&bar[XB_XSUB(b.x)], 1u);
        const unsigned gen = old / nloc;
        if (old + 1u == (gen + 1u) * nloc) {
            __builtin_amdgcn_fence(__ATOMIC_RELEASE, "agent");
            asm volatile("s_waitcnt vmcnt(0)" ::: "memory");
            const unsigned og = xb_add(&bar[XB_TOP], 1u);
            const unsigned tg = og / nx;
            if (og + 1u == (tg + 1u) * nx) xb_add(&bar[XB_TOPGEN], 1u);
            else XB_SPIN(xb_ld(&bar[XB_TOPGEN]) == tg, bar);
            __builtin_amdgcn_fence(__ATOMIC_ACQUIRE, "agent");
            xb_add(&bar[XB_XGEN(b.x)], 1u);
            asm volatile("s_waitcnt vmcnt(0)" ::: "memory");
        } else {
            XB_SPIN(xb_ld(&bar[XB_XGEN(b.x)]) == gen, bar);
            __builtin_amdgcn_fence(__ATOMIC_ACQUIRE, "agent");
            asm volatile("s_waitcnt vmcnt(0)" ::: "memory");
        }
    }
    __syncthreads();
}


static_assert(att::LDS_NEED <= LDS_RING && g8::STAGE_BYTES <= LDS_RING, "LDS ring");
__global__ void __launch_bounds__(NTHREADS, 2) mega(Params P, int ph_lo, int ph_hi) {
    extern __shared__ __attribute__((aligned(16))) unsigned char lds_raw[];
    LAS unsigned char* lds = (LAS unsigned char*)lds_raw;
    float* ldsf = (float*)lds_raw;
    cg::grid_group grid = cg::this_grid();
    LAS unsigned* bst = (LAS unsigned*)(lds + LDS_RING);
    if (threadIdx.x < 2) bst[threadIdx.x] = 0u;
    __syncthreads();
    const bool one = (ph_hi - ph_lo) > 1;
    XcdBarrier bar; bar.bar = (unsigned*)(P.ws + WS_BAR); bar.x = 0; bar.st = nullptr;
    if (one) bar = xcd_barrier_post((unsigned*)(P.ws + WS_BAR), (volatile LAS unsigned*)bst);
#define RUN_PHASE(k, call) do { if (ph_lo <= (k) && (k) < ph_hi) { call; if ((k) + 1 < ph_hi) { if ((k) == 0 && ph_hi > 1000) grid.sync(); else xcd_barrier(bar); } } } while (0)
    RUN_PHASE(0, phase0(P, ldsf));
    RUN_PHASE(1, phase1(P));
    RUN_PHASE(2, phase2(P, lds));
    RUN_PHASE(3, phase3(P, lds));
    RUN_PHASE(4, phase4(P, lds, ldsf));
    RUN_PHASE(5, phase5p(P));
    RUN_PHASE(6, phase5(P, lds, ldsf));
    RUN_PHASE(7, phase6(P));
    RUN_PHASE(8, phase7(P, lds));
    RUN_PHASE(9, phase9f(P, lds));
    RUN_PHASE(10, phase9(P, lds));
    RUN_PHASE(11, phase10(P, lds));
    RUN_PHASE(12, phase11(P, lds));
#undef RUN_PHASE
}

extern "C" void kernel_launch(void* const* d_in, const int* in_sizes, int n_in, void* d_out, int out_size, void* d_ws, size_t ws_size, hipStream_t stream) {
    static int grid = 0;
    if (grid == 0) {
        if (n_in != 34 || out_size != T * D || ws_size < WS_END) { fprintf(stderr, "kernel_launch: unexpected problem (n_in %d, out %d, ws %zu)\n", n_in, out_size, ws_size); grid = -1; return; }
        int dev = 0, cus = 0, per_cu = 0;
        (void)hipGetDevice(&dev);
        (void)hipDeviceGetAttribute(&cus, hipDeviceAttributeMultiprocessorCount, dev);
        if (hipFuncSetAttribute((const void*)mega, hipFuncAttributeMaxDynamicSharedMemorySize, LDS_TOTAL) != hipSuccess) { fprintf(stderr, "kernel_launch: hipFuncSetAttribute failed\n"); grid = -1; return; }
        (void)hipOccupancyMaxActiveBlocksPerMultiprocessor(&per_cu, mega, NTHREADS, LDS_TOTAL);
        if (per_cu < 1) { fprintf(stderr, "kernel_launch: occupancy query says %d\n", per_cu); grid = -1; return; }
        grid = cus;
    }
    if (grid < 0) return;
    Params p{};
    for (int i = 0; i < 34; ++i) p.in[i] = (const float*)d_in[i];
    p.out = (float*)d_out; p.ws = (unsigned char*)d_ws;
#if MK_ONE_LAUNCH
    (void)hipMemsetAsync((char*)d_ws + WS_BAR, 0, XCD_BAR_WORDS * 4, stream);
    int lo = 0, hi = NPHASES;
    void* args[] = {&p, &lo, &hi};
    hipError_t e = hipLaunchCooperativeKernel((void*)mega, dim3(grid), dim3(NTHREADS), args, LDS_TOTAL, stream);
    if (e != hipSuccess) fprintf(stderr, "cooperative launch failed: %s (grid %d)\n", hipGetErrorString(e), grid);
#else
    for (int ph = 0; ph < NPHASES; ++ph) hipLaunchKernelGGL(mega, dim3(grid), dim3(NTHREADS), LDS_TOTAL, stream, p, ph, ph + 1);
#endif
}
```

```cpp
#include <hip/hip_runtime.h>
#include <hip/hip_cooperative_groups.h>
#include <cstdio>
#include <cstdint>
namespace cg = cooperative_groups;

#ifndef MK_ONE_LAUNCH
#define MK_ONE_LAUNCH 1
#endif

typedef unsigned short bf16_t;
typedef short bf16x8 __attribute__((ext_vector_type(8)));
typedef float f32x4 __attribute__((ext_vector_type(4)));
typedef unsigned u32x4 __attribute__((ext_vector_type(4)));
typedef unsigned u32x2 __attribute__((ext_vector_type(2)));
typedef int i32x8 __attribute__((ext_vector_type(8)));
typedef int i32x4 __attribute__((ext_vector_type(4)));
typedef short s16x16 __attribute__((ext_vector_type(16)));
#define LAS __attribute__((address_space(3)))

constexpr int NB = 4, S = 8192, T = NB * S, D = 1024;
constexpr int NP = 3072;
constexpr int Q0 = 0, KC0 = 512, VC0 = 640, KS0 = 768, VS0 = 896, KW0 = 1024, VW0 = 1152, R0 = 1280, K0 = 1792, V0 = 2304, GL0 = 2816, WD0 = 2840;
constexpr int IN_COLS = 3000;
constexpr int NE = 32;
constexpr int NTHREADS = 512, NWAVES = 8;
constexpr int NPHASES = 13;
#ifndef EXPERT_CONV_IN_SCAN
#define EXPERT_CONV_IN_SCAN 1
#endif
constexpr int LDS_RING = 139264, LDS_TOTAL = 155648;

constexpr size_t MiB = 1u << 20;
constexpr size_t WS_CTL = 0;
constexpr size_t WS_BAR = 65536;
constexpr size_t WS_ADA = 1 * MiB;
constexpr size_t WS_COS = 2 * MiB, WS_SIN = 3 * MiB;
constexpr size_t WS_WIN = 4 * MiB;
constexpr size_t WS_WOUT = 10 * MiB;
constexpr size_t WS_CW1 = 12 * MiB;
constexpr size_t WS_CMP = 14 * MiB;
constexpr size_t WS_HID = 16 * MiB;
constexpr size_t WS_TOKW = 18 * MiB;
constexpr size_t WS_LIST = 984 * MiB;
constexpr size_t WS_BIAS1 = 23 * MiB;
constexpr size_t WS_WLORA = 23 * MiB + 65536;
constexpr size_t WS_LX = 768 * MiB;
constexpr size_t WS_WAG = 784 * MiB;
constexpr size_t WS_KVC = 24 * MiB;
constexpr size_t KVC_STRIDE = (size_t)(65536 + 16) * 64;
constexpr size_t WS_GU = 42 * MiB;
constexpr size_t WS_SROW = 138 * MiB;
constexpr size_t WS_QS = 139 * MiB;
constexpr size_t WS_H8 = 106 * MiB;
constexpr size_t WS_DN = 170 * MiB;
constexpr size_t WS_RA = 256 * MiB;
constexpr size_t WS_PROJ = 320 * MiB;
constexpr size_t WS_RW_W = 512 * MiB;
constexpr size_t WS_RW_R = 576 * MiB, WS_RW_K = 608 * MiB, WS_RW_V = 640 * MiB, WS_RW_KK = 672 * MiB, WS_RW_KKA = 704 * MiB, WS_RW_G = 736 * MiB;
constexpr size_t WS_Y = 768 * MiB;
constexpr size_t WS_ONSA = 832 * MiB;
constexpr size_t WS_MIXED = 320 * MiB;
constexpr size_t WS_ACT = 320 * MiB;
constexpr size_t WS_X1 = 600 * MiB;
constexpr size_t WS_YK = 728 * MiB;
constexpr size_t WS_H2X = 728 * MiB;
constexpr size_t WS_LOGP = 234 * MiB;
constexpr size_t WS_WRT = 250 * MiB;
constexpr size_t WS_KVI = 896 * MiB;
constexpr size_t WS_CMPI = 928 * MiB;
constexpr size_t WS_END = 1000 * MiB;

struct Params {
    const float* in[34];
    float* out;
    unsigned char* ws;
};
enum { I_X = 0, I_C, I_ADAW, I_ADAB, I_MIXPRE, I_MIXPOST, I_FFNPRE, I_FFNPOST, I_WIN, I_KPE, I_KW1, I_KW2, I_VPE, I_VW1, I_VW2, I_NSANORM,
       I_MU, I_W0, I_W2, I_A0, I_A2, I_G2, I_KK, I_KA, I_RK, I_LNW, I_LNB, I_WOUT, I_RW, I_RB, I_EGU, I_EBGU, I_EDN, I_EBDN };

__device__ __forceinline__ unsigned f2bf(float f) { unsigned u = __builtin_bit_cast(unsigned, f); return (u + 0x7fffu + ((u >> 16) & 1u)) >> 16; }
__device__ __forceinline__ float bf2f(unsigned short h) { return __builtin_bit_cast(float, (unsigned)h << 16); }
typedef float f32x2_pk __attribute__((ext_vector_type(2))); typedef __bf16 bf16x2_pk __attribute__((ext_vector_type(2)));
__device__ __forceinline__ unsigned pk2(float lo, float hi) { f32x2_pk v = {lo, hi}; bf16x2_pk b = __builtin_convertvector(v, bf16x2_pk); return __builtin_bit_cast(unsigned, b); }
__device__ __forceinline__ unsigned pk4f8(float a, float b, float c, float d) { int w = 0; w = __builtin_amdgcn_cvt_pk_fp8_f32(a, b, w, false); w = __builtin_amdgcn_cvt_pk_fp8_f32(c, d, w, true); return (unsigned)w; }
__device__ __forceinline__ float wave_sum(float v) {
#pragma unroll
    for (int o = 1; o < 64; o <<= 1) v += __shfl_xor(v, o);
    return v;
}
__device__ __forceinline__ float wave_max(float v) {
#pragma unroll
    for (int o = 1; o < 64; o <<= 1) v = fmaxf(v, __shfl_xor(v, o));
    return v;
}
__device__ __forceinline__ unsigned pk4i8(float a, float b, float c, float d) {
    const int ia = (int)__builtin_rintf(__builtin_amdgcn_fmed3f(a, -127.f, 127.f)), ib = (int)__builtin_rintf(__builtin_amdgcn_fmed3f(b, -127.f, 127.f)), ic = (int)__builtin_rintf(__builtin_amdgcn_fmed3f(c, -127.f, 127.f)), id = (int)__builtin_rintf(__builtin_amdgcn_fmed3f(d, -127.f, 127.f));
    return (unsigned)(ia & 255) | ((unsigned)(ib & 255) << 8) | ((unsigned)(ic & 255) << 16) | ((unsigned)id << 24);
}
__device__ __forceinline__ int tidx() { int t = (int)threadIdx.x; asm volatile("" : "+v"(t)); return t; }
__device__ __forceinline__ float sigmoidf_(float x) { return 1.f / (1.f + __expf(-x)); }
__device__ __forceinline__ void unpack8(u32x4 u, float (&f)[8]) {
    f[0] = __builtin_bit_cast(float, u.x << 16); f[1] = __builtin_bit_cast(float, u.x & 0xffff0000u); f[2] = __builtin_bit_cast(float, u.y << 16); f[3] = __builtin_bit_cast(float, u.y & 0xffff0000u);
    f[4] = __builtin_bit_cast(float, u.z << 16); f[5] = __builtin_bit_cast(float, u.z & 0xffff0000u); f[6] = __builtin_bit_cast(float, u.w << 16); f[7] = __builtin_bit_cast(float, u.w & 0xffff0000u);
}
__device__ __forceinline__ u32x4 pack8(const float (&f)[8]) { u32x4 o; o.x = pk2(f[0], f[1]); o.y = pk2(f[2], f[3]); o.z = pk2(f[4], f[5]); o.w = pk2(f[6], f[7]); return o; }
__device__ __forceinline__ int rope_d(int p) { return ((p >> 2) & 1) * 32 + ((p >> 5) & 1) * 16 + ((p >> 3) & 3) * 4 + (p & 3); }

template <int MODE = 0, class PMap, class KMap>
__device__ __forceinline__ void tr_tile(const float* __restrict__ src, int Nsrc, bf16_t* __restrict__ dst, int K, int p0, int k0, PMap pmap, KMap kmap, float* tile  , float qmul = 32.f) {
    const int tx = tidx() & 63, ty = tidx() >> 6;
    const int c = pmap(p0 + tx);
    float v[32];
#pragma unroll
    for (int i = 0; i < 32; ++i) { const int kk = ty + 8 * i; v[i] = (c >= 0) ? src[(size_t)kmap(k0 + kk) * Nsrc + c] : 0.f; }
#pragma unroll
    for (int i = 0; i < 32; ++i) tile[(ty + 8 * i) * 65 + tx] = v[i];
    __syncthreads();
    { const int pp = tidx() >> 3, kq = tidx() & 7;
#pragma unroll
      for (int j = 0; j < 4; ++j) { const float* tp = tile + (64 * j + 8 * kq) * 65 + pp;
        if constexpr (MODE == 1) { u32x2 o; o.x = pk4f8(32.f * tp[0], 32.f * tp[65], 32.f * tp[2 * 65], 32.f * tp[3 * 65]); o.y = pk4f8(32.f * tp[4 * 65], 32.f * tp[5 * 65], 32.f * tp[6 * 65], 32.f * tp[7 * 65]);
          *(u32x2*)((unsigned char*)dst + (size_t)(p0 + pp) * K + k0 + 64 * j + 8 * kq) = o; }
        else if constexpr (MODE == 2) { u32x2 o; o.x = pk4i8(qmul * tp[0], qmul * tp[65], qmul * tp[2 * 65], qmul * tp[3 * 65]); o.y = pk4i8(qmul * tp[4 * 65], qmul * tp[5 * 65], qmul * tp[6 * 65], qmul * tp[7 * 65]);
          *(u32x2*)((unsigned char*)dst + (size_t)(p0 + pp) * K + k0 + 64 * j + 8 * kq) = o; }
        else { u32x4 o; o.x = pk2(tp[0], tp[65]); o.y = pk2(tp[2 * 65], tp[3 * 65]); o.z = pk2(tp[4 * 65], tp[5 * 65]); o.w = pk2(tp[6 * 65], tp[7 * 65]);
          *(u32x4*)(dst + (size_t)(p0 + pp) * K + k0 + 64 * j + 8 * kq) = o; } } }
    __syncthreads();
}
struct MapId { __device__ int operator()(int p) const { return p; } };
struct MapWin { __device__ int operator()(int P) const {
    if (P < 1280) { const bool rope = (P < 640) || (P >= 768 && P < 896) || (P >= 1024 && P < 1152); return rope ? (P & ~63) + rope_d(P & 63) : P; }
    return P < 2816 ? P + 24 : (P < 2840 ? P - 2816 + 1280 : (P < IN_COLS ? P : -1)); } };
struct MapGU { __device__ int operator()(int P) const { return ((P >> 7) & 1) * 1024 + (P >> 8) * 128 + (P & 127); } };
struct MapCW1P { __device__ int operator()(int P) const { return P < 128 ? P : -1; } };
struct MapCW1K { __device__ int operator()(int k) const { return (k & ~63) + rope_d(k & 63); } };

__device__ __forceinline__ float sample_qmul(const float* __restrict__ w, float* red  ) {
    const int tid = tidx(); float s = 0.f;
#pragma unroll
    for (int i = 0; i < 8; ++i) { const float v = w[tid + 512 * i]; s += v * v; }
    s = wave_sum(s);
    __syncthreads();
    if ((tid & 63) == 0) red[tid >> 6] = s;
    __syncthreads();
    const float tot = ((red[0] + red[1]) + (red[2] + red[3])) + ((red[4] + red[5]) + (red[6] + red[7]));
    __syncthreads();
    const float rms = sqrtf(tot * (1.f / 4096.f));
    return rms > 0.f ? 127.f / (6.f * rms) : 0.f;
}
__device__ __forceinline__ void phase0(const Params& P, float* lds) {
    unsigned char* ws = P.ws;
    const int tid = tidx();
    if (blockIdx.x == 0 && tid < 128) ((unsigned*)(ws + WS_CTL))[tid] = 0u;
    for (int e = blockIdx.x * NTHREADS + tid; e < 1536 * 256; e += gridDim.x * NTHREADS) {
        const int n = e >> 8, k = e & 255; float v = 0.f;
        if (n < 512) { if (k < 32) v = P.in[I_W2][k * 512 + n]; }
        else if (n < 1024) { if (k >= 32 && k < 64) v = P.in[I_A2][(k - 32) * 512 + n - 512]; }
        else if (k >= 64 && k < 160) v = P.in[I_G2][(k - 64) * 512 + n - 1024];
        ((bf16_t*)(ws + WS_WLORA))[e] = (bf16_t)f2bf(v);
    }
    constexpr int U_ADA = 192, U_ROPE = 0, U_WIN = 48 * 4, U_WOUT = 16 * 4, U_CW1 = 2 * 4 * 8, U_B1 = 16, U_GU = 32 * 32 * 4, U_DN = 32 * 16 * 4;
    constexpr int TOTAL = U_ADA + U_ROPE + U_WIN + U_WOUT + U_CW1 + U_B1 + (EXPERT_CONV_IN_SCAN ? 0 : U_GU + U_DN);
    for (int u = blockIdx.x; u < TOTAL; u += gridDim.x) {
        int r = u;
        if (r < U_ADA) {
            float* cs = lds;
            float* part = lds + 4096;
            for (int i = tid; i < 4096; i += NTHREADS) { const float c0 = P.in[I_C][i]; cs[i] = c0 * sigmoidf_(c0); }
            __syncthreads();
            const int col = tid & 31, kg = tid >> 5, n = r * 32 + col;
            float a0 = 0.f, a1 = 0.f, a2 = 0.f, a3 = 0.f;
            const float* cw = P.in[I_ADAW] + (size_t)(kg * 64) * 6144 + n;
#pragma unroll 8
            for (int k = 0; k < 64; ++k) {
                const float w = cw[(size_t)k * 6144]; const int kk = kg * 64 + k;
                a0 += w * cs[kk]; a1 += w * cs[1024 + kk]; a2 += w * cs[2048 + kk]; a3 += w * cs[3072 + kk];
            }
            part[(kg * 4 + 0) * 32 + col] = a0; part[(kg * 4 + 1) * 32 + col] = a1; part[(kg * 4 + 2) * 32 + col] = a2; part[(kg * 4 + 3) * 32 + col] = a3;
            __syncthreads();
            if (tid < 128) { const int b = tid >> 5, j = tid & 31; float sacc = 0.f;
#pragma unroll
                for (int g = 0; g < 16; ++g) sacc += part[(g * 4 + b) * 32 + j];
                ((float*)(ws + WS_ADA))[b * 6144 + r * 32 + j] = sacc + P.in[I_ADAB][r * 32 + j]; }
            __syncthreads();
            continue;
        }
        r -= U_ADA;
        if (r < U_ROPE) {
            const int e = r * 512 + tid, t = e >> 5, j = e & 31;
            const double inv = pow(10000.0, -(double)j / 32.0);
            const float ang = (float)t * (float)inv;
            ((float*)(ws + WS_COS))[e] = (float)cos((double)ang);
            ((float*)(ws + WS_SIN))[e] = (float)sin((double)ang);
            continue;
        }
        r -= U_ROPE;
        if (r < U_WIN) { const float qm = sample_qmul(P.in[I_WIN], lds + 256 * 65); if (r == 0 && tid == 0) ((float*)(ws + WS_QS))[0] = qm > 0.f ? 1.f / qm : 0.f;
            tr_tile<2>(P.in[I_WIN], IN_COLS, (bf16_t*)(ws + WS_WIN), 1024, (r >> 2) * 64, (r & 3) * 256, MapWin(), MapId(), lds, qm); continue; }
        r -= U_WIN;
        if (r < U_WOUT) { tr_tile(P.in[I_WOUT], 1024, (bf16_t*)(ws + WS_WOUT), 1024, (r >> 2) * 64, (r & 3) * 256, MapId(), MapId(), lds); continue; }
        r -= U_WOUT;
        if (r < U_CW1) { const int kv = r >> 5, q = r & 31; bf16_t* dst = (bf16_t*)(ws + WS_CW1) + (size_t)kv * 256 * 2048;
            if (kv == 0) tr_tile(P.in[I_KW1], 128, dst, 2048, (q >> 3) * 64, (q & 7) * 256, MapCW1P(), MapCW1K(), lds);
            else tr_tile(P.in[I_VW1], 128, dst, 2048, (q >> 3) * 64, (q & 7) * 256, MapCW1P(), MapId(), lds);
            continue; }
        r -= U_CW1;
        if (r < U_B1) {
            const int kv = r >> 3, sl = r & 7;
            const float* pe = P.in[kv ? I_VPE : I_KPE]; const float* w1 = P.in[kv ? I_VW1 : I_KW1];
            const int n = tid & 127, qd = tid >> 7; float a = 0.f;
            const int kb = sl * 256 + qd * 64;
#pragma unroll 16
            for (int k = 0; k < 64; ++k) a += pe[kb + k] * w1[(size_t)(kb + k) * 128 + n];
            lds[tid] = a; __syncthreads();
            if (tid < 128) ((float*)(ws + WS_BIAS1))[(kv * 8 + sl) * 128 + tid] = (lds[tid] + lds[tid + 128]) + (lds[tid + 256] + lds[tid + 384]);
            __syncthreads();
            continue;
        }
        r -= U_B1;
        static_assert(EXPERT_CONV_IN_SCAN, "the expert weights (fp8) are converted by the scan units' loader waves");
    }
}

__device__ __forceinline__ void phase1(const Params& P) {
    const int lane = tidx() & 63, gw = blockIdx.x * NWAVES + (tidx() >> 6), ngw = gridDim.x * NWAVES;
    const float* ada = (const float*)(P.ws + WS_ADA);
    bf16_t* XN = (bf16_t*)(P.ws + WS_RA);
    for (int row = gw; row < T; row += ngw) {
        const int b = row / S;
        const f32x4* xr = (const f32x4*)(P.in[I_X] + (size_t)row * D) + lane;
        f32x4 v[4]; float s = 0.f;
#pragma unroll
        for (int j = 0; j < 4; ++j) { v[j] = xr[64 * j]; s += v[j].x * v[j].x + v[j].y * v[j].y + v[j].z * v[j].z + v[j].w * v[j].w; }
        const float rstd = rsqrtf(wave_sum(s) * (1.f / D) + 1e-6f);
        unsigned* o = (unsigned*)((unsigned char*)XN + (size_t)row * D) + lane;
        f32x4 h[4]; float am = 0.f;
#pragma unroll
        for (int j = 0; j < 4; ++j) {
            const int c = 4 * (lane + 64 * j);
            const f32x4 g = *(const f32x4*)(P.in[I_MIXPRE] + c), sh = *(const f32x4*)(ada + b * 6144 + c), sc = *(const f32x4*)(ada + b * 6144 + 1024 + c);
            h[j] = v[j] * rstd * g * (sc + 1.f) + sh;
            am = fmaxf(fmaxf(am, fmaxf(fabsf(h[j].x), fabsf(h[j].y))), fmaxf(fabsf(h[j].z), fabsf(h[j].w)));
        }
        am = wave_max(am);
        const float qm = am > 0.f ? 127.f / am : 0.f;
        if (lane == 0) ((float*)(P.ws + WS_SROW))[row] = am * (1.f / 127.f);
#pragma unroll
        for (int j = 0; j < 4; ++j) o[64 * j] = pk4i8(h[j].x * qm, h[j].y * qm, h[j].z * qm, h[j].w * qm);
    }
}

namespace g8 {
constexpr int BM = 256, BK = 64, HALF = 128, HTB = HALF * BK * 2, STAGE_BYTES = 8 * HTB;
__device__ __forceinline__ int lds_byte(int r, int c) { const int st = (r >> 4) * 2 + (c >> 5), rr = r & 15, cc = c & 31, ob = rr * 64 + cc * 2; return st * 1024 + (ob ^ (((ob >> 9) & 1) << 5)); }
__device__ __forceinline__ void stage_rc(int b, int& R, int& C) { const int st = b / 1024, sb = b % 1024, swz = sb ^ (((sb >> 9) & 1) << 5); R = (st >> 1) * 16 + swz / 64; C = (st & 1) * 32 + (swz % 64) / 2; }
__device__ __forceinline__ int perm32(int rho) { const int n = rho >> 4, i = rho & 15; return 8 * (i >> 2) + 4 * n + (i & 3); }
__device__ __forceinline__ i32x8 cat8(bf16x8 a, bf16x8 b) { const s16x16 v = __builtin_shufflevector(a, b, 0, 1, 2, 3, 4, 5, 6, 7, 8, 9, 10, 11, 12, 13, 14, 15); return __builtin_bit_cast(i32x8, v); }
__device__ __forceinline__ unsigned cvt_pk_bf16(float lo, float hi) { unsigned r; asm volatile("v_cvt_pk_bf16_f32 %0, %1, %2" : "=v"(r) : "v"(lo), "v"(hi)); return r; }

__device__ __forceinline__ void mma8(f32x4 (&c)[4][2], const bf16x8 (&At)[4][2], const bf16x8 (&Bt)[2][2]) {
    const i32x8 a0 = cat8(At[0][0], At[0][1]), a1 = cat8(At[1][0], At[1][1]), a2 = cat8(At[2][0], At[2][1]), a3 = cat8(At[3][0], At[3][1]), b0 = cat8(Bt[0][0], Bt[0][1]), b1 = cat8(Bt[1][0], Bt[1][1]);
    const unsigned one = 0x7f7f7f7fu;
    asm volatile("s_setprio 1\n\ts_nop 1\n\t"
                 "v_mfma_scale_f32_16x16x128_f8f6f4 %0, %8, %10, %0, %14, %14 op_sel_hi:[0,0,0]\n\t"
                 "v_mfma_scale_f32_16x16x128_f8f6f4 %1, %9, %10, %1, %14, %14 op_sel_hi:[0,0,0]\n\t"
                 "v_mfma_scale_f32_16x16x128_f8f6f4 %2, %8, %11, %2, %14, %14 op_sel_hi:[0,0,0]\n\t"
                 "v_mfma_scale_f32_16x16x128_f8f6f4 %3, %9, %11, %3, %14, %14 op_sel_hi:[0,0,0]\n\t"
                 "v_mfma_scale_f32_16x16x128_f8f6f4 %4, %8, %12, %4, %14, %14 op_sel_hi:[0,0,0]\n\t"
                 "v_mfma_scale_f32_16x16x128_f8f6f4 %5, %9, %12, %5, %14, %14 op_sel_hi:[0,0,0]\n\t"
                 "v_mfma_scale_f32_16x16x128_f8f6f4 %6, %8, %13, %6, %14, %14 op_sel_hi:[0,0,0]\n\t"
                 "v_mfma_scale_f32_16x16x128_f8f6f4 %7, %9, %13, %7, %14, %14 op_sel_hi:[0,0,0]\n\t"
                 "s_setprio 0"
                 : "+v"(c[0][0]), "+v"(c[0][1]), "+v"(c[1][0]), "+v"(c[1][1]), "+v"(c[2][0]), "+v"(c[2][1]), "+v"(c[3][0]), "+v"(c[3][1])
                 : "v"(b0), "v"(b1), "v"(a0), "v"(a1), "v"(a2), "v"(a3), "v"(one));
}

template <bool NOP>
__device__ __forceinline__ void mma8_settle(f32x4 (&c)[2][4][2]) {
#define G8_PIN16 "+v"(c[0][0][0]), "+v"(c[0][0][1]), "+v"(c[0][1][0]), "+v"(c[0][1][1]), "+v"(c[0][2][0]), "+v"(c[0][2][1]), "+v"(c[0][3][0]), "+v"(c[0][3][1]), \
                 "+v"(c[1][0][0]), "+v"(c[1][0][1]), "+v"(c[1][1][0]), "+v"(c[1][1][1]), "+v"(c[1][2][0]), "+v"(c[1][2][1]), "+v"(c[1][3][0]), "+v"(c[1][3][1])
    if constexpr (NOP) asm volatile("s_nop 15\n\ts_nop 7" : G8_PIN16); else asm volatile("" : G8_PIN16);
#undef G8_PIN16
}

struct Unit { const char* A; const char* B; unsigned va[2][2]; int x0, x1, x2, x3; };

template <bool PERM, int MODE = 0, class Epi, class Sched>
__device__ __forceinline__ void gemm_phase(LAS unsigned char* lds, int K, int ldb, const Sched& S, const Epi& E) {
    const int tid = tidx(), wid = __builtin_amdgcn_readfirstlane(tid >> 6), lane = tid & 63, wr = wid >> 2, wc = wid & 3, fr = lane & 15, fq = lane >> 4;
    int nt = K / BK; asm volatile("" : "+s"(nt));
    unsigned vb[2][2];
    { int R0, C0, R1, C1; stage_rc(tid * 16, R0, C0); stage_rc(tid * 16 + 8192, R1, C1);
      const int Rb0 = PERM ? ((R0 & ~31) + perm32(R0 & 31)) : R0, Rb1 = PERM ? ((R1 & ~31) + perm32(R1 & 31)) : R1;
      vb[0][0] = (unsigned)(Rb0 * ldb + C0) * 2u; vb[0][1] = (unsigned)(Rb1 * ldb + C1) * 2u; vb[1][0] = (unsigned)((Rb0 + HALF) * ldb + C0) * 2u; vb[1][1] = (unsigned)((Rb1 + HALF) * ldb + C1) * 2u; }
    const size_t kstep = (size_t)(BK * 2);
    const unsigned ldsw = (unsigned)wid * 1024u;
    const int aoff = lds_byte(wr * 64 + fr, fq * 8), boff = lds_byte(wc * 32 + fr, fq * 8);
#define G8_SA(b, h) (((b) * 2 + (h)) * HTB)
#define G8_SB(b, h) ((4 + (b) * 2 + (h)) * HTB)
#define G8_STAGE(bufoff, gbase, v0, v1) do { unsigned o0_ = (v0), o1_ = (v1); asm volatile("" : "+v"(o0_), "+v"(o1_));     \
        __builtin_amdgcn_global_load_lds((const unsigned*)((gbase) + o0_), (LAS unsigned*)(lds + (bufoff) + ldsw), 16, 0, 0); \
        __builtin_amdgcn_global_load_lds((const unsigned*)((gbase) + o1_), (LAS unsigned*)(lds + (bufoff) + ldsw + 8192), 16, 0, 0); } while (0)
#define G8_LDA(dst, b, h) do { _Pragma("unroll") for (int m = 0; m < 4; ++m) _Pragma("unroll") for (int k = 0; k < 2; ++k) dst[m][k] = *(const LAS bf16x8*)(lds + G8_SA(b, h) + aoff + m * 2048 + k * 1024); } while (0)
#define G8_LDB(dst, b, h) do { _Pragma("unroll") for (int n = 0; n < 2; ++n) _Pragma("unroll") for (int k = 0; k < 2; ++k) dst[n][k] = *(const LAS bf16x8*)(lds + G8_SB(b, h) + boff + n * 2048 + k * 1024); } while (0)
#define G8_MMA(ai, bj, At, Bt) do { if constexpr (MODE == 1) mma8(acc[ai][bj], At, Bt); else if constexpr (MODE == 2) { __builtin_amdgcn_s_setprio(1); _Pragma("unroll") for (int m = 0; m < 4; ++m) _Pragma("unroll") for (int n = 0; n < 2; ++n) _Pragma("unroll") for (int k = 0; k < 2; ++k) \
        acc[ai][bj][m][n] = __builtin_bit_cast(f32x4, __builtin_amdgcn_mfma_i32_16x16x64_i8(__builtin_bit_cast(i32x4, Bt[n][k]), __builtin_bit_cast(i32x4, At[m][k]), __builtin_bit_cast(i32x4, acc[ai][bj][m][n]), 0, 0, 0)); __builtin_amdgcn_s_setprio(0); } \
        else { __builtin_amdgcn_s_setprio(1); _Pragma("unroll") for (int m = 0; m < 4; ++m) _Pragma("unroll") for (int n = 0; n < 2; ++n) _Pragma("unroll") for (int k = 0; k < 2; ++k) \
        acc[ai][bj][m][n] = __builtin_amdgcn_mfma_f32_16x16x32_bf16(Bt[n][k], At[m][k], acc[ai][bj][m][n], 0, 0, 0); __builtin_amdgcn_s_setprio(0); } } while (0)
#define G8_WAIT_V(n) asm volatile("s_waitcnt vmcnt(" #n ")" ::: "memory")
#define G8_WAIT_L(n) asm volatile("s_waitcnt lgkmcnt(" #n ")" ::: "memory")
#define G8_BAR __builtin_amdgcn_s_barrier()
#define G8_SCHED __builtin_amdgcn_sched_barrier(0)
    Unit cur, nxt; int ui = 0;
#define G8_NEXT(i, u) ({ int R0_, C0_, R1_, C1_; const int t_ = tidx(); stage_rc(t_ * 16, R0_, C0_); stage_rc(t_ * 16 + 8192, R1_, C1_); S.next((i), (u), R0_, C0_, R1_, C1_); })
    if (!G8_NEXT(0, cur)) return;
    f32x4 acc[2][2][4][2];
#pragma unroll
    for (int a = 0; a < 2; ++a)
#pragma unroll
        for (int b = 0; b < 2; ++b)
#pragma unroll
            for (int m = 0; m < 4; ++m)
#pragma unroll
                for (int n = 0; n < 2; ++n) acc[a][b][m][n] = (f32x4){0.f, 0.f, 0.f, 0.f};
    bf16x8 At[4][2], B0[2][2], B1[2][2];
    G8_STAGE(G8_SB(0, 0), cur.B, vb[0][0], vb[0][1]); G8_STAGE(G8_SB(0, 1), cur.B, vb[1][0], vb[1][1]); G8_STAGE(G8_SA(0, 0), cur.A, cur.va[0][0], cur.va[0][1]); G8_STAGE(G8_SA(0, 1), cur.A, cur.va[1][0], cur.va[1][1]);
    if (wr == 1) G8_BAR;
    G8_WAIT_V(2); G8_BAR;
    G8_STAGE(G8_SB(1, 0), cur.B + kstep, vb[0][0], vb[0][1]); G8_STAGE(G8_SA(1, 0), cur.A + kstep, cur.va[0][0], cur.va[0][1]); G8_STAGE(G8_SB(1, 1), cur.B + kstep, vb[1][0], vb[1][1]);
    G8_WAIT_V(6); G8_BAR;
    for (;;) {
        const bool has_next = G8_NEXT(ui + 1, nxt);
        if (!has_next) nxt = cur;
        for (int t = 0; t < nt; t += 2) {
            const bool last = (t == nt - 2);
            const char* a1 = cur.A + (size_t)(t + 1) * kstep;
            const char* a2 = last ? nxt.A : cur.A + (size_t)(t + 2) * kstep; const char* b2 = last ? nxt.B : cur.B + (size_t)(t + 2) * kstep;
            const char* a3 = a2 + kstep; const char* b3 = b2 + kstep;
            const unsigned w00 = last ? nxt.va[0][0] : cur.va[0][0], w01 = last ? nxt.va[0][1] : cur.va[0][1], w10 = last ? nxt.va[1][0] : cur.va[1][0], w11 = last ? nxt.va[1][1] : cur.va[1][1];
            G8_LDB(B0, 0, 0); G8_LDB(B1, 0, 1); G8_SCHED; G8_LDA(At, 0, 0); G8_STAGE(G8_SA(1, 1), a1, cur.va[1][0], cur.va[1][1]);
            G8_WAIT_V(8); G8_WAIT_L(0); G8_BAR; G8_MMA(0, 0, At, B0); G8_MMA(0, 1, At, B1); G8_BAR; G8_SCHED;
            G8_LDA(At, 0, 1); G8_STAGE(G8_SB(0, 0), b2, vb[0][0], vb[0][1]); G8_STAGE(G8_SB(0, 1), b2, vb[1][0], vb[1][1]); G8_STAGE(G8_SA(0, 0), a2, w00, w01);
            G8_WAIT_V(8); G8_WAIT_L(0); G8_BAR; G8_MMA(1, 0, At, B0); G8_MMA(1, 1, At, B1); G8_BAR; G8_SCHED;
            G8_LDB(B0, 1, 0); G8_LDB(B1, 1, 1); G8_SCHED; G8_LDA(At, 1, 0); G8_STAGE(G8_SA(0, 1), a2, w10, w11);
            G8_WAIT_V(8); G8_WAIT_L(0); G8_BAR; G8_MMA(0, 0, At, B0); G8_MMA(0, 1, At, B1); G8_BAR; G8_SCHED;
            G8_LDA(At, 1, 1); G8_STAGE(G8_SB(1, 0), b3, vb[0][0], vb[0][1]); G8_STAGE(G8_SB(1, 1), b3, vb[1][0], vb[1][1]); G8_STAGE(G8_SA(1, 0), a3, w00, w01);
            G8_WAIT_V(8); G8_WAIT_L(0); G8_BAR; G8_MMA(1, 0, At, B0); G8_MMA(1, 1, At, B1); G8_BAR; G8_SCHED;
        }
        if (wr == 0) G8_BAR;
        if constexpr (MODE == 2) {
            const int fr_ = tidx() & 15;
            _Pragma("unroll") for (int a = 0; a < 2; ++a) _Pragma("unroll") for (int m = 0; m < 4; ++m) { const float sc = E.rs(cur, a * 128 + wr * 64 + m * 16 + fr_);
                _Pragma("unroll") for (int b = 0; b < 2; ++b) _Pragma("unroll") for (int n = 0; n < 2; ++n) _Pragma("unroll") for (int i = 0; i < 4; ++i) { const f32x4 t = acc[a][b][m][n]; const i32x4 ti = __builtin_bit_cast(i32x4, t); acc[a][b][m][n][i] = (float)ti[i] * sc; } }
        }
        if constexpr (MODE == 1) {
            mma8_settle<true>(acc[0]); mma8_settle<false>(acc[1]);
            _Pragma("unroll") for (int a = 0; a < 2; ++a) _Pragma("unroll") for (int b = 0; b < 2; ++b) _Pragma("unroll") for (int m = 0; m < 4; ++m) _Pragma("unroll") for (int n = 0; n < 2; ++n) acc[a][b][m][n] *= (1.f / 32.f);
        }
        { const int l_ = tidx() & 63; E(acc, cur, wr, wc, l_ & 15, l_ >> 4); }
        if (!has_next) break;
#pragma unroll
        for (int a = 0; a < 2; ++a)
#pragma unroll
            for (int b = 0; b < 2; ++b)
#pragma unroll
                for (int m = 0; m < 4; ++m)
#pragma unroll
                    for (int n = 0; n < 2; ++n) acc[a][b][m][n] = (f32x4){0.f, 0.f, 0.f, 0.f};
        cur = nxt; ++ui;
        if (wr == 1) G8_BAR;
    }
    G8_WAIT_V(0);
    G8_BAR;
#undef G8_NEXT
#undef G8_SA
#undef G8_SB
#undef G8_STAGE
#undef G8_LDA
#undef G8_LDB
#undef G8_MMA
#undef G8_WAIT_V
#undef G8_WAIT_L
#undef G8_BAR
#undef G8_SCHED
}

__device__ __forceinline__ const char* uptr(const void* p) {
    const unsigned long long v = (unsigned long long)p; const unsigned lo = __builtin_amdgcn_readfirstlane((unsigned)v), hi = __builtin_amdgcn_readfirstlane((unsigned)(v >> 32));
    return (const char*)(((unsigned long long)hi << 32) | lo); }
__device__ __forceinline__ int ui(int v) { return __builtin_amdgcn_readfirstlane(v); }
__device__ __forceinline__ void dense_unit(Unit& u, const bf16_t* A, int lda, const bf16_t* Bt, int ldb, int pm, int pn, int R0, int C0, int R1, int C1) {
    u.A = uptr(A + (size_t)pm * BM * lda); u.B = uptr(Bt + (size_t)pn * BM * ldb);
    u.va[0][0] = (unsigned)(R0 * lda + C0) * 2u; u.va[0][1] = (unsigned)(R1 * lda + C1) * 2u; u.va[1][0] = (unsigned)((R0 + HALF) * lda + C0) * 2u; u.va[1][1] = (unsigned)((R1 + HALF) * lda + C1) * 2u;
    u.x0 = ui(pm); u.x1 = ui(pn); u.x2 = 0; u.x3 = 0;
}
__device__ __forceinline__ bool static_tile(int i, int G, int c, int nM, int nN, int& pm, int& pn) {
    const int nwg = nM * nN; const long L = (long)i * G + c; if (L >= nwg) return false;
    int wgid = (int)L; { const int q = nwg / 8, r = nwg % 8, xcd = wgid % 8, off = wgid / 8; wgid = (xcd < r ? xcd * (q + 1) : r * (q + 1) + (xcd - r) * q) + off; }
    const int nig = 8 * nN, gid = wgid / nig, fm = gid * 8, gsz = (nM - fm) < 8 ? (nM - fm) : 8;
    pm = fm + ((wgid % nig) % gsz); pn = (wgid % nig) / gsz; return true;
}
}

struct SchedDense {
    const bf16_t* A; const bf16_t* Bt; int lda, ldb, nM, nN;
    __device__ __forceinline__ bool next(int i, g8::Unit& u, int R0, int C0, int R1, int C1) const {
        int pm, pn; if (!g8::static_tile(i, (int)gridDim.x, (int)blockIdx.x, nM, nN, pm, pn)) return false;
        g8::dense_unit(u, A, lda, Bt, ldb, pm, pn, R0, C0, R1, C1); return true;
    }
};
struct EpiInProj {
    bf16_t* proj; bf16_t* kvc; unsigned char* kvi; const float* COS; const float* SIN; const float* srow; const float* qs;
    __device__ __forceinline__ float rs(const g8::Unit& u, int r) const { return srow[u.x0 * 256 + r] * qs[0]; }
    __device__ __forceinline__ void operator()(const f32x4 (&acc)[2][2][4][2], const g8::Unit& u, int wr, int wc, int fr, int fq) const {
        const int pm = u.x0, pn = u.x1;
        f32x4 frv;
#pragma unroll
        for (int i = 0; i < 4; ++i) frv[i] = __builtin_amdgcn_exp2f(-(float)(16 * (wc & 1) + 4 * fq + i) * (13.287712379549449f / 32.f)) * 0.15915494309189535f;
#pragma unroll
        for (int ai = 0; ai < 2; ++ai)
#pragma unroll
            for (int m = 0; m < 4; ++m) {
                const int row = pm * 256 + ai * 128 + wr * 64 + m * 16 + fr, t = row & (S - 1);
                f32x4 cs = {0.f, 0.f, 0.f, 0.f}, sn = {0.f, 0.f, 0.f, 0.f};
                if (pn < 5) {
#pragma unroll
                    for (int i = 0; i < 4; ++i) { const float rev = __builtin_amdgcn_fractf((float)t * frv[i]); cs[i] = __builtin_amdgcn_cosf(rev); sn[i] = __builtin_amdgcn_sinf(rev); }
                }
                u32x4 w[2];
#pragma unroll
                for (int bj = 0; bj < 2; ++bj) {
                    f32x4 v0 = acc[ai][bj][m][0], v1 = acc[ai][bj][m][1];
                    if (pn < 2 || (pn < 5 && bj == 0)) { const f32x4 x1 = v0, x2 = v1; v0 = x1 * cs - x2 * sn; v1 = x2 * cs + x1 * sn; }
                    w[bj].x = g8::cvt_pk_bf16(v0[0], v0[1]); w[bj].y = g8::cvt_pk_bf16(v0[2], v0[3]); w[bj].z = g8::cvt_pk_bf16(v1[0], v1[1]); w[bj].w = g8::cvt_pk_bf16(v1[2], v1[3]);
                }
                if (pn == 3 || pn == 4) {
                    const int b = row / S, g = wc >> 1, key = t & 63;
                    unsigned char* ti = kvi + ((size_t)(((pn - 3) * NB + b) * 2 + g) * (S / 64) + (t >> 6)) * 16384;
                    *(u32x4*)(ti + ((wc & 1) * 4 + fq) * 1024 + key * 16) = w[0];
                    *(u32x4*)(ti + 8192 + (wc & 1) * 4096 + (key >> 4) * 1024 + (key & 15) * 64 + fq * 16) = w[1];
                } else {
                    bf16_t* pr = proj + (size_t)row * NP + pn * 256 + wc * 32 + 8 * fq;
                    *(u32x4*)pr = w[0]; *(u32x4*)(pr + 128) = w[1];
                    if (pn == 2) {
                        const int b = row / S, g = wc >> 1;
                        bf16_t* kp = kvc + ((size_t)((b * 2 + g) * S + t)) * 64 + (wc & 1) * 32 + 8 * fq;
                        *(u32x4*)kp = w[0]; *(u32x4*)(kp + KVC_STRIDE) = w[1];
                    }
                }
                asm volatile("" ::: "memory");
            }
    }
};
__device__ __forceinline__ void phase2(const Params& P, LAS unsigned char* lds) {
    unsigned char* ws = P.ws;
    SchedDense Sd{(const bf16_t*)(ws + WS_RA), (const bf16_t*)(ws + WS_WIN), D / 2, D / 2, T / 256, NP / 256};
    EpiInProj E{(bf16_t*)(ws + WS_PROJ), (bf16_t*)(ws + WS_KVC), ws + WS_KVI, (const float*)(ws + WS_COS), (const float*)(ws + WS_SIN), (const float*)(ws + WS_SROW), (const float*)(ws + WS_QS)};
    g8::gemm_phase<true, 2>(lds, D / 2, D / 2, Sd, E);
}

__device__ __forceinline__ float gelu_tanh(float x) { const float u = 0.7978845608028654f * (x + 0.044715f * x * x * x); return 0.5f * x * (1.f + tanhf(u)); }
struct SchedCmp {
    const bf16_t* kvc; const bf16_t* cw1;
    __device__ __forceinline__ bool next(int i, g8::Unit& u, int R0, int C0, int R1, int C1) const {
        const int id = (int)blockIdx.x + i * (int)gridDim.x; if (id >= 32) return false;
        const int kv = id >> 4, mt = id & 15;
        g8::dense_unit(u, kvc + (size_t)kv * KVC_STRIDE, 1024, cw1 + (size_t)kv * 256 * 2048, 2048, mt, 0, R0, C0, R1, C1); u.x2 = g8::ui(kv); return true;
    }
};
struct EpiCmp {
    bf16_t* hid; const float* bias1;
    __device__ __forceinline__ void operator()(const f32x4 (&acc)[2][2][4][2], const g8::Unit& u, int wr, int wc, int fr, int fq) const {
        const int kv = u.x2, col = wc * 32 + 8 * fq;
        f32x4 b0 = {0.f, 0.f, 0.f, 0.f}, b1 = {0.f, 0.f, 0.f, 0.f};
#pragma unroll
        for (int sl = 0; sl < 8; ++sl) { b0 += *(const f32x4*)(bias1 + (kv * 8 + sl) * 128 + col); b1 += *(const f32x4*)(bias1 + (kv * 8 + sl) * 128 + col + 4); }
#pragma unroll
        for (int ai = 0; ai < 2; ++ai)
#pragma unroll
            for (int m = 0; m < 4; ++m) {
                const int row = u.x0 * 256 + ai * 128 + wr * 64 + m * 16 + fr;
                const f32x4 v0 = acc[ai][0][m][0] + b0, v1 = acc[ai][0][m][1] + b1;
                u32x4 w; w.x = pk2(gelu_tanh(v0[0]), gelu_tanh(v0[1])); w.y = pk2(gelu_tanh(v0[2]), gelu_tanh(v0[3])); w.z = pk2(gelu_tanh(v1[0]), gelu_tanh(v1[1])); w.w = pk2(gelu_tanh(v1[2]), gelu_tanh(v1[3]));
                *(u32x4*)(hid + ((size_t)kv * 4096 + row) * 128 + col) = w;
            }
    }
};
__device__ __forceinline__ void phase3(const Params& P, LAS unsigned char* lds) {
    unsigned char* ws = P.ws;
    {
        SchedCmp Sc{(const bf16_t*)(ws + WS_KVC), (const bf16_t*)(ws + WS_CW1)};
        EpiCmp E{(bf16_t*)(ws + WS_HID), (const float*)(ws + WS_BIAS1)};
        g8::gemm_phase<true>(lds, 2048, 2048, Sc, E);
    }
    const bf16_t* proj = (const bf16_t*)(ws + WS_PROJ);
    const float* mu = P.in[I_MU];
    bf16_t* LX = (bf16_t*)(ws + WS_LX);
    for (int e = blockIdx.x * NTHREADS + tidx(); e < T * 32; e += gridDim.x * NTHREADS) {
        const int row = e >> 5, c0 = (e & 31) * 8, t = row & (S - 1);
        u32x4 o = {0u, 0u, 0u, 0u};
        if (c0 < 160) {
            const u32x4 cu = *(const u32x4*)(proj + (size_t)row * NP + WD0 + c0);
            u32x4 pu = {0u, 0u, 0u, 0u}; if (t > 0) pu = *(const u32x4*)(proj + (size_t)(row - 1) * NP + WD0 + c0);
            float cv[8], pv_[8], xs[8]; unpack8(cu, cv); unpack8(pu, pv_);
#pragma unroll
            for (int i = 0; i < 8; ++i) {
                float x = cv[i] + (pv_[i] - cv[i]) * mu[1536 + c0 + i];
                xs[i] = c0 < 32 ? tanhf(x) : (c0 >= 64 ? sigmoidf_(x) : x);
            }
            o = pack8(xs);
        }
        *(u32x4*)(LX + (size_t)row * 256 + c0) = o;
    }
}

struct EpiBf16 {
    bf16_t* O; int ldc;
    __device__ __forceinline__ void operator()(const f32x4 (&acc)[2][2][4][2], const g8::Unit& u, int wr, int wc, int fr, int fq) const {
#pragma unroll
        for (int ai = 0; ai < 2; ++ai)
#pragma unroll
            for (int m = 0; m < 4; ++m) {
                bf16_t* rowp = O + (size_t)(u.x0 * 256 + ai * 128 + wr * 64 + m * 16 + fr) * ldc + u.x1 * 256 + wc * 32 + 8 * fq;
#pragma unroll
                for (int bj = 0; bj < 2; ++bj) {
                    const f32x4 v0 = acc[ai][bj][m][0], v1 = acc[ai][bj][m][1];
                    u32x4 w; w.x = g8::cvt_pk_bf16(v0[0], v0[1]); w.y = g8::cvt_pk_bf16(v0[2], v0[3]); w.z = g8::cvt_pk_bf16(v1[0], v1[1]); w.w = g8::cvt_pk_bf16(v1[2], v1[3]);
                    *(u32x4*)(rowp + bj * 128) = w;
                }
            }
    }
};
__device__ __forceinline__ void phase4(const Params& P, LAS unsigned char* lds, float* ldsf) {
    unsigned char* ws = P.ws;
    {
        SchedDense Sd{(const bf16_t*)(ws + WS_LX), (const bf16_t*)(ws + WS_WLORA), 256, 256, T / 256, 1536 / 256};
        EpiBf16 E{(bf16_t*)(ws + WS_WAG), 1536};
        g8::gemm_phase<true>(lds, 256, 256, Sd, E);
    }
    __syncthreads();
    float* w2s = ldsf;
    float* hs = ldsf + 2 * 128 * 64 + (tidx() >> 6) * 128;
    for (int i = tidx(); i < 2 * 128 * 64 / 4; i += NTHREADS) { const int kv = i >> 11, j = i & 2047; ((f32x4*)w2s)[i] = ((const f32x4*)P.in[kv ? I_VW2 : I_KW2])[j]; }
    __syncthreads();
    const int lane = tidx() & 63, gw = blockIdx.x * NWAVES + (tidx() >> 6), ngw = gridDim.x * NWAVES;
    for (int item = gw; item < 2 * 4096; item += ngw) {
        const int kv = item >> 12, row = item & 4095;
        const unsigned hw = ((const unsigned*)((const bf16_t*)(ws + WS_HID) + ((size_t)kv * 4096 + row) * 128))[lane];
        hs[2 * lane] = __builtin_bit_cast(float, hw << 16); hs[2 * lane + 1] = __builtin_bit_cast(float, hw & 0xffff0000u);
        asm volatile("s_waitcnt lgkmcnt(0)" ::: "memory");
        const int ns = kv ? lane : rope_d(lane);
        const float* wc = w2s + kv * 8192 + ns;
        float a0 = 0.f, a1 = 0.f;
#pragma unroll 8
        for (int c = 0; c < 128; c += 4) { const f32x4 h4 = *(const f32x4*)(hs + c); a0 += h4.x * wc[c * 64] + h4.z * wc[(c + 2) * 64]; a1 += h4.y * wc[(c + 1) * 64] + h4.w * wc[(c + 3) * 64]; }
        const float a = a0 + a1;
        { const int bg = row >> 9, i = row & 511, key = i & 63, n = lane; unsigned char* ti = ws + WS_CMPI + ((size_t)bg * 8 + (i >> 6)) * 16384;
          if (kv == 0) *(bf16_t*)(ti + (n >> 3) * 1024 + key * 16 + (n & 7) * 2) = (bf16_t)f2bf(a);
          else *(bf16_t*)(ti + 8192 + (n >> 5) * 4096 + (key >> 4) * 1024 + (key & 15) * 64 + (n & 31) * 2) = (bf16_t)f2bf(a); }
        asm volatile("s_waitcnt lgkmcnt(0)" ::: "memory");
    }
}

__device__ __forceinline__ void phase5p(const Params& P) {
    unsigned char* ws = P.ws;
    const int lane = tidx() & 63, gw = blockIdx.x * NWAVES + (tidx() >> 6), ngw = gridDim.x * NWAVES, c0 = 8 * lane;
    const bf16_t* proj = (const bf16_t*)(ws + WS_PROJ); const bf16_t* wag = (const bf16_t*)(ws + WS_WAG);
    const float* mu = P.in[I_MU];
    float w0[8], a0v[8], kkw[8], kaw[8], mur[8], muk[8], muv[8];
#pragma unroll
    for (int i = 0; i < 8; ++i) { w0[i] = P.in[I_W0][c0 + i]; a0v[i] = P.in[I_A0][c0 + i]; kkw[i] = P.in[I_KK][c0 + i]; kaw[i] = P.in[I_KA][c0 + i]; mur[i] = mu[c0 + i]; muk[i] = mu[512 + c0 + i]; muv[i] = mu[1024 + c0 + i]; }
    for (int row = gw; row < T; row += ngw) {
        const bool has_prev = (row & (S - 1)) != 0;
        const bf16_t* pr = proj + (size_t)row * NP + c0; const bf16_t* pp = has_prev ? pr - NP : pr; const bf16_t* wg = wag + (size_t)row * 1536 + c0;
        const u32x4 r8 = *(const u32x4*)(pr + R0), k8 = *(const u32x4*)(pr + K0), v8 = *(const u32x4*)(pr + V0);
        const u32x4 rp8 = *(const u32x4*)(pp + R0), kp8 = *(const u32x4*)(pp + K0), vp8 = *(const u32x4*)(pp + V0);
        const u32x4 wl8 = *(const u32x4*)(wg), al8 = *(const u32x4*)(wg + 512), gg8 = *(const u32x4*)(wg + 1024);
        float rc[8], kc[8], vc[8], rp[8], kp[8], vp[8], wl[8], al[8];
        unpack8(r8, rc); unpack8(k8, kc); unpack8(v8, vc); unpack8(rp8, rp); unpack8(kp8, kp); unpack8(vp8, vp); unpack8(wl8, wl); unpack8(al8, al);
        float ro[8], ko[8], vo[8], wo[8], kk[8], kka[8], av[8]; float ss = 0.f;
#pragma unroll
        for (int i = 0; i < 8; ++i) {
            const float pr_ = has_prev ? rp[i] : 0.f, pk_ = has_prev ? kp[i] : 0.f, pv_ = has_prev ? vp[i] : 0.f;
            ro[i] = rc[i] + (pr_ - rc[i]) * mur[i]; const float k = kc[i] + (pk_ - kc[i]) * muk[i]; vo[i] = vc[i] + (pv_ - vc[i]) * muv[i];
            av[i] = sigmoidf_(a0v[i] + al[i]);
            wo[i] = __expf(-0.6065306597126334f * sigmoidf_(w0[i] + wl[i]));
            kk[i] = k * kkw[i]; ss += kk[i] * kk[i];
            ko[i] = k * (1.f + (av[i] - 1.f) * kaw[i]);
        }
        ss += __shfl_xor(ss, 1); ss += __shfl_xor(ss, 2); ss += __shfl_xor(ss, 4);
        const float inv = 1.f / fmaxf(sqrtf(ss), 1e-12f);
#pragma unroll
        for (int i = 0; i < 8; ++i) { kk[i] *= inv; kka[i] = kk[i] * av[i]; }
        const size_t o = (size_t)row * 512 + c0;
        *(f32x4*)((float*)(ws + WS_RW_W) + o) = (f32x4){wo[0], wo[1], wo[2], wo[3]}; *(f32x4*)((float*)(ws + WS_RW_W) + o + 4) = (f32x4){wo[4], wo[5], wo[6], wo[7]};
        *(u32x4*)((bf16_t*)(ws + WS_RW_R) + o) = pack8(ro); *(u32x4*)((bf16_t*)(ws + WS_RW_K) + o) = pack8(ko); *(u32x4*)((bf16_t*)(ws + WS_RW_V) + o) = pack8(vo);
        *(u32x4*)((bf16_t*)(ws + WS_RW_KK) + o) = pack8(kk); *(u32x4*)((bf16_t*)(ws + WS_RW_KKA) + o) = pack8(kka); *(u32x4*)((bf16_t*)(ws + WS_RW_G) + o) = gg8;
    }
}

namespace att {
typedef float f32x16 __attribute__((ext_vector_type(16)));
typedef short s16x4 __attribute__((ext_vector_type(4)));
typedef float f32x2_t __attribute__((ext_vector_type(2)));
typedef __bf16 bf16x2_t __attribute__((ext_vector_type(2)));
constexpr float C2 = 0.125f * 1.4426950408889634f;
constexpr int SLOT = 16384;
constexpr int GROUP = 3, NSLOT = 2 * GROUP;
constexpr int IMP_STRIDE = 136;
constexpr int WAVE_LDS = 256 + 8 * IMP_STRIDE * 4 + 128;
constexpr int WAVE_OFF = NSLOT * SLOT;
constexpr int LDS_NEED = WAVE_OFF + NWAVES * WAVE_LDS;
constexpr int QT = 8 * NWAVES;
constexpr float THR = 8.f;

__device__ __forceinline__ int crow(int r, int hi) { return (r & 3) + 8 * (r >> 2) + 4 * hi; }
__device__ __forceinline__ unsigned cvtpk(float lo, float hi) { f32x2_t v = {lo, hi}; bf16x2_t b = __builtin_convertvector(v, bf16x2_t); return __builtin_bit_cast(unsigned, b); }
__device__ __forceinline__ float ex2(float x) { return __builtin_amdgcn_exp2f(x); }

__device__ __forceinline__ void tile_dma(const unsigned char* gt, LAS unsigned char* slot, int wid, int lane) {
    const unsigned char* src = gt + wid * 2048 + lane * 16;
    __builtin_amdgcn_global_load_lds((const unsigned*)src, (LAS unsigned*)(slot + wid * 2048), 16, 0, 0);
    __builtin_amdgcn_global_load_lds((const unsigned*)(src + 1024), (LAS unsigned*)(slot + wid * 2048 + 1024), 16, 0, 0);
}
__device__ __forceinline__ void qkt(f32x16& p0, f32x16& p1, const LAS unsigned char* Kslot, const bf16x8 (&qr)[4], float cinit, int r32, int hi) {
    const LAS unsigned char* kb = Kslot + hi * 1024 + r32 * 16;
#pragma unroll
    for (int r = 0; r < 16; ++r) { p0[r] = cinit; p1[r] = cinit; }
#pragma unroll
    for (int d0 = 0; d0 < 4; ++d0) {
        const bf16x8 b0 = *(const LAS bf16x8*)(kb + d0 * 2048);
        const bf16x8 b1 = *(const LAS bf16x8*)(kb + d0 * 2048 + 512);
        p0 = __builtin_amdgcn_mfma_f32_32x32x16_bf16(b0, qr[d0], p0, 0, 0, 0);
        p1 = __builtin_amdgcn_mfma_f32_32x32x16_bf16(b1, qr[d0], p1, 0, 0, 0);
    }
}
struct VFrag { s16x4 lo[2][4], hi[2][4]; };
__device__ __forceinline__ void pv_read(VFrag& v, int vb) {
#pragma unroll
    for (int d0 = 0; d0 < 2; ++d0)
#pragma unroll
        for (int ks = 0; ks < 4; ++ks) {
            asm volatile("ds_read_b64_tr_b16 %0,%1 offset:%c2" : "=&v"(v.lo[d0][ks]) : "v"(vb), "i"(d0 * 4096 + ks * 1024) : "memory");
            asm volatile("ds_read_b64_tr_b16 %0,%1 offset:%c2" : "=&v"(v.hi[d0][ks]) : "v"(vb), "i"(d0 * 4096 + ks * 1024 + 512) : "memory");
        }
}
__device__ __forceinline__ void pv_mma(f32x16 (&o)[2], VFrag& v, bf16x8 pa0, bf16x8 pa1, bf16x8 pa2, bf16x8 pa3) {
    asm volatile("s_waitcnt lgkmcnt(0)" : "+v"(v.lo[0][0]), "+v"(v.lo[0][1]), "+v"(v.lo[0][2]), "+v"(v.lo[0][3]), "+v"(v.hi[0][0]), "+v"(v.hi[0][1]), "+v"(v.hi[0][2]), "+v"(v.hi[0][3]) :: "memory");
    asm volatile("" : "+v"(v.lo[1][0]), "+v"(v.lo[1][1]), "+v"(v.lo[1][2]), "+v"(v.lo[1][3]), "+v"(v.hi[1][0]), "+v"(v.hi[1][1]), "+v"(v.hi[1][2]), "+v"(v.hi[1][3]));
#pragma unroll
    for (int d0 = 0; d0 < 2; ++d0) {
#define ATT_PK(k) (bf16x8){v.lo[d0][k][0], v.lo[d0][k][1], v.lo[d0][k][2], v.lo[d0][k][3], v.hi[d0][k][0], v.hi[d0][k][1], v.hi[d0][k][2], v.hi[d0][k][3]}
        o[d0] = __builtin_amdgcn_mfma_f32_32x32x16_bf16(pa0, ATT_PK(0), o[d0], 0, 0, 0);
        o[d0] = __builtin_amdgcn_mfma_f32_32x32x16_bf16(pa1, ATT_PK(1), o[d0], 0, 0, 0);
        o[d0] = __builtin_amdgcn_mfma_f32_32x32x16_bf16(pa2, ATT_PK(2), o[d0], 0, 0, 0);
        o[d0] = __builtin_amdgcn_mfma_f32_32x32x16_bf16(pa3, ATT_PK(3), o[d0], 0, 0, 0);
#undef ATT_PK
    }
}
__device__ __forceinline__ float max3f(float a, float b, float c) { float r; asm("v_max3_f32 %0, %1, %2, %3" : "=v"(r) : "v"(a), "v"(b), "v"(c)); return r; }
__device__ __forceinline__ float max32(const f32x16& p0, const f32x16& p1) {
    float a = max3f(p0[0], p0[1], p1[0]), b = max3f(p0[2], p0[3], p1[1]); a = max3f(a, p1[2], p1[3]);
#pragma unroll
    for (int r = 4; r < 16; r += 4) { a = max3f(a, p0[r], p0[r + 1]); b = max3f(b, p0[r + 2], p0[r + 3]); a = max3f(a, p1[r], p1[r + 1]); b = max3f(b, p1[r + 2], p1[r + 3]); }
    a = fmaxf(a, b);
    return fmaxf(a, __shfl_xor(a, 32));
}
__device__ __forceinline__ void pack_p(const f32x16& p0, const f32x16& p1, bf16x8& a0, bf16x8& a1, bf16x8& a2, bf16x8& a3) {
    u32x4 w0 = {cvtpk(p0[0], p0[1]), cvtpk(p0[2], p0[3]), cvtpk(p0[4], p0[5]), cvtpk(p0[6], p0[7])};
    u32x4 w1 = {cvtpk(p0[8], p0[9]), cvtpk(p0[10], p0[11]), cvtpk(p0[12], p0[13]), cvtpk(p0[14], p0[15])};
    u32x4 w2 = {cvtpk(p1[0], p1[1]), cvtpk(p1[2], p1[3]), cvtpk(p1[4], p1[5]), cvtpk(p1[6], p1[7])};
    u32x4 w3 = {cvtpk(p1[8], p1[9]), cvtpk(p1[10], p1[11]), cvtpk(p1[12], p1[13]), cvtpk(p1[14], p1[15])};
    a0 = __builtin_bit_cast(bf16x8, w0); a1 = __builtin_bit_cast(bf16x8, w1); a2 = __builtin_bit_cast(bf16x8, w2); a3 = __builtin_bit_cast(bf16x8, w3);
}
__device__ __forceinline__ void bcast_rows(LAS float* wsf, float v, int r32, int hi, float (&f)[16]) {
    if (hi == 0) wsf[r32] = v;
    asm volatile("s_waitcnt lgkmcnt(0)" ::: "memory");
#pragma unroll
    for (int r = 0; r < 16; ++r) f[r] = wsf[crow(r, hi)];
    asm volatile("s_waitcnt lgkmcnt(0)" ::: "memory");
}

template <int MODE, class PreF, class MaskF>
__device__ __forceinline__ void flash_pass(LAS unsigned char* lds, LAS float* wsf, LAS float* imp, const unsigned char* img, int t_lo, int t_hi,
                                           const bf16x8 (&qr)[4], PreF pref, MaskF maskf, float& m, float& l, f32x16 (&o)[2], int r32, int hi) {
    if (t_lo > t_hi) return;
    const int tid = tidx(), wid = __builtin_amdgcn_readfirstlane(tid >> 6), lane = tid & 63;
    const int ngroups = (t_hi - t_lo + GROUP) / GROUP;
    for (int tt = 0; tt < GROUP; ++tt) if (t_lo + tt <= t_hi) tile_dma(img + (size_t)(t_lo + tt) * SLOT, lds + tt * SLOT, wid, lane);
    asm volatile("s_waitcnt vmcnt(0)" ::: "memory");
    __syncthreads();
    const int vbl = (int)(unsigned)(uintptr_t)(lds + 8192) + ((tid >> 4) & 1) * 32 + (tid & 3) * 8 + (4 * hi + ((tid & 15) >> 2)) * 64;
    float carry_prev = 0.f; bool fresh = (MODE != 1);
    for (int gi = 0; gi < ngroups; ++gi) {
        const int half = (gi & 1) * GROUP;
        if (gi + 1 < ngroups) {
            for (int tt = 0; tt < GROUP; ++tt) { const int t = t_lo + (gi + 1) * GROUP + tt; if (t <= t_hi) tile_dma(img + (size_t)t * SLOT, lds + ((GROUP - half) + tt) * SLOT, wid, lane); }
        }
#pragma unroll 1
        for (int tt = 0; tt < GROUP; ++tt) {
            const int t = t_lo + gi * GROUP + tt;
            if (t > t_hi) break;
            bool sel = true;
            const bool act = pref(t, sel);
            if (!act) { if (MODE == 1) carry_prev = 0.f; continue; }
            LAS unsigned char* buf = lds + (half + tt) * SLOT;
            f32x16 p0, p1;
            qkt(p0, p1, buf, qr, sel ? -m : -__builtin_inff(), r32, hi);
            VFrag vf;
            if (MODE != 0) pv_read(vf, vbl + (half + tt) * SLOT);
            maskf(t, p0, p1);
            if (MODE == 0 || MODE == 2) {
                const float rm = max32(p0, p1);
                const float dl = ((fresh || rm > THR) && rm > -3.0e38f) ? rm : 0.f;
                if (__any(dl != 0.f)) {
#pragma unroll
                    for (int r = 0; r < 16; ++r) { p0[r] -= dl; p1[r] -= dl; }
                    m += dl; const float alpha = ex2(-dl); l *= alpha;
                    if (MODE == 2 && !fresh) {
                        float f[16]; bcast_rows(wsf, alpha, r32, hi, f);
#pragma unroll
                        for (int r = 0; r < 16; ++r) { o[0][r] *= f[r]; o[1][r] *= f[r]; }
                    }
                }
                fresh = false;
                float sum = 0.f;
#pragma unroll
                for (int r = 0; r < 16; ++r) { p0[r] = ex2(p0[r]); p1[r] = ex2(p1[r]); sum += p0[r] + p1[r]; }
                l += sum;
            } else {
#pragma unroll
                for (int r = 0; r < 16; ++r) { p0[r] = ex2(p0[r]) * l; p1[r] = ex2(p1[r]) * l; }
                float a[8], cy[8];
#pragma unroll
                for (int k = 0; k < 4; ++k) {
                    a[k] = (p0[4 * k] + p0[4 * k + 1]) + (p0[4 * k + 2] + 0.5f * p0[4 * k + 3]); cy[k] = 0.5f * p0[4 * k + 3];
                    a[4 + k] = (p1[4 * k] + p1[4 * k + 1]) + (p1[4 * k + 2] + 0.5f * p1[4 * k + 3]); cy[4 + k] = 0.5f * p1[4 * k + 3];
                }
                float cx[8];
#pragma unroll
                for (int q8 = 0; q8 < 8; ++q8) cx[q8] = __shfl_xor(cy[q8], 32);
#pragma unroll
                for (int q8 = 0; q8 < 8; ++q8) {
                    float v = a[q8] + (hi ? cx[q8] : (q8 > 0 ? cx[q8 - 1] : carry_prev));
                    v += __shfl_xor(v, 1); v += __shfl_xor(v, 2);
                    if ((r32 & 3) == 0) imp[(r32 >> 2) * IMP_STRIDE + 16 * t + 2 * q8 + hi] = v;
                }
                carry_prev = cx[7];
            }
            if (MODE != 0) {
                bf16x8 a0, a1, a2, a3; pack_p(p0, p1, a0, a1, a2, a3);
                pv_mma(o, vf, a0, a1, a2, a3);
            }
        }
        asm volatile("s_waitcnt vmcnt(0)" ::: "memory");
        __syncthreads();
    }
}

__device__ __forceinline__ void nsa_unit(const Params& P, int b, int g, int t0, LAS unsigned char* lds) {
    unsigned char* ws = P.ws;
    const bf16_t* proj = (const bf16_t*)(ws + WS_PROJ);
    const int tid = tidx(), wid = tid >> 6, lane = tid & 63, r32 = lane & 31, hi = lane >> 5;
    LAS unsigned char* wl = lds + WAVE_OFF + wid * WAVE_LDS;
    LAS float* wsf = (LAS float*)wl; LAS float* imp = (LAS float*)(wl + 256); LAS unsigned* selm = (LAS unsigned*)(wl + 256 + 8 * IMP_STRIDE * 4);
    const int tq = t0 + 8 * wid + (r32 >> 2), head = g * 4 + (r32 & 3);
    const int tq_lo = __builtin_amdgcn_readfirstlane(t0 + 8 * wid);
    const size_t row = (size_t)b * S + tq;
    bf16x8 qr[4];
#pragma unroll
    for (int d0 = 0; d0 < 4; ++d0) {
        const u32x4 raw = *(const u32x4*)(proj + row * NP + Q0 + head * 64 + d0 * 16 + hi * 8);
        u32x4 sc;
        sc.x = cvtpk(__builtin_bit_cast(float, raw.x << 16) * C2, __builtin_bit_cast(float, raw.x & 0xffff0000u) * C2); sc.y = cvtpk(__builtin_bit_cast(float, raw.y << 16) * C2, __builtin_bit_cast(float, raw.y & 0xffff0000u) * C2);
        sc.z = cvtpk(__builtin_bit_cast(float, raw.z << 16) * C2, __builtin_bit_cast(float, raw.z & 0xffff0000u) * C2); sc.w = cvtpk(__builtin_bit_cast(float, raw.w << 16) * C2, __builtin_bit_cast(float, raw.w & 0xffff0000u) * C2);
        qr[d0] = __builtin_bit_cast(bf16x8, sc);
    }
    const bf16_t* gl = proj + row * NP + GL0 + head * 3;
    const float g0 = sigmoidf_(bf2f(gl[0])), g1 = sigmoidf_(bf2f(gl[1])), g2 = sigmoidf_(bf2f(gl[2]));
    f32x16 o[2], out[2];
    auto emit = [&](float fac, bool first) {
        if (hi == 0) wsf[r32] = fac;
        asm volatile("s_waitcnt lgkmcnt(0)" ::: "memory");
#pragma unroll
        for (int r = 0; r < 16; ++r) {
            const float f = wsf[crow(r, hi)];
            if (first) { out[0][r] = o[0][r] * f; out[1][r] = o[1][r] * f; } else { out[0][r] += o[0][r] * f; out[1][r] += o[1][r] * f; }
        }
        asm volatile("s_waitcnt lgkmcnt(0)" ::: "memory");
    };
    const float NINF = -__builtin_inff();
    auto pre_all = [&](int, bool&) -> bool { return true; };
    for (int i = lane; i < 8 * IMP_STRIDE; i += 64) imp[i] = 0.f;
    {
        const unsigned char* img = ws + WS_CMPI + (size_t)(b * 2 + g) * 8 * SLOT;
        const int c_hi = (t0 + QT - 32) >> 10;
        const int ivis = tq >= 31 ? ((tq - 31) >> 4) : -1;
        const int ivis_lo = tq_lo >= 31 ? ((tq_lo - 31) >> 4) : -1;
        auto maskc = [&](int t, f32x16& p0, f32x16& p1) {
            if (64 * t + 63 > ivis_lo) {
                const int kb = 64 * t + 4 * hi;
#pragma unroll
                for (int r = 0; r < 16; ++r) { const int i = kb + (r & 3) + 8 * (r >> 2); if (i > ivis) p0[r] = NINF; if (i + 32 > ivis) p1[r] = NINF; }
            }
        };
        float m = 0.f, l = 0.f;
        flash_pass<0>(lds, wsf, imp, img, 0, c_hi, qr, pre_all, maskc, m, l, o, r32, hi);
        l += __shfl_xor(l, 32);
        float linv = l > 0.f ? 1.f / l : 0.f;
        o[0] = (f32x16){0.f}; o[1] = (f32x16){0.f};
        flash_pass<1>(lds, wsf, imp, img, 0, c_hi, qr, pre_all, maskc, m, linv, o, r32, hi);
        emit(g0, true);
    }
    unsigned sw0, sw1, sw2, sw3;
    {
        const int tok = lane >> 3, sub = lane & 7, tqs = t0 + 8 * wid + tok, cur = tqs >> 6;
        float val[16];
#pragma unroll
        for (int e = 0; e < 16; ++e) {
            const int j = 8 * e + sub; float x = imp[tok * IMP_STRIDE + j];
            if (j * 64 > tqs) x = -1.0e30f; else if (j == 0 || j == cur || j == cur - 1) x = 1.0e9f;
            val[e] = x;
        }
        unsigned m0 = 0u, m1 = 0u, m2 = 0u, m3 = 0u;
#pragma unroll 1
        for (int r = 0; r < 16; ++r) {
            float bv = val[0]; int bj = sub;
#pragma unroll
            for (int e = 1; e < 16; ++e) if (val[e] > bv) { bv = val[e]; bj = 8 * e + sub; }
#pragma unroll
            for (int o2 = 1; o2 < 8; o2 <<= 1) { const float ov = __shfl_xor(bv, o2); const int oj = __shfl_xor(bj, o2); if (ov > bv || (ov == bv && oj < bj)) { bv = ov; bj = oj; } }
            if (bv > -1.0e29f) {
                const unsigned bit = 1u << (bj & 31); const int wq = bj >> 5;
                m0 |= wq == 0 ? bit : 0u; m1 |= wq == 1 ? bit : 0u; m2 |= wq == 2 ? bit : 0u; m3 |= wq == 3 ? bit : 0u;
#pragma unroll
                for (int e = 0; e < 16; ++e) if (bj == 8 * e + sub) val[e] = -3.0e38f;
            }
        }
        if (sub == 0) { selm[tok * 4 + 0] = m0; selm[tok * 4 + 1] = m1; selm[tok * 4 + 2] = m2; selm[tok * 4 + 3] = m3; }
        asm volatile("s_waitcnt lgkmcnt(0)" ::: "memory");
        sw0 = selm[(r32 >> 2) * 4 + 0]; sw1 = selm[(r32 >> 2) * 4 + 1]; sw2 = selm[(r32 >> 2) * 4 + 2]; sw3 = selm[(r32 >> 2) * 4 + 3];
        asm volatile("s_waitcnt lgkmcnt(0)" ::: "memory");
    }
    {
        const unsigned char* img = ws + WS_KVI + (size_t)((0 * NB + b) * 2 + g) * (S / 64) * SLOT;
        auto pres = [&](int t, bool& sel) -> bool {
            const unsigned w = t < 32 ? sw0 : (t < 64 ? sw1 : (t < 96 ? sw2 : sw3));
            sel = (w >> (t & 31)) & 1u;
            return __any(sel);
        };
        auto masks = [&](int t, f32x16& p0, f32x16& p1) {
            if (64 * t + 63 > tq_lo) {
                const int kb0 = 64 * t + 4 * hi;
#pragma unroll
                for (int r = 0; r < 16; ++r) { const int pos = kb0 + (r & 3) + 8 * (r >> 2); if (pos > tq) p0[r] = NINF; if (pos + 32 > tq) p1[r] = NINF; }
            }
        };
        float m = 0.f, l = 0.f; o[0] = (f32x16){0.f}; o[1] = (f32x16){0.f};
        flash_pass<2>(lds, wsf, imp, img, 0, (t0 + QT - 1) >> 6, qr, pres, masks, m, l, o, r32, hi);
        l += __shfl_xor(l, 32);
        emit(l > 0.f ? g1 / l : 0.f, false);
    }
    {
        const unsigned char* img = ws + WS_KVI + (size_t)((1 * NB + b) * 2 + g) * (S / 64) * SLOT;
        auto maskw = [&](int t, f32x16& p0, f32x16& p1) {
            if (64 * t + 63 > tq_lo || 64 * t < tq_lo + 7 - 511) {
                const int kb0 = 64 * t + 4 * hi;
#pragma unroll
                for (int r = 0; r < 16; ++r) { const int pos = kb0 + (r & 3) + 8 * (r >> 2); if (pos > tq || pos < tq - 511) p0[r] = NINF; if (pos + 32 > tq || pos + 32 < tq - 511) p1[r] = NINF; }
            }
        };
        float m = 0.f, l = 0.f; o[0] = (f32x16){0.f}; o[1] = (f32x16){0.f};
        const int lo = t0 - 511 > 0 ? (t0 - 511) >> 6 : 0;
        flash_pass<2>(lds, wsf, imp, img, lo, (t0 + QT - 1) >> 6, qr, pre_all, maskw, m, l, o, r32, hi);
        l += __shfl_xor(l, 32);
        emit(l > 0.f ? g2 / l : 0.f, false);
    }
    bf16_t* on = (bf16_t*)(ws + WS_ONSA) + ((size_t)b * S + t0 + 8 * wid) * 512 + g * 256 + r32;
#pragma unroll
    for (int r = 0; r < 16; ++r) {
        const int q = crow(r, hi); bf16_t* op = on + (size_t)(q >> 2) * 512 + (q & 3) * 64;
        op[0] = (bf16_t)f2bf(out[0][r]); op[32] = (bf16_t)f2bf(out[1][r]);
    }
}
}

template <int CTRL> __device__ __forceinline__ float dppf(float v) { return __builtin_bit_cast(float, __builtin_amdgcn_update_dpp(0, __builtin_bit_cast(int, v), CTRL, 0xf, 0xf, true)); }
__device__ __forceinline__ float sum16(float v) { v += dppf<0x128>(v); v += dppf<0x124>(v); v += dppf<0x122>(v); v += dppf<0x121>(v); return v; }
struct ScanRegs { f32x4 w0, w1; u32x4 kk, ka, k, r; unsigned v; };
__device__ __forceinline__ f32x4 bflo(u32x4 u) { return (f32x4){__builtin_bit_cast(float, u.x << 16), __builtin_bit_cast(float, u.x & 0xffff0000u), __builtin_bit_cast(float, u.y << 16), __builtin_bit_cast(float, u.y & 0xffff0000u)}; }
__device__ __forceinline__ f32x4 bfhi(u32x4 u) { return (f32x4){__builtin_bit_cast(float, u.z << 16), __builtin_bit_cast(float, u.z & 0xffff0000u), __builtin_bit_cast(float, u.w << 16), __builtin_bit_cast(float, u.w & 0xffff0000u)}; }
__device__ __forceinline__ void rwkv_scan_unit(const Params& P, int b, int h, int qr, int unit, float* sm  ) {
    unsigned char* ws = P.ws;
    const int tid = tidx(); const bool comp = tid < 256;
    const int rowl = (tid & 255) >> 4, l16 = tid & 15;
    const int lst = (tid & 255) >> 3, j8 = tid & 7;
    float s0 = 0.f, s1 = 0.f, s2 = 0.f, s3 = 0.f;
    const float* Ww = (const float*)(ws + WS_RW_W);
    const bf16_t* Rr = (const bf16_t*)(ws + WS_RW_R); const bf16_t* Kk = (const bf16_t*)(ws + WS_RW_K); const bf16_t* Vv = (const bf16_t*)(ws + WS_RW_V);
    const bf16_t* KK = (const bf16_t*)(ws + WS_RW_KK); const bf16_t* KA = (const bf16_t*)(ws + WS_RW_KKA);
    float* Y = (float*)(ws + WS_Y);
    constexpr int SR = 336, CH = 32 * SR;
    auto gload = [&](ScanRegs& R, int t0) {
        const size_t base = ((size_t)b * S + t0 + lst) * 512 + h * 64 + 8 * j8;
        R.w0 = *(const f32x4*)(Ww + base); R.w1 = *(const f32x4*)(Ww + base + 4); R.kk = *(const u32x4*)(KK + base); R.ka = *(const u32x4*)(KA + base);
        R.k = *(const u32x4*)(Kk + base); R.r = *(const u32x4*)(Rr + base); R.v = *(const unsigned*)(Vv + base - 8 * j8 + qr * 16 + 2 * j8);
    };
    auto lstore = [&](const ScanRegs& R, float* buf) {
        float* q = buf + lst * SR + 8 * j8;
        *(f32x4*)q = R.w0; *(f32x4*)(q + 4) = R.w1; *(f32x4*)(q + 64) = bflo(R.kk); *(f32x4*)(q + 68) = bfhi(R.kk); *(f32x4*)(q + 128) = bflo(R.ka); *(f32x4*)(q + 132) = bfhi(R.ka);
        *(f32x4*)(q + 192) = bflo(R.k); *(f32x4*)(q + 196) = bfhi(R.k); *(f32x4*)(q + 256) = bflo(R.r); *(f32x4*)(q + 260) = bfhi(R.r);
        buf[lst * SR + 320 + 2 * j8] = __builtin_bit_cast(float, R.v << 16); buf[lst * SR + 321 + 2 * j8] = __builtin_bit_cast(float, R.v & 0xffff0000u);
    };
    typedef float f2 __attribute__((ext_vector_type(2)));
    auto compute16 = [&](const float* buf) -> float {
        const float* q0 = buf + l16 * 4; const float* qv = buf + 320 + rowl;
        f2 sa_ = {s0, s1}, sb_ = {s2, s3};
        f32x4 w = *(const f32x4*)(q0), kk = *(const f32x4*)(q0 + 64), ka = *(const f32x4*)(q0 + 128), k = *(const f32x4*)(q0 + 192), r = *(const f32x4*)(q0 + 256);
        float v = qv[0];
        float ep[16];
#pragma unroll
        for (int st = 0; st < 16; ++st) {
            f32x4 wn, kkn, kan, kn, rn; float vn;
            if (st < 15) { const float* q = q0 + (st + 1) * SR; wn = *(const f32x4*)(q); kkn = *(const f32x4*)(q + 64); kan = *(const f32x4*)(q + 128); kn = *(const f32x4*)(q + 192); rn = *(const f32x4*)(q + 256); vn = qv[(st + 1) * SR]; }
            const f2 d = sa_ * (f2){kk.x, kk.y} + sb_ * (f2){kk.z, kk.w};
            const float sa = -sum16(d.x + d.y);
            const f2 vv = {v, v}, ss = {sa, sa};
            const f2 ta = sa_ * (f2){w.x, w.y} + vv * (f2){k.x, k.y}, tb = sb_ * (f2){w.z, w.w} + vv * (f2){k.z, k.w};
            sa_ = ta + ss * (f2){ka.x, ka.y}; sb_ = tb + ss * (f2){ka.z, ka.w};
            const f2 e = sa_ * (f2){r.x, r.y} + sb_ * (f2){r.z, r.w};
            ep[st] = e.x + e.y;
            asm volatile("" : "+v"(ep[st]));
            if (st < 15) { w = wn; kk = kkn; ka = kan; k = kn; r = rn; v = vn; }
        }
        s0 = sa_.x; s1 = sa_.y; s2 = sb_.x; s3 = sb_.y;
        const bool b3 = (l16 & 8) != 0, b2 = (l16 & 4) != 0, b1 = (l16 & 2) != 0, b0 = (l16 & 1) != 0;
        float e8[8], e4[4], e2[2];
#pragma unroll
        for (int i = 0; i < 8; ++i) { const float keep = b3 ? ep[i + 8] : ep[i], send = b3 ? ep[i] : ep[i + 8]; e8[i] = keep + dppf<0x128>(send); }
#pragma unroll
        for (int i = 0; i < 4; ++i) { const float keep = b2 ? e8[i + 4] : e8[i], send = b2 ? e8[i] : e8[i + 4]; e4[i] = keep + dppf<0x141>(send); }
#pragma unroll
        for (int i = 0; i < 2; ++i) { const float keep = b1 ? e4[i + 2] : e4[i], send = b1 ? e4[i] : e4[i + 2]; e2[i] = keep + dppf<0x4E>(send); }
        { const float keep = b0 ? e2[1] : e2[0], send = b0 ? e2[0] : e2[1]; return keep + dppf<0xB1>(send); }
    };
    auto ystore = [&](float yk, int t0) { Y[((size_t)b * S + t0 + l16) * 512 + h * 64 + qr * 16 + rowl] = yk; };
    float* ct = sm + 2 * CH;
    constexpr int CT = 64 * 65;
    const int lt = tid & 255, ctx = lt & 63, cty = lt >> 6, cpp = lt >> 2, ckq = lt & 3;
    float cva[16], cvb[16];
    auto conv_src = [&](int tile, const float*& src, int& nsrc, unsigned char*& dst, int& p0, int& k0, int& col) {
        if (tile < 16384) { const int e = tile >> 9, q = tile & 511; src = P.in[I_EGU] + (size_t)e * 1024 * 2048; nsrc = 2048; dst = ws + WS_GU + (size_t)e * 2048 * 1024; p0 = (q >> 4) * 64; k0 = (q & 15) * 64; col = MapGU()(p0 + ctx); }
        else { const int t2 = tile - 16384, e = t2 >> 8, q = t2 & 255; src = P.in[I_EDN] + (size_t)e * 1024 * 1024; nsrc = 1024; dst = ws + WS_DN + (size_t)e * 1024 * 1024; p0 = (q >> 4) * 64; k0 = (q & 15) * 64; col = p0 + ctx; }
    };
    auto conv_load = [&](float (&cv)[16], int iv) {
        const int tile = unit * 192 + iv; if (iv >= 192 || !EXPERT_CONV_IN_SCAN) return;
        const float* src; int nsrc, p0, k0, col; unsigned char* dst; conv_src(tile, src, nsrc, dst, p0, k0, col);
#pragma unroll
        for (int i = 0; i < 16; ++i) cv[i] = src[(size_t)(k0 + cty + 4 * i) * nsrc + col];
    };
    auto conv_lds = [&](const float (&cv)[16], float* buf, int iv) {
        if (iv >= 192 || !EXPERT_CONV_IN_SCAN) return;
#pragma unroll
        for (int i = 0; i < 16; ++i) buf[(cty + 4 * i) * 65 + ctx] = cv[i];
    };
    auto conv_out = [&](const float* buf, int iv) {
        const int tile = unit * 192 + iv; if (iv >= 192 || !EXPERT_CONV_IN_SCAN) return;
        const float* src; int nsrc, p0, k0, col; unsigned char* dst; conv_src(tile, src, nsrc, dst, p0, k0, col);
        const float* tp = buf + (16 * ckq) * 65 + cpp;
        u32x4 o0;
        o0.x = pk4f8(32.f * tp[0], 32.f * tp[65], 32.f * tp[2 * 65], 32.f * tp[3 * 65]); o0.y = pk4f8(32.f * tp[4 * 65], 32.f * tp[5 * 65], 32.f * tp[6 * 65], 32.f * tp[7 * 65]);
        o0.z = pk4f8(32.f * tp[8 * 65], 32.f * tp[9 * 65], 32.f * tp[10 * 65], 32.f * tp[11 * 65]); o0.w = pk4f8(32.f * tp[12 * 65], 32.f * tp[13 * 65], 32.f * tp[14 * 65], 32.f * tp[15 * 65]);
        *(u32x4*)(dst + (size_t)(p0 + cpp) * 1024 + k0 + 16 * ckq) = o0;
    };
    ScanRegs RA, RB;
    __syncthreads();
    if (!comp) { gload(RA, 0); lstore(RA, sm); gload(RA, 32); gload(RB, 64); conv_load(cva, 0); conv_load(cvb, 1); }
    __syncthreads();
    if (comp) __builtin_amdgcn_s_setprio(3);
    for (int c = 0; c < S / 32; c += 2) {
        if (comp) { const float y0 = compute16(sm), y1 = compute16(sm + 16 * SR); ystore(y0, 32 * c); ystore(y1, 32 * c + 16); }
        else { lstore(RA, sm + CH); if (32 * (c + 3) < S) gload(RA, 32 * (c + 3)); conv_lds(cva, ct, c); }
        __syncthreads();
        if (comp) { const float y2 = compute16(sm + CH), y3 = compute16(sm + CH + 16 * SR); ystore(y2, 32 * (c + 1)); ystore(y3, 32 * (c + 1) + 16); }
        else { if (32 * (c + 2) < S) lstore(RB, sm); if (32 * (c + 4) < S) gload(RB, 32 * (c + 4)); conv_out(ct, c); conv_load(cva, c + 2); conv_lds(cvb, ct + CT, c + 1); }
        __syncthreads();
        if (!comp) { conv_out(ct + CT, c + 1); conv_load(cvb, c + 3); }
    }
    __builtin_amdgcn_s_setprio(0);
    __syncthreads();
}

__device__ __forceinline__ void phase5(const Params& P, LAS unsigned char* lds, float* ldsf) {
    constexpr int U_SCAN = NB * 8 * 4, U_ATT = NB * 2 * (S / att::QT);
    for (int u = blockIdx.x; u < U_SCAN; u += gridDim.x) rwkv_scan_unit(P, u >> 5, (u >> 2) & 7, u & 3, u, ldsf);
    unsigned* qhead = (unsigned*)(P.ws + WS_CTL) + 64;
    LAS int* slot = (LAS int*)(lds + LDS_RING + 64);
    for (;;) {
        __syncthreads();
        if (tidx() == 0) *slot = (int)atomicAdd(qhead, 1u);
        __syncthreads();
        const int a = *slot;
        if (a >= U_ATT) break;
        const int qt = (S / att::QT - 1) - (a >> 3), b = (a >> 1) & 3, g = a & 1;
        att::nsa_unit(P, b, g, qt * att::QT, lds);
    }
}


__device__ __forceinline__ void phase6(const Params& P) {
    unsigned char* ws = P.ws;
    const int lane = tidx() & 63, gw = blockIdx.x * NWAVES + (tidx() >> 6), ngw = gridDim.x * NWAVES, c0 = 8 * lane;
    bf16_t* amix = (bf16_t*)(ws + WS_RA);
    float gn[8], lw[8], lb[8], rk[8];
#pragma unroll
    for (int i = 0; i < 8; ++i) { gn[i] = P.in[I_NSANORM][c0 + i]; lw[i] = P.in[I_LNW][c0 + i]; lb[i] = P.in[I_LNB][c0 + i]; rk[i] = P.in[I_RK][c0 + i]; }
    for (int row = gw; row < T; row += ngw) {
        const size_t o = (size_t)row * 512 + c0;
        const u32x4 n8 = *(const u32x4*)((const bf16_t*)(ws + WS_ONSA) + o);
        const f32x4 y0 = *(const f32x4*)((const float*)(ws + WS_Y) + o), y1 = *(const f32x4*)((const float*)(ws + WS_Y) + o + 4);
        const u32x4 r8 = *(const u32x4*)((const bf16_t*)(ws + WS_RW_R) + o), k8 = *(const u32x4*)((const bf16_t*)(ws + WS_RW_K) + o), v8 = *(const u32x4*)((const bf16_t*)(ws + WS_RW_V) + o), g8 = *(const u32x4*)((const bf16_t*)(ws + WS_RW_G) + o);
        float nv[8]; unpack8(n8, nv); const float yv[8] = {y0.x, y0.y, y0.z, y0.w, y1.x, y1.y, y1.z, y1.w};
        float s = 0.f;
#pragma unroll
        for (int i = 0; i < 8; ++i) s += nv[i] * nv[i];
        const float rstd = rsqrtf(wave_sum(s) * (1.f / 512.f) + 1e-6f);
        float on[8];
#pragma unroll
        for (int i = 0; i < 8; ++i) on[i] = nv[i] * rstd * gn[i];
        *(u32x4*)(amix + (size_t)row * D + c0) = pack8(on);
        float rr[8], kk[8], vv[8], gg[8]; unpack8(r8, rr); unpack8(k8, kk); unpack8(v8, vv); unpack8(g8, gg);
        float sm = 0.f, bs = 0.f;
#pragma unroll
        for (int i = 0; i < 8; ++i) { sm += yv[i]; bs += rr[i] * kk[i] * rk[i]; }
        sm += __shfl_xor(sm, 1); sm += __shfl_xor(sm, 2); sm += __shfl_xor(sm, 4);
        bs += __shfl_xor(bs, 1); bs += __shfl_xor(bs, 2); bs += __shfl_xor(bs, 4);
        const float mean = sm * (1.f / 64.f); float vs = 0.f;
#pragma unroll
        for (int i = 0; i < 8; ++i) { const float d = yv[i] - mean; vs += d * d; }
        vs += __shfl_xor(vs, 1); vs += __shfl_xor(vs, 2); vs += __shfl_xor(vs, 4);
        const float rs = rsqrtf(vs * (1.f / 64.f) + 64e-5f);
        float oo[8];
#pragma unroll
        for (int i = 0; i < 8; ++i) oo[i] = ((yv[i] - mean) * rs * lw[i] + lb[i] + bs * vv[i]) * gg[i];
        *(u32x4*)(amix + (size_t)row * D + 512 + c0) = pack8(oo);
    }
}

struct EpiF32 {
    float* C; int ldc;
    __device__ __forceinline__ void operator()(const f32x4 (&acc)[2][2][4][2], const g8::Unit& u, int wr, int wc, int fr, int fq) const {
        const int row0 = u.x0 * 256 + wr * 64 + fr, col0 = u.x1 * 256 + wc * 32 + 4 * fq;
#pragma unroll
        for (int ai = 0; ai < 2; ++ai)
#pragma unroll
            for (int m = 0; m < 4; ++m) { float* rowp = C + (size_t)(row0 + ai * 128 + m * 16) * ldc + col0;
#pragma unroll
                for (int bj = 0; bj < 2; ++bj)
#pragma unroll
                    for (int n = 0; n < 2; ++n) *(f32x4*)(rowp + bj * 128 + n * 16) = acc[ai][bj][m][n]; }
    }
};
__device__ __forceinline__ void phase7(const Params& P, LAS unsigned char* lds) {
    unsigned char* ws = P.ws;
    SchedDense Sd{(const bf16_t*)(ws + WS_RA), (const bf16_t*)(ws + WS_WOUT), D, D, T / 256, D / 256};
    EpiBf16 E{(bf16_t*)(ws + WS_MIXED), D};
    g8::gemm_phase<true>(lds, D, D, Sd, E);
}

constexpr int LGS = 33;
__device__ __forceinline__ void phase9f(const Params& P, LAS unsigned char* lds) {
    unsigned char* ws = P.ws;
    const int tid = tidx(), wid = tid >> 6, lane = tid & 63;
    const float* ada = (const float*)(ws + WS_ADA);
    unsigned* cnt = (unsigned*)(ws + WS_CTL);
    LAS float* Wl = (LAS float*)lds;
    auto lgrow = [&](int tok) -> LAS float* { return tok < 62 ? (LAS float*)(lds + 131072) + tok * LGS : (LAS float*)(lds + LDS_RING + 1024) + (tok - 62) * LGS; };
    LAS unsigned* lcnt = (LAS unsigned*)(lds + LDS_RING + 1024 + 66 * LGS * 4);
    static_assert(131072 + 62 * LGS * 4 <= LDS_RING && LDS_RING + 1024 + 66 * LGS * 4 + 256 <= LDS_TOTAL, "phase 9 LDS layout");
    for (int q = tid; q < 8192; q += NTHREADS) {
        const int c = q >> 3, eq = q & 7; const f32x4 w = *(const f32x4*)(P.in[I_RW] + c * 32 + 4 * eq);
        *(LAS f32x4*)(Wl + ((((c >> 8) * 4 + (c & 3)) * 8 + eq) * 64 + ((c >> 2) & 63)) * 4) = w;
    }
    const bool b5 = (lane & 32) != 0, b4 = (lane & 16) != 0, b3 = (lane & 8) != 0, b2 = (lane & 4) != 0, b1 = (lane & 2) != 0, b0 = (lane & 1) != 0;
    for (int blk = blockIdx.x; blk < T / 128; blk += gridDim.x) {
        __syncthreads();
        { const int t0 = tidx(); if (t0 < 64) lcnt[t0] = 0u; }
        f32x4 A1[4], A2[4], A3[4];
        { const int b = (blk * 128) / S;
#pragma unroll
          for (int j = 0; j < 4; ++j) {
              const int c = 4 * (lane + 64 * j);
              A1[j] = *(const f32x4*)(P.in[I_MIXPOST] + c) * *(const f32x4*)(ada + b * 6144 + 2048 + c);
              A2[j] = *(const f32x4*)(P.in[I_FFNPRE] + c) * (*(const f32x4*)(ada + b * 6144 + 4096 + c) + 1.f);
              A3[j] = *(const f32x4*)(ada + b * 6144 + 3072 + c);
          } }
        for (int pr = 0; pr < 8; ++pr) {
            float hh[2][16];
            const int row0 = blk * 128 + wid * 16 + pr * 2;
            f32x4 xq[2][4]; u32x2 mq[2][4];
#pragma unroll
            for (int tk = 0; tk < 2; ++tk)
#pragma unroll
                for (int j = 0; j < 4; ++j) {
                    xq[tk][j] = ((const f32x4*)(P.in[I_X] + (size_t)(row0 + tk) * D) + lane)[64 * j];
                    mq[tk][j] = ((const u32x2*)((const bf16_t*)(ws + WS_MIXED) + (size_t)(row0 + tk) * D) + lane)[64 * j];
                }
#pragma unroll
            for (int tk = 0; tk < 2; ++tk) {
                const int row = row0 + tk;
                f32x4 m[4]; float sq = 0.f;
#pragma unroll
                for (int j = 0; j < 4; ++j) { const u32x2 w = mq[tk][j]; m[j] = (f32x4){__builtin_bit_cast(float, w.x << 16), __builtin_bit_cast(float, w.x & 0xffff0000u), __builtin_bit_cast(float, w.y << 16), __builtin_bit_cast(float, w.y & 0xffff0000u)};
                    sq += m[j].x * m[j].x + m[j].y * m[j].y + m[j].z * m[j].z + m[j].w * m[j].w; }
                const float rstd = rsqrtf(wave_sum(sq) * (1.f / D) + 1e-6f);
                f32x4 x1[4]; float s2 = 0.f;
#pragma unroll
                for (int j = 0; j < 4; ++j) {
                    x1[j] = xq[tk][j] + A1[j] * (m[j] * rstd);
                    s2 += x1[j].x * x1[j].x + x1[j].y * x1[j].y + x1[j].z * x1[j].z + x1[j].w * x1[j].w;
                    ((f32x4*)((float*)(ws + WS_X1) + (size_t)row * D))[lane + 64 * j] = x1[j];
                }
                const float rstd2 = rsqrtf(wave_sum(s2) * (1.f / D) + 1e-6f);
#pragma unroll
                for (int j = 0; j < 4; ++j) {
                    const f32x4 h = x1[j] * rstd2 * A2[j] + A3[j];
                    hh[tk][4 * j] = h.x; hh[tk][4 * j + 1] = h.y; hh[tk][4 * j + 2] = h.z; hh[tk][4 * j + 3] = h.w;
                    ((unsigned*)(ws + WS_H8 + (size_t)row * 1024))[lane + 64 * j] = pk4f8(__builtin_amdgcn_fmed3f(h.x, -448.f, 448.f), __builtin_amdgcn_fmed3f(h.y, -448.f, 448.f), __builtin_amdgcn_fmed3f(h.z, -448.f, 448.f), __builtin_amdgcn_fmed3f(h.w, -448.f, 448.f));
                }
            }
            typedef float f2 __attribute__((ext_vector_type(2)));
            f2 ac[2][16];
#pragma unroll
            for (int v = 0; v < 16; ++v) { ac[0][v] = (f2){0.f, 0.f}; ac[1][v] = (f2){0.f, 0.f}; }
            const LAS f32x4* wp = (const LAS f32x4*)Wl + lane;
            f32x4 wa[4], wb[4];
#define P9_LDW(dst, g) do { _Pragma("unroll") for (int q = 0; q < 4; ++q) dst[q] = wp[((g) * 4 + q) * 64]; } while (0)
#define P9_FMW(src, g) do { const float h0 = hh[0][(g) >> 1], h1 = hh[1][(g) >> 1]; _Pragma("unroll") for (int q = 0; q < 4; ++q) { const int eq = 4 * ((g) & 1) + q; const f2 w01 = {src[q].x, src[q].y}, w23 = {src[q].z, src[q].w}; \
                ac[0][2 * eq] += w01 * h0; ac[0][2 * eq + 1] += w23 * h0; ac[1][2 * eq] += w01 * h1; ac[1][2 * eq + 1] += w23 * h1; } } while (0)
            P9_LDW(wa, 0);
#pragma unroll
            for (int g = 0; g < 32; g += 2) {
                P9_LDW(wb, g + 1); __builtin_amdgcn_sched_barrier(0);
                P9_FMW(wa, g); __builtin_amdgcn_sched_barrier(0);
                if (g + 2 < 32) P9_LDW(wa, g + 2);
                __builtin_amdgcn_sched_barrier(0);
                P9_FMW(wb, g + 1); __builtin_amdgcn_sched_barrier(0);
            }
#undef P9_LDW
#undef P9_FMW
            float a64[64];
#pragma unroll
            for (int v = 0; v < 16; ++v) { a64[2 * v] = ac[0][v].x; a64[2 * v + 1] = ac[0][v].y; a64[32 + 2 * v] = ac[1][v].x; a64[32 + 2 * v + 1] = ac[1][v].y; }
            float a32[32], a16[16], a8[8], a4[4], a2[2];
#pragma unroll
            for (int i = 0; i < 32; ++i) { const float keep = b5 ? a64[i + 32] : a64[i], send = b5 ? a64[i] : a64[i + 32]; a32[i] = keep + __shfl_xor(send, 32); }
#pragma unroll
            for (int i = 0; i < 16; ++i) { const float keep = b4 ? a32[i + 16] : a32[i], send = b4 ? a32[i] : a32[i + 16]; a16[i] = keep + __shfl_xor(send, 16); }
#pragma unroll
            for (int i = 0; i < 8; ++i) { const float keep = b3 ? a16[i + 8] : a16[i], send = b3 ? a16[i] : a16[i + 8]; a8[i] = keep + __shfl_xor(send, 8); }
#pragma unroll
            for (int i = 0; i < 4; ++i) { const float keep = b2 ? a8[i + 4] : a8[i], send = b2 ? a8[i] : a8[i + 4]; a4[i] = keep + __shfl_xor(send, 4); }
#pragma unroll
            for (int i = 0; i < 2; ++i) { const float keep = b1 ? a4[i + 2] : a4[i], send = b1 ? a4[i] : a4[i + 2]; a2[i] = keep + __shfl_xor(send, 2); }
            { const float keep = b0 ? a2[1] : a2[0], send = b0 ? a2[0] : a2[1];
              lgrow(wid * 16 + pr * 2 + (lane >> 5))[lane & 31] = keep + __shfl_xor(send, 1); }
        }
        __syncthreads();
        const int t2 = tidx();
        int ti[4] = {0, 0, 0, 0}; float wv[4] = {0.f, 0.f, 0.f, 0.f}; unsigned rk[4] = {0u, 0u, 0u, 0u};
        const int row = blk * 128 + t2;
        if (t2 < 128) {
            float lg[32];
            { const LAS float* lr = lgrow(t2);
#pragma unroll
              for (int e = 0; e < 32; ++e) lg[e] = lr[e] + P.in[I_RB][e]; }
            float tv[4];
#pragma unroll
            for (int r = 0; r < 4; ++r) {
                float bv = lg[0]; int bi = 0;
#pragma unroll
                for (int e = 1; e < 32; ++e) if (lg[e] > bv) { bv = lg[e]; bi = e; }
                tv[r] = bv; ti[r] = bi;
#pragma unroll
                for (int e = 0; e < 32; ++e) if (e == bi) lg[e] = -3.0e38f;
            }
            const float e1 = __expf(tv[1] - tv[0]), e2 = __expf(tv[2] - tv[0]), e3 = __expf(tv[3] - tv[0]);
            const float inv = 1.f / (1.f + e1 + e2 + e3);
            wv[0] = inv; wv[1] = e1 * inv; wv[2] = e2 * inv; wv[3] = e3 * inv;
#pragma unroll
            for (int r = 0; r < 4; ++r) rk[r] = atomicAdd((unsigned*)(lcnt + ti[r]), 1u);
        }
        __syncthreads();
        if (t2 < 32) lcnt[32 + t2] = atomicAdd(cnt + t2, lcnt[t2]);
        __syncthreads();
        if (t2 < 128) {
#pragma unroll
            for (int r = 0; r < 4; ++r) {
                const unsigned pos = lcnt[32 + ti[r]] + rk[r];
                ((u32x2*)(ws + WS_LIST))[(size_t)ti[r] * T + pos] = (u32x2){(unsigned)(row * 4 + r), 0u};
                ((unsigned*)(ws + WS_TOKW))[row * 4 + r] = ((unsigned)ti[r] << 20) | pos;
                ((float*)(ws + WS_TOKW + 524288))[row * 4 + r] = wv[r];
            }
        }
    }
}

constexpr int MOE_TAB_OFF = LDS_RING + 256;
__device__ __forceinline__ void moe_table(const unsigned* cnt, int ntn, LAS unsigned char* lds) {
    LAS int* tab = (LAS int*)(lds + MOE_TAB_OFF);
    __syncthreads();
    if (tidx() < 64) {
        const int lane = tidx(); const int c = lane < NE ? (int)cnt[lane] : 0, m = (c + 255) >> 8;
        int inc = m;
#pragma unroll
        for (int o = 1; o < 32; o <<= 1) { const int t = __shfl_up(inc, o); if (lane >= o) inc += t; }
        if (lane < NE) { tab[lane] = (inc - m) * ntn; tab[64 + lane] = (inc - m) * 256; tab[128 + lane] = c; }
        if (lane == NE - 1) tab[NE] = inc * ntn;
    }
    __syncthreads();
}
__device__ __forceinline__ bool moe_unit(LAS unsigned char* lds, int u, int ntn, int& e, int& mt, int& nt, int& base_rows, int& ce) {
    const LAS int* tab = (const LAS int*)(lds + MOE_TAB_OFF);
    const int lane = tidx() & 63;
    if (u >= tab[NE]) return false;
    const int st = lane < NE ? tab[lane] : 0x7fffffff;
    const unsigned long long bal = __ballot(u >= st);
    e = __builtin_popcountll(bal) - 1;
    const int r = u - tab[e]; mt = r / ntn; nt = r % ntn; base_rows = tab[64 + e]; ce = tab[128 + e];
    return true;
}
struct SchedGU {
    LAS unsigned char* lds; const u32x2* list; const unsigned char* H8; const unsigned char* W;
    __device__ __forceinline__ bool next(int i, g8::Unit& u, int R0, int C0, int R1, int C1) const {
        int e, mt, nt, base, ce; if (!moe_unit(lds, (int)((blockIdx.x & 7) * (gridDim.x >> 3) + (blockIdx.x >> 3)) + i * (int)gridDim.x, 8, e, mt, nt, base, ce)) return false;
        const u32x2* le = list + (size_t)e * T;
        const int i00 = mt * 256 + R0, i01 = mt * 256 + R1, i10 = i00 + 128, i11 = i01 + 128;
        const int t00 = (int)(i00 < ce ? le[i00].x : 0u) >> 2, t01 = (int)(i01 < ce ? le[i01].x : 0u) >> 2, t10 = (int)(i10 < ce ? le[i10].x : 0u) >> 2, t11 = (int)(i11 < ce ? le[i11].x : 0u) >> 2;
        u.A = g8::uptr(H8); u.B = g8::uptr(W + ((size_t)e * 2048 + nt * 256) * 1024);
        u.va[0][0] = (unsigned)(t00 * 512 + C0) * 2u; u.va[0][1] = (unsigned)(t01 * 512 + C1) * 2u; u.va[1][0] = (unsigned)(t10 * 512 + C0) * 2u; u.va[1][1] = (unsigned)(t11 * 512 + C1) * 2u;
        u.x0 = g8::ui(base + mt * 256); u.x1 = g8::ui(nt); u.x2 = g8::ui(e); u.x3 = g8::ui(ce - mt * 256); return true;
    }
};
struct EpiGU {
    unsigned char* act; const float* bgu;
    __device__ __forceinline__ void operator()(const f32x4 (&acc)[2][2][4][2], const g8::Unit& u, int wr, int wc, int fr, int fq) const {
        const int col = u.x1 * 128 + wc * 32 + 8 * fq; const float* bg = bgu + (size_t)u.x2 * 2048 + col;
        const f32x4 bg0 = *(const f32x4*)bg, bg1 = *(const f32x4*)(bg + 4), bu0 = *(const f32x4*)(bg + 1024), bu1 = *(const f32x4*)(bg + 1028);
#pragma unroll
        for (int ai = 0; ai < 2; ++ai)
#pragma unroll
            for (int m = 0; m < 4; ++m) {
                const int r = ai * 128 + wr * 64 + m * 16 + fr;
                f32x4 o[2];
#pragma unroll
                for (int n = 0; n < 2; ++n) {
                    const f32x4 gv = acc[ai][0][m][n] + (n ? bg1 : bg0), uv = acc[ai][1][m][n] + (n ? bu1 : bu0);
#pragma unroll
                    for (int i = 0; i < 4; ++i) { const float gate = fminf(gv[i], 7.f), up = fminf(fmaxf(uv[i], -7.f), 7.f); o[n][i] = (up + 1.f) * (gate * sigmoidf_(1.702f * gate)); }
                }
                u32x2 w; w.x = pk4f8(o[0][0], o[0][1], o[0][2], o[0][3]); w.y = pk4f8(o[1][0], o[1][1], o[1][2], o[1][3]);
                *(u32x2*)(act + (size_t)(u.x0 + r) * D + col) = w;
                asm volatile("" ::: "memory");
            }
    }
};
__device__ __forceinline__ void phase9(const Params& P, LAS unsigned char* lds) {
    unsigned char* ws = P.ws;
    moe_table((const unsigned*)(ws + WS_CTL), 8, lds);
    SchedGU Sg{lds, (const u32x2*)(ws + WS_LIST), ws + WS_H8, ws + WS_GU};
    EpiGU E{ws + WS_ACT, P.in[I_EBGU]};
    g8::gemm_phase<true, true>(lds, D / 2, D / 2, Sg, E);
}
struct SchedDN {
    LAS unsigned char* lds; const unsigned char* act; const unsigned char* W;
    __device__ __forceinline__ bool next(int i, g8::Unit& u, int R0, int C0, int R1, int C1) const {
        int e, mt, nt, base, ce; if (!moe_unit(lds, (int)((blockIdx.x & 7) * (gridDim.x >> 3) + (blockIdx.x >> 3)) + i * (int)gridDim.x, 4, e, mt, nt, base, ce)) return false;
        g8::dense_unit(u, (const bf16_t*)(act + (size_t)(base + mt * 256) * D), D / 2, (const bf16_t*)(W + ((size_t)e * 1024 + nt * 256) * 1024), D / 2, 0, 0, R0, C0, R1, C1);
        u.x0 = g8::ui(base + mt * 256); u.x1 = g8::ui(nt); u.x2 = g8::ui(e); u.x3 = 0; return true;
    }
};
struct EpiDN {
    bf16_t* yk; const float* bdn;
    __device__ __forceinline__ void operator()(const f32x4 (&acc)[2][2][4][2], const g8::Unit& u, int wr, int wc, int fr, int fq) const {
        f32x4 bd[2][2];
#pragma unroll
        for (int bj = 0; bj < 2; ++bj) { const float* bp = bdn + (size_t)u.x2 * 1024 + u.x1 * 256 + bj * 128 + wc * 32 + 8 * fq; bd[bj][0] = *(const f32x4*)bp; bd[bj][1] = *(const f32x4*)(bp + 4); }
#pragma unroll
        for (int ai = 0; ai < 2; ++ai)
#pragma unroll
            for (int m = 0; m < 4; ++m) {
                bf16_t* rowp = yk + (size_t)(u.x0 + ai * 128 + wr * 64 + m * 16 + fr) * D + u.x1 * 256 + wc * 32 + 8 * fq;
#pragma unroll
                for (int bj = 0; bj < 2; ++bj) {
                    const f32x4 v0 = acc[ai][bj][m][0] + bd[bj][0], v1 = acc[ai][bj][m][1] + bd[bj][1];
                    u32x4 o; o.x = g8::cvt_pk_bf16(v0[0], v0[1]); o.y = g8::cvt_pk_bf16(v0[2], v0[3]); o.z = g8::cvt_pk_bf16(v1[0], v1[1]); o.w = g8::cvt_pk_bf16(v1[2], v1[3]);
                    *(u32x4*)(rowp + bj * 128) = o;
                }
            }
    }
};
__device__ __forceinline__ void phase10(const Params& P, LAS unsigned char* lds) {
    unsigned char* ws = P.ws;
    moe_table((const unsigned*)(ws + WS_CTL), 4, lds);
    SchedDN Sn{lds, ws + WS_ACT, ws + WS_DN};
    EpiDN E{(bf16_t*)(ws + WS_YK), P.in[I_EBDN]};
    g8::gemm_phase<true, true>(lds, D / 2, D / 2, Sn, E);
}

__device__ __forceinline__ void phase11(const Params& P, LAS unsigned char* lds) {
    unsigned char* ws = P.ws;
    const int lane = tidx() & 63, gw = blockIdx.x * NWAVES + (tidx() >> 6), ngw = gridDim.x * NWAVES;
    const float* ada = (const float*)(ws + WS_ADA);
    LAS int* ebase = (LAS int*)lds;
    if (tidx() == 0) { const unsigned* cnt = (const unsigned*)(ws + WS_CTL); int rows = 0; for (int i = 0; i < NE; ++i) { ebase[i] = rows; rows += (((int)cnt[i] + 255) >> 8) * 256; } }
    __syncthreads();
    for (int row = gw; row < T; row += ngw) {
        const int b = row / S;
        const u32x4 tp0 = *(const u32x4*)((const unsigned*)(ws + WS_TOKW) + (size_t)row * 4); const f32x4 tw0 = *(const f32x4*)((const float*)(ws + WS_TOKW + 524288) + (size_t)row * 4);
        const unsigned ep[4] = {tp0.x, tp0.y, tp0.z, tp0.w}; const float wk[4] = {tw0.x, tw0.y, tw0.z, tw0.w};
        f32x4 y[4]; float s = 0.f;
#pragma unroll
        for (int j = 0; j < 4; ++j) y[j] = (f32x4){0.f, 0.f, 0.f, 0.f};
#pragma unroll
        for (int k = 0; k < 4; ++k) {
            const size_t prow = (size_t)(ebase[ep[k] >> 20] + (int)(ep[k] & 0xfffffu));
            const u32x2* yr = (const u32x2*)((const bf16_t*)(ws + WS_YK) + prow * D);
#pragma unroll
            for (int j = 0; j < 4; ++j) { const u32x2 w = yr[lane + 64 * j];
                y[j].x += wk[k] * __builtin_bit_cast(float, w.x << 16); y[j].y += wk[k] * __builtin_bit_cast(float, w.x & 0xffff0000u); y[j].z += wk[k] * __builtin_bit_cast(float, w.y << 16); y[j].w += wk[k] * __builtin_bit_cast(float, w.y & 0xffff0000u); }
        }
#pragma unroll
        for (int j = 0; j < 4; ++j) s += y[j].x * y[j].x + y[j].y * y[j].y + y[j].z * y[j].z + y[j].w * y[j].w;
        const float rstd = rsqrtf(wave_sum(s) * (1.f / D) + 1e-6f);
#pragma unroll
        for (int j = 0; j < 4; ++j) {
            const int c = 4 * (lane + 64 * j);
            const f32x4 g = *(const f32x4*)(P.in[I_FFNPOST] + c), gf = *(const f32x4*)(ada + b * 6144 + 5120 + c);
            const f32x4 x1 = ((const f32x4*)((const float*)(ws + WS_X1) + (size_t)row * D))[lane + 64 * j];
            ((f32x4*)(P.out + (size_t)row * D))[lane + 64 * j] = x1 + gf * (y[j] * rstd * g);
        }
    }
}

#define RLX_AGENT __ATOMIC_RELAXED, __HIP_MEMORY_SCOPE_AGENT
#define XB_TMO      128
#define XB_XCNT(j)  (256  + 64 * (j))
#define XB_XSUB(j)  (1280 + 64 * (j))
#define XB_XGEN(j)  (2304 + 64 * (j))
#define XB_TOP      3328
#define XB_TOPGEN   3392
#define XCD_BAR_WORDS 3456
#define XB_SPIN_CAP (1u << 18)

__device__ __forceinline__ unsigned xb_ld(unsigned* p)              { return __hip_atomic_load(p, __ATOMIC_RELAXED, __HIP_MEMORY_SCOPE_AGENT); }
__device__ __forceinline__ unsigned xb_add(unsigned* p, unsigned v) { return __hip_atomic_fetch_add(p, v, __ATOMIC_RELAXED, __HIP_MEMORY_SCOPE_AGENT); }
__device__ __forceinline__ unsigned xb_xcc_id() { return (unsigned)__builtin_amdgcn_s_getreg((3 << 11) | 20) & 0xFu; }
#define XB_SPIN(cond, bar) do { unsigned _sp = 0; while (cond) { __builtin_amdgcn_s_sleep(1); \
    if ((++_sp & 255u) == 0u) { if (xb_ld(&(bar)[XB_TMO])) break; if (_sp > XB_SPIN_CAP) { atomicAdd(&(bar)[XB_TMO], 1u); break; } } } } while (0)

struct XcdBarrier {
    unsigned* bar; unsigned x;
    volatile LAS unsigned* st;
};

__device__ __forceinline__ XcdBarrier xcd_barrier_post(unsigned* bar, volatile LAS unsigned* st) {
    XcdBarrier b; b.bar = bar; b.x = xb_xcc_id(); b.st = st;
    if (threadIdx.x == 0) (void)xb_add(&bar[XB_XCNT(b.x)], 1u);
    return b;
}
__device__ __forceinline__ void xcd_barrier_complete(unsigned* bar, unsigned x, unsigned& nloc, unsigned& nx) {
    const unsigned G = gridDim.x * gridDim.y * gridDim.z;
    unsigned sum, cnt, mine, sp = 0u;
    for (;;) {
        sum = 0u; cnt = 0u; mine = 0u;
#pragma unroll
        for (unsigned j = 0; j < 16; ++j) { const unsigned c = xb_ld(&bar[XB_XCNT(j)]); sum += c; cnt += (c > 0u) ? 1u : 0u; mine = (j == x) ? c : mine; }
        if (sum == G) break;
        __builtin_amdgcn_s_sleep(1);
        if ((++sp & 255u) == 0u) { if (xb_ld(&bar[XB_TMO])) break; if (sp > XB_SPIN_CAP) { atomicAdd(&bar[XB_TMO], 1u); break; } }
    }
    nloc = mine > 0u ? mine : 1u; nx = cnt > 0u ? cnt : 1u;
}

__device__ __forceinline__ void xcd_barrier(const XcdBarrier& b) {
    asm volatile("s_waitcnt vmcnt(0)" ::: "memory");
    __syncthreads();
    if (threadIdx.x == 0) {
        unsigned* bar = b.bar;
        __builtin_amdgcn_s_waitcnt(0);
        unsigned nloc = b.st[0], nx = b.st[1];
        if (nloc == 0u) { xcd_barrier_complete(bar, b.x, nloc, nx); b.st[0] = nloc; b.st[1] = nx; }
        const unsigned old = xb_add(&bar[XB_XSUB(b.x)], 1u);
        const unsigned gen = old / nloc;
        if (old + 1u == (gen + 1u) * nloc) {
            __builtin_amdgcn_fence(__ATOMIC_RELEASE, "agent");
            asm volatile("s_waitcnt vmcnt(0)" ::: "memory");
            const unsigned og = xb_add(&bar[XB_TOP], 1u);
            const unsigned tg = og / nx;
            if (og + 1u == (tg + 1u) * nx) xb_add(&bar[XB_TOPGEN], 1u);
            else XB_SPIN(xb_ld(&bar[XB_TOPGEN]) == tg, bar);
            __builtin_amdgcn_fence(__ATOMIC_ACQUIRE, "agent");
            xb_add(&bar[XB_XGEN(b.x)], 1u);
            asm volatile("s_waitcnt vmcnt(0)" ::: "memory");
        } else {
            XB_SPIN(xb_ld(&bar[XB_XGEN(b.x)]) == gen, bar);
            __builtin_amdgcn_fence(__ATOMIC_ACQUIRE, "agent");
            asm volatile("s_waitcnt vmcnt(0)" ::: "memory");
        }
    }
    __syncthreads();
}


static_assert(att::LDS_NEED <= LDS_RING && g8::STAGE_BYTES <= LDS_RING, "LDS ring");
__global__ void __launch_bounds__(NTHREADS, 2) mega(Params P, int ph_lo, int ph_hi) {
    extern __shared__ __attribute__((aligned(16))) unsigned char lds_raw[];
    LAS unsigned char* lds = (LAS unsigned char*)lds_raw;
    float* ldsf = (float*)lds_raw;
    cg::grid_group grid = cg::this_grid();
    LAS unsigned* bst = (LAS unsigned*)(lds + LDS_RING);
    if (threadIdx.x < 2) bst[threadIdx.x] = 0u;
    __syncthreads();
    const bool one = (ph_hi - ph_lo) > 1;
    XcdBarrier bar; bar.bar = (unsigned*)(P.ws + WS_BAR); bar.x = 0; bar.st = nullptr;
    if (one) bar = xcd_barrier_post((unsigned*)(P.ws + WS_BAR), (volatile LAS unsigned*)bst);
#define RUN_PHASE(k, call) do { if (ph_lo <= (k) && (k) < ph_hi) { call; if ((k) + 1 < ph_hi) { if ((k) == 0 && ph_hi > 1000) grid.sync(); else xcd_barrier(bar); } } } while (0)
    RUN_PHASE(0, phase0(P, ldsf));
    RUN_PHASE(1, phase1(P));
    RUN_PHASE(2, phase2(P, lds));
    RUN_PHASE(3, phase3(P, lds));
    RUN_PHASE(4, phase4(P, lds, ldsf));
    RUN_PHASE(5, phase5p(P));
    RUN_PHASE(6, phase5(P, lds, ldsf));
    RUN_PHASE(7, phase6(P));
    RUN_PHASE(8, phase7(P, lds));
    RUN_PHASE(9, phase9f(P, lds));
    RUN_PHASE(10, phase9(P, lds));
    RUN_PHASE(11, phase10(P, lds));
    RUN_PHASE(12, phase11(P, lds));
#undef RUN_PHASE
}

extern "C" void kernel_launch(void* const* d_in, const int* in_sizes, int n_in, void* d_out, int out_size, void* d_ws, size_t ws_size, hipStream_t stream) {
    static int grid = 0;
    if (grid == 0) {
        if (n_in != 34 || out_size != T * D || ws_size < WS_END) { fprintf(stderr, "kernel_launch: unexpected problem (n_in %d, out %d, ws %zu)\n", n_in, out_size, ws_size); grid = -1; return; }
        int dev = 0, cus = 0, per_cu = 0;
        (void)hipGetDevice(&dev);
        (void)hipDeviceGetAttribute(&cus, hipDeviceAttributeMultiprocessorCount, dev);
        if (hipFuncSetAttribute((const void*)mega, hipFuncAttributeMaxDynamicSharedMemorySize, LDS_TOTAL) != hipSuccess) { fprintf(stderr, "kernel_launch: hipFuncSetAttribute failed\n"); grid = -1; return; }
        (void)hipOccupancyMaxActiveBlocksPerMultiprocessor(&per_cu, mega, NTHREADS, LDS_TOTAL);
        if (per_cu < 1) { fprintf(stderr, "kernel_launch: occupancy query says %d\n", per_cu); grid = -1; return; }
        grid = cus;
    }
    if (grid < 0) return;
    Params p{};
    for (int i = 0; i < 34; ++i) p.in[i] = (const float*)d_in[i];
    p.out = (float*)d_out; p.ws = (unsigned char*)d_ws;
#if MK_ONE_LAUNCH
    (void)hipMemsetAsync((char*)d_ws + WS_BAR, 0, XCD_BAR_WORDS * 4, stream);
    int lo = 0, hi = NPHASES;
    void* args[] = {&p, &lo, &hi};
    hipError_t e = hipLaunchCooperativeKernel((void*)mega, dim3(grid), dim3(NTHREADS), args, LDS_TOTAL, stream);
    if (e != hipSuccess) fprintf(stderr, "cooperative launch failed: %s (grid %d)\n", hipGetErrorString(e), grid);
#else
    for (int ph = 0; ph < NPHASES; ++ph) hipLaunchKernelGGL(mega, dim3(grid), dim3(NTHREADS), LDS_TOTAL, stream, p, ph, ph + 1);
#endif
}
```

```cpp
#include <hip/hip_runtime.h>
#include <hip/hip_cooperative_groups.h>
#include <cstdio>
#include <cstdint>
namespace cg = cooperative_groups;

#ifndef MK_ONE_LAUNCH
#define MK_ONE_LAUNCH 1
#endif

typedef unsigned short bf16_t;
typedef short bf16x8 __attribute__((ext_vector_type(8)));
typedef float f32x4 __attribute__((ext_vector_type(4)));
typedef unsigned u32x4 __attribute__((ext_vector_type(4)));
typedef unsigned u32x2 __attribute__((ext_vector_type(2)));
typedef int i32x8 __attribute__((ext_vector_type(8)));
typedef int i32x4 __attribute__((ext_vector_type(4)));
typedef short s16x16 __attribute__((ext_vector_type(16)));
#define LAS __attribute__((address_space(3)))

constexpr int NB = 4, S = 8192, T = NB * S, D = 1024;
constexpr int NP = 3072;
constexpr int Q0 = 0, KC0 = 512, VC0 = 640, KS0 = 768, VS0 = 896, KW0 = 1024, VW0 = 1152, R0 = 1280, K0 = 1792, V0 = 2304, GL0 = 2816, WD0 = 2840;
constexpr int IN_COLS = 3000;
constexpr int NE = 32;
constexpr int NTHREADS = 512, NWAVES = 8;
constexpr int NPHASES = 13;
#ifndef EXPERT_CONV_IN_SCAN
#define EXPERT_CONV_IN_SCAN 1
#endif
constexpr int LDS_RING = 139264, LDS_TOTAL = 155648;

constexpr size_t MiB = 1u << 20;
constexpr size_t WS_CTL = 0;
constexpr size_t WS_BAR = 65536;
constexpr size_t WS_ADA = 1 * MiB;
constexpr size_t WS_COS = 2 * MiB, WS_SIN = 3 * MiB;
constexpr size_t WS_WIN = 4 * MiB;
constexpr size_t WS_WOUT = 10 * MiB;
constexpr size_t WS_CW1 = 12 * MiB;
constexpr size_t WS_CMP = 14 * MiB;
constexpr size_t WS_HID = 16 * MiB;
constexpr size_t WS_TOKW = 18 * MiB;
constexpr size_t WS_LIST = 984 * MiB;
constexpr size_t WS_BIAS1 = 23 * MiB;
constexpr size_t WS_WLORA = 23 * MiB + 65536;
constexpr size_t WS_LX = 768 * MiB;
constexpr size_t WS_WAG = 784 * MiB;
constexpr size_t WS_KVC = 24 * MiB;
constexpr size_t KVC_STRIDE = (size_t)(65536 + 16) * 64;
constexpr size_t WS_GU = 42 * MiB;
constexpr size_t WS_SROW = 138 * MiB;
constexpr size_t WS_QS = 139 * MiB;
constexpr size_t WS_H8 = 106 * MiB;
constexpr size_t WS_CPART = 202 * MiB;
constexpr size_t WS_DN = 170 * MiB;
constexpr size_t WS_RA = 256 * MiB;
constexpr size_t WS_PROJ = 320 * MiB;
constexpr size_t WS_RW_W = 512 * MiB;
constexpr size_t WS_RW_R = 576 * MiB, WS_RW_K = 608 * MiB, WS_RW_V = 640 * MiB, WS_RW_KK = 672 * MiB, WS_RW_KKA = 704 * MiB, WS_RW_G = 736 * MiB;
constexpr size_t WS_Y = 768 * MiB;
constexpr size_t WS_ONSA = 832 * MiB;
constexpr size_t WS_MIXED = 320 * MiB;
constexpr size_t WS_ACT = 320 * MiB;
constexpr size_t WS_X1 = 600 * MiB;
constexpr size_t WS_YK = 728 * MiB;
constexpr size_t WS_H2X = 728 * MiB;
constexpr size_t WS_LOGP = 234 * MiB;
constexpr size_t WS_WRT = 250 * MiB;
constexpr size_t WS_KVI = 896 * MiB;
constexpr size_t WS_CMPI = 928 * MiB;
constexpr size_t WS_BS = 1000 * MiB;
constexpr size_t WS_END = 1001 * MiB;

struct Params {
    const float* in[34];
    float* out;
    unsigned char* ws;
};
enum { I_X = 0, I_C, I_ADAW, I_ADAB, I_MIXPRE, I_MIXPOST, I_FFNPRE, I_FFNPOST, I_WIN, I_KPE, I_KW1, I_KW2, I_VPE, I_VW1, I_VW2, I_NSANORM,
       I_MU, I_W0, I_W2, I_A0, I_A2, I_G2, I_KK, I_KA, I_RK, I_LNW, I_LNB, I_WOUT, I_RW, I_RB, I_EGU, I_EBGU, I_EDN, I_EBDN };

__device__ __forceinline__ unsigned f2bf(float f) { unsigned u = __builtin_bit_cast(unsigned, f); return (u + 0x7fffu + ((u >> 16) & 1u)) >> 16; }
__device__ __forceinline__ float bf2f(unsigned short h) { return __builtin_bit_cast(float, (unsigned)h << 16); }
typedef float f32x2_pk __attribute__((ext_vector_type(2))); typedef __bf16 bf16x2_pk __attribute__((ext_vector_type(2)));
__device__ __forceinline__ unsigned pk2(float lo, float hi) { f32x2_pk v = {lo, hi}; bf16x2_pk b = __builtin_convertvector(v, bf16x2_pk); return __builtin_bit_cast(unsigned, b); }
__device__ __forceinline__ unsigned pk4f8(float a, float b, float c, float d) { int w = 0; w = __builtin_amdgcn_cvt_pk_fp8_f32(a, b, w, false); w = __builtin_amdgcn_cvt_pk_fp8_f32(c, d, w, true); return (unsigned)w; }
__device__ __forceinline__ float wave_sum(float v) {
#pragma unroll
    for (int o = 1; o < 64; o <<= 1) v += __shfl_xor(v, o);
    return v;
}
__device__ __forceinline__ float wave_max(float v) {
#pragma unroll
    for (int o = 1; o < 64; o <<= 1) v = fmaxf(v, __shfl_xor(v, o));
    return v;
}
__device__ __forceinline__ unsigned pk4i8(float a, float b, float c, float d) {
    const int ia = (int)__builtin_rintf(__builtin_amdgcn_fmed3f(a, -127.f, 127.f)), ib = (int)__builtin_rintf(__builtin_amdgcn_fmed3f(b, -127.f, 127.f)), ic = (int)__builtin_rintf(__builtin_amdgcn_fmed3f(c, -127.f, 127.f)), id = (int)__builtin_rintf(__builtin_amdgcn_fmed3f(d, -127.f, 127.f));
    return (unsigned)(ia & 255) | ((unsigned)(ib & 255) << 8) | ((unsigned)(ic & 255) << 16) | ((unsigned)id << 24);
}
__device__ __forceinline__ int tidx() { int t = (int)threadIdx.x; asm volatile("" : "+v"(t)); return t; }
__device__ __forceinline__ float sigmoidf_(float x) { return __builtin_amdgcn_rcpf(1.f + __expf(-x)); }
__device__ __forceinline__ void unpack8(u32x4 u, float (&f)[8]) {
    f[0] = __builtin_bit_cast(float, u.x << 16); f[1] = __builtin_bit_cast(float, u.x & 0xffff0000u); f[2] = __builtin_bit_cast(float, u.y << 16); f[3] = __builtin_bit_cast(float, u.y & 0xffff0000u);
    f[4] = __builtin_bit_cast(float, u.z << 16); f[5] = __builtin_bit_cast(float, u.z & 0xffff0000u); f[6] = __builtin_bit_cast(float, u.w << 16); f[7] = __builtin_bit_cast(float, u.w & 0xffff0000u);
}
__device__ __forceinline__ u32x4 pack8(const float (&f)[8]) { u32x4 o; o.x = pk2(f[0], f[1]); o.y = pk2(f[2], f[3]); o.z = pk2(f[4], f[5]); o.w = pk2(f[6], f[7]); return o; }
__device__ __forceinline__ int rope_d(int p) { return ((p >> 2) & 1) * 32 + ((p >> 5) & 1) * 16 + ((p >> 3) & 3) * 4 + (p & 3); }

template <int MODE = 0, class PMap, class KMap>
__device__ __forceinline__ void tr_tile(const float* __restrict__ src, int Nsrc, bf16_t* __restrict__ dst, int K, int p0, int k0, PMap pmap, KMap kmap, float* tile  , float qmul = 32.f) {
    const int tx = tidx() & 63, ty = tidx() >> 6;
    const int c = pmap(p0 + tx);
    float v[32];
#pragma unroll
    for (int i = 0; i < 32; ++i) { const int kk = ty + 8 * i; v[i] = (c >= 0) ? src[(size_t)kmap(k0 + kk) * Nsrc + c] : 0.f; }
#pragma unroll
    for (int i = 0; i < 32; ++i) tile[(ty + 8 * i) * 65 + tx] = v[i];
    __syncthreads();
    { const int pp = tidx() >> 3, kq = tidx() & 7;
#pragma unroll
      for (int j = 0; j < 4; ++j) { const float* tp = tile + (64 * j + 8 * kq) * 65 + pp;
        if constexpr (MODE == 1) { u32x2 o; o.x = pk4f8(32.f * tp[0], 32.f * tp[65], 32.f * tp[2 * 65], 32.f * tp[3 * 65]); o.y = pk4f8(32.f * tp[4 * 65], 32.f * tp[5 * 65], 32.f * tp[6 * 65], 32.f * tp[7 * 65]);
          *(u32x2*)((unsigned char*)dst + (size_t)(p0 + pp) * K + k0 + 64 * j + 8 * kq) = o; }
        else if constexpr (MODE == 2) { u32x2 o; o.x = pk4i8(qmul * tp[0], qmul * tp[65], qmul * tp[2 * 65], qmul * tp[3 * 65]); o.y = pk4i8(qmul * tp[4 * 65], qmul * tp[5 * 65], qmul * tp[6 * 65], qmul * tp[7 * 65]);
          *(u32x2*)((unsigned char*)dst + (size_t)(p0 + pp) * K + k0 + 64 * j + 8 * kq) = o; }
        else { u32x4 o; o.x = pk2(tp[0], tp[65]); o.y = pk2(tp[2 * 65], tp[3 * 65]); o.z = pk2(tp[4 * 65], tp[5 * 65]); o.w = pk2(tp[6 * 65], tp[7 * 65]);
          *(u32x4*)(dst + (size_t)(p0 + pp) * K + k0 + 64 * j + 8 * kq) = o; } } }
    __syncthreads();
}
struct MapId { __device__ int operator()(int p) const { return p; } };
struct MapWin { __device__ int operator()(int P) const {
    if (P < 1280) { const bool rope = (P < 640) || (P >= 768 && P < 896) || (P >= 1024 && P < 1152); return rope ? (P & ~63) + rope_d(P & 63) : P; }
    return P < 2816 ? P + 24 : (P < 2840 ? P - 2816 + 1280 : (P < IN_COLS ? P : -1)); } };
struct MapGU { __device__ int operator()(int P) const { return ((P >> 7) & 1) * 1024 + (P >> 8) * 128 + (P & 127); } };
struct MapCW1P { __device__ int operator()(int P) const { return P < 128 ? P : -1; } };
struct MapCW1K { __device__ int operator()(int k) const { return (k & ~63) + rope_d(k & 63); } };

__device__ __forceinline__ float sample_qmul(const float* __restrict__ w, float* red  ) {
    const int tid = tidx(); float s = 0.f;
#pragma unroll
    for (int i = 0; i < 8; ++i) { const float v = w[tid + 512 * i]; s += v * v; }
    s = wave_sum(s);
    __syncthreads();
    if ((tid & 63) == 0) red[tid >> 6] = s;
    __syncthreads();
    const float tot = ((red[0] + red[1]) + (red[2] + red[3])) + ((red[4] + red[5]) + (red[6] + red[7]));
    __syncthreads();
    const float rms = sqrtf(tot * (1.f / 4096.f));
    return rms > 0.f ? 127.f / (6.f * rms) : 0.f;
}
__device__ __forceinline__ void phase0(const Params& P, float* lds) {
    unsigned char* ws = P.ws;
    const int tid = tidx();
    if (blockIdx.x == 0 && tid < 128) ((unsigned*)(ws + WS_CTL))[tid] = 0u;
    for (int e = blockIdx.x * NTHREADS + tid; e < 1536 * 256; e += gridDim.x * NTHREADS) {
        const int n = e >> 8, k = e & 255; float v = 0.f;
        if (n < 512) { if (k < 32) v = P.in[I_W2][k * 512 + n]; }
        else if (n < 1024) { if (k >= 32 && k < 64) v = P.in[I_A2][(k - 32) * 512 + n - 512]; }
        else if (k >= 64 && k < 160) v = P.in[I_G2][(k - 64) * 512 + n - 1024];
        ((bf16_t*)(ws + WS_WLORA))[e] = (bf16_t)f2bf(v);
    }
    constexpr int U_ADA = 192, U_ROPE = 0, U_WIN = 48 * 4, U_WOUT = 16 * 4, U_CW1 = 2 * 4 * 8, U_B1 = 16, U_GU = 32 * 32 * 4, U_DN = 32 * 16 * 4;
    constexpr int TOTAL = U_ADA + U_ROPE + U_WIN + U_WOUT + U_CW1 + U_B1 + (EXPERT_CONV_IN_SCAN ? 0 : U_GU + U_DN);
    for (int u = blockIdx.x; u < TOTAL; u += gridDim.x) {
        int r = u;
        if (r < U_ADA) {
            float* cs = lds;
            float* part = lds + 4096;
            for (int i = tid; i < 4096; i += NTHREADS) { const float c0 = P.in[I_C][i]; cs[i] = c0 * sigmoidf_(c0); }
            __syncthreads();
            const int col = tid & 31, kg = tid >> 5, n = r * 32 + col;
            float a0 = 0.f, a1 = 0.f, a2 = 0.f, a3 = 0.f;
            const float* cw = P.in[I_ADAW] + (size_t)(kg * 64) * 6144 + n;
#pragma unroll 8
            for (int k = 0; k < 64; ++k) {
                const float w = cw[(size_t)k * 6144]; const int kk = kg * 64 + k;
                a0 += w * cs[kk]; a1 += w * cs[1024 + kk]; a2 += w * cs[2048 + kk]; a3 += w * cs[3072 + kk];
            }
            part[(kg * 4 + 0) * 32 + col] = a0; part[(kg * 4 + 1) * 32 + col] = a1; part[(kg * 4 + 2) * 32 + col] = a2; part[(kg * 4 + 3) * 32 + col] = a3;
            __syncthreads();
            if (tid < 128) { const int b = tid >> 5, j = tid & 31; float sacc = 0.f;
#pragma unroll
                for (int g = 0; g < 16; ++g) sacc += part[(g * 4 + b) * 32 + j];
                ((float*)(ws + WS_ADA))[b * 6144 + r * 32 + j] = sacc + P.in[I_ADAB][r * 32 + j]; }
            __syncthreads();
            continue;
        }
        r -= U_ADA;
        if (r < U_ROPE) {
            const int e = r * 512 + tid, t = e >> 5, j = e & 31;
            const double inv = pow(10000.0, -(double)j / 32.0);
            const float ang = (float)t * (float)inv;
            ((float*)(ws + WS_COS))[e] = (float)cos((double)ang);
            ((float*)(ws + WS_SIN))[e] = (float)sin((double)ang);
            continue;
        }
        r -= U_ROPE;
        if (r < U_WIN) { const float qm = sample_qmul(P.in[I_WIN], lds + 256 * 65); if (r == 0 && tid == 0) ((float*)(ws + WS_QS))[0] = qm > 0.f ? 1.f / qm : 0.f;
            tr_tile<2>(P.in[I_WIN], IN_COLS, (bf16_t*)(ws + WS_WIN), 1024, (r >> 2) * 64, (r & 3) * 256, MapWin(), MapId(), lds, qm); continue; }
        r -= U_WIN;
        if (r < U_WOUT) { const float qm = sample_qmul(P.in[I_WOUT], lds + 256 * 65); if (r == 0 && tid == 0) ((float*)(ws + WS_QS))[1] = qm > 0.f ? 1.f / qm : 0.f;
            tr_tile<2>(P.in[I_WOUT], 1024, (bf16_t*)(ws + WS_WOUT), 1024, (r >> 2) * 64, (r & 3) * 256, MapId(), MapId(), lds, qm); continue; }
        r -= U_WOUT;
        if (r < U_CW1) { const int kv = r >> 5, q = r & 31; bf16_t* dst = (bf16_t*)(ws + WS_CW1) + (size_t)kv * 256 * 2048;
            if (kv == 0) tr_tile(P.in[I_KW1], 128, dst, 2048, (q >> 3) * 64, (q & 7) * 256, MapCW1P(), MapCW1K(), lds);
            else tr_tile(P.in[I_VW1], 128, dst, 2048, (q >> 3) * 64, (q & 7) * 256, MapCW1P(), MapId(), lds);
            continue; }
        r -= U_CW1;
        if (r < U_B1) {
            const int kv = r >> 3, sl = r & 7;
            const float* pe = P.in[kv ? I_VPE : I_KPE]; const float* w1 = P.in[kv ? I_VW1 : I_KW1];
            const int n = tid & 127, qd = tid >> 7; float a = 0.f;
            const int kb = sl * 256 + qd * 64;
#pragma unroll 16
            for (int k = 0; k < 64; ++k) a += pe[kb + k] * w1[(size_t)(kb + k) * 128 + n];
            lds[tid] = a; __syncthreads();
            if (tid < 128) ((float*)(ws + WS_BIAS1))[(kv * 8 + sl) * 128 + tid] = (lds[tid] + lds[tid + 128]) + (lds[tid + 256] + lds[tid + 384]);
            __syncthreads();
            continue;
        }
        r -= U_B1;
        static_assert(EXPERT_CONV_IN_SCAN, "the expert weights (fp8) are converted by the scan units' loader waves");
    }
}

__device__ __forceinline__ void phase1(const Params& P) {
    const int lane = tidx() & 63, gw = blockIdx.x * NWAVES + (tidx() >> 6), ngw = gridDim.x * NWAVES;
    const float* ada = (const float*)(P.ws + WS_ADA);
    bf16_t* XN = (bf16_t*)(P.ws + WS_RA);
    for (int row = gw; row < T; row += ngw) {
        const int b = row / S;
        const f32x4* xr = (const f32x4*)(P.in[I_X] + (size_t)row * D) + lane;
        f32x4 v[4]; float s = 0.f;
#pragma unroll
        for (int j = 0; j < 4; ++j) { v[j] = xr[64 * j]; s += v[j].x * v[j].x + v[j].y * v[j].y + v[j].z * v[j].z + v[j].w * v[j].w; }
        const float rstd = rsqrtf(wave_sum(s) * (1.f / D) + 1e-6f);
        unsigned* o = (unsigned*)((unsigned char*)XN + (size_t)row * D) + lane;
        f32x4 h[4]; float am = 0.f;
#pragma unroll
        for (int j = 0; j < 4; ++j) {
            const int c = 4 * (lane + 64 * j);
            const f32x4 g = *(const f32x4*)(P.in[I_MIXPRE] + c), sh = *(const f32x4*)(ada + b * 6144 + c), sc = *(const f32x4*)(ada + b * 6144 + 1024 + c);
            h[j] = v[j] * rstd * g * (sc + 1.f) + sh;
            am = fmaxf(fmaxf(am, fmaxf(fabsf(h[j].x), fabsf(h[j].y))), fmaxf(fabsf(h[j].z), fabsf(h[j].w)));
        }
        am = wave_max(am);
        const float qm = am > 0.f ? 127.f / am : 0.f;
        if (lane == 0) ((float*)(P.ws + WS_SROW))[row] = am * (1.f / 127.f);
#pragma unroll
        for (int j = 0; j < 4; ++j) o[64 * j] = pk4i8(h[j].x * qm, h[j].y * qm, h[j].z * qm, h[j].w * qm);
    }
}

namespace g8 {
constexpr int BM = 256, BK = 64, HALF = 128, HTB = HALF * BK * 2, STAGE_BYTES = 8 * HTB;
__device__ __forceinline__ int lds_byte(int r, int c) { const int st = (r >> 4) * 2 + (c >> 5), rr = r & 15, cc = c & 31, ob = rr * 64 + cc * 2; return st * 1024 + (ob ^ (((ob >> 9) & 1) << 5)); }
__device__ __forceinline__ void stage_rc(int b, int& R, int& C) { const int st = b / 1024, sb = b % 1024, swz = sb ^ (((sb >> 9) & 1) << 5); R = (st >> 1) * 16 + swz / 64; C = (st & 1) * 32 + (swz % 64) / 2; }
__device__ __forceinline__ int perm32(int rho) { const int n = rho >> 4, i = rho & 15; return 8 * (i >> 2) + 4 * n + (i & 3); }
__device__ __forceinline__ i32x8 cat8(bf16x8 a, bf16x8 b) { const s16x16 v = __builtin_shufflevector(a, b, 0, 1, 2, 3, 4, 5, 6, 7, 8, 9, 10, 11, 12, 13, 14, 15); return __builtin_bit_cast(i32x8, v); }
__device__ __forceinline__ unsigned cvt_pk_bf16(float lo, float hi) { unsigned r; asm volatile("v_cvt_pk_bf16_f32 %0, %1, %2" : "=v"(r) : "v"(lo), "v"(hi)); return r; }

__device__ __forceinline__ void mma8(f32x4 (&c)[4][2], const bf16x8 (&At)[4][2], const bf16x8 (&Bt)[2][2]) {
    const i32x8 a0 = cat8(At[0][0], At[0][1]), a1 = cat8(At[1][0], At[1][1]), a2 = cat8(At[2][0], At[2][1]), a3 = cat8(At[3][0], At[3][1]), b0 = cat8(Bt[0][0], Bt[0][1]), b1 = cat8(Bt[1][0], Bt[1][1]);
    const unsigned one = 0x7f7f7f7fu;
    asm volatile("s_setprio 1\n\ts_nop 1\n\t"
                 "v_mfma_scale_f32_16x16x128_f8f6f4 %0, %8, %10, %0, %14, %14 op_sel_hi:[0,0,0]\n\t"
                 "v_mfma_scale_f32_16x16x128_f8f6f4 %1, %9, %10, %1, %14, %14 op_sel_hi:[0,0,0]\n\t"
                 "v_mfma_scale_f32_16x16x128_f8f6f4 %2, %8, %11, %2, %14, %14 op_sel_hi:[0,0,0]\n\t"
                 "v_mfma_scale_f32_16x16x128_f8f6f4 %3, %9, %11, %3, %14, %14 op_sel_hi:[0,0,0]\n\t"
                 "v_mfma_scale_f32_16x16x128_f8f6f4 %4, %8, %12, %4, %14, %14 op_sel_hi:[0,0,0]\n\t"
                 "v_mfma_scale_f32_16x16x128_f8f6f4 %5, %9, %12, %5, %14, %14 op_sel_hi:[0,0,0]\n\t"
                 "v_mfma_scale_f32_16x16x128_f8f6f4 %6, %8, %13, %6, %14, %14 op_sel_hi:[0,0,0]\n\t"
                 "v_mfma_scale_f32_16x16x128_f8f6f4 %7, %9, %13, %7, %14, %14 op_sel_hi:[0,0,0]\n\t"
                 "s_setprio 0"
                 : "+v"(c[0][0]), "+v"(c[0][1]), "+v"(c[1][0]), "+v"(c[1][1]), "+v"(c[2][0]), "+v"(c[2][1]), "+v"(c[3][0]), "+v"(c[3][1])
                 : "v"(b0), "v"(b1), "v"(a0), "v"(a1), "v"(a2), "v"(a3), "v"(one));
}
__device__ __forceinline__ void mma8z(f32x4 (&c)[4][2], const bf16x8 (&At)[4][2], const bf16x8 (&Bt)[2][2]) {
    const i32x8 a0 = cat8(At[0][0], At[0][1]), a1 = cat8(At[1][0], At[1][1]), a2 = cat8(At[2][0], At[2][1]), a3 = cat8(At[3][0], At[3][1]), b0 = cat8(Bt[0][0], Bt[0][1]), b1 = cat8(Bt[1][0], Bt[1][1]);
    const unsigned one = 0x7f7f7f7fu;
    asm volatile("s_setprio 1\n\ts_nop 1\n\t"
                 "v_mfma_scale_f32_16x16x128_f8f6f4 %0, %8, %10, 0, %14, %14 op_sel_hi:[0,0,0]\n\t"
                 "v_mfma_scale_f32_16x16x128_f8f6f4 %1, %9, %10, 0, %14, %14 op_sel_hi:[0,0,0]\n\t"
                 "v_mfma_scale_f32_16x16x128_f8f6f4 %2, %8, %11, 0, %14, %14 op_sel_hi:[0,0,0]\n\t"
                 "v_mfma_scale_f32_16x16x128_f8f6f4 %3, %9, %11, 0, %14, %14 op_sel_hi:[0,0,0]\n\t"
                 "v_mfma_scale_f32_16x16x128_f8f6f4 %4, %8, %12, 0, %14, %14 op_sel_hi:[0,0,0]\n\t"
                 "v_mfma_scale_f32_16x16x128_f8f6f4 %5, %9, %12, 0, %14, %14 op_sel_hi:[0,0,0]\n\t"
                 "v_mfma_scale_f32_16x16x128_f8f6f4 %6, %8, %13, 0, %14, %14 op_sel_hi:[0,0,0]\n\t"
                 "v_mfma_scale_f32_16x16x128_f8f6f4 %7, %9, %13, 0, %14, %14 op_sel_hi:[0,0,0]\n\t"
                 "s_setprio 0"
                 : "=&v"(c[0][0]), "=&v"(c[0][1]), "=&v"(c[1][0]), "=&v"(c[1][1]), "=&v"(c[2][0]), "=&v"(c[2][1]), "=&v"(c[3][0]), "=&v"(c[3][1])
                 : "v"(b0), "v"(b1), "v"(a0), "v"(a1), "v"(a2), "v"(a3), "v"(one));
}

template <bool NOP>
__device__ __forceinline__ void mma8_settle(f32x4 (&c)[2][4][2]) {
#define G8_PIN16 "+v"(c[0][0][0]), "+v"(c[0][0][1]), "+v"(c[0][1][0]), "+v"(c[0][1][1]), "+v"(c[0][2][0]), "+v"(c[0][2][1]), "+v"(c[0][3][0]), "+v"(c[0][3][1]), \
                 "+v"(c[1][0][0]), "+v"(c[1][0][1]), "+v"(c[1][1][0]), "+v"(c[1][1][1]), "+v"(c[1][2][0]), "+v"(c[1][2][1]), "+v"(c[1][3][0]), "+v"(c[1][3][1])
    if constexpr (NOP) asm volatile("s_nop 15\n\ts_nop 7" : G8_PIN16); else asm volatile("" : G8_PIN16);
#undef G8_PIN16
}

struct Unit { const char* A; const char* B; unsigned va[2][2]; int x0, x1, x2, x3; };

template <bool PERM, int MODE = 0, class Epi, class Sched>
__device__ __forceinline__ void gemm_phase(LAS unsigned char* lds, int K, int ldb, const Sched& S, const Epi& E) {
    const int tid = tidx(), wid = __builtin_amdgcn_readfirstlane(tid >> 6), lane = tid & 63, wr = wid >> 2, wc = wid & 3, fr = lane & 15, fq = lane >> 4;
    int nt = K / BK; asm volatile("" : "+s"(nt));
    unsigned vb[2][2];
    { int R0, C0, R1, C1; stage_rc(tid * 16, R0, C0); stage_rc(tid * 16 + 8192, R1, C1);
      const int Rb0 = PERM ? ((R0 & ~31) + perm32(R0 & 31)) : R0, Rb1 = PERM ? ((R1 & ~31) + perm32(R1 & 31)) : R1;
      vb[0][0] = (unsigned)(Rb0 * ldb + C0) * 2u; vb[0][1] = (unsigned)(Rb1 * ldb + C1) * 2u; vb[1][0] = (unsigned)((Rb0 + HALF) * ldb + C0) * 2u; vb[1][1] = (unsigned)((Rb1 + HALF) * ldb + C1) * 2u; }
    const size_t kstep = (size_t)(BK * 2);
    const unsigned ldsw = (unsigned)wid * 1024u;
    const int aoff = lds_byte(wr * 64 + fr, fq * 8), boff = lds_byte(wc * 32 + fr, fq * 8);
#define G8_SA(b, h) (((b) * 2 + (h)) * HTB)
#define G8_SB(b, h) ((4 + (b) * 2 + (h)) * HTB)
#define G8_STAGE(bufoff, gbase, v0, v1) do { unsigned o0_ = (v0), o1_ = (v1); asm volatile("" : "+v"(o0_), "+v"(o1_));     \
        __builtin_amdgcn_global_load_lds((const unsigned*)((gbase) + o0_), (LAS unsigned*)(lds + (bufoff) + ldsw), 16, 0, 0); \
        __builtin_amdgcn_global_load_lds((const unsigned*)((gbase) + o1_), (LAS unsigned*)(lds + (bufoff) + ldsw + 8192), 16, 0, 0); } while (0)
#define G8_LDA(dst, b, h) do { _Pragma("unroll") for (int m = 0; m < 4; ++m) _Pragma("unroll") for (int k = 0; k < 2; ++k) dst[m][k] = *(const LAS bf16x8*)(lds + G8_SA(b, h) + aoff + m * 2048 + k * 1024); } while (0)
#define G8_LDB(dst, b, h) do { _Pragma("unroll") for (int n = 0; n < 2; ++n) _Pragma("unroll") for (int k = 0; k < 2; ++k) dst[n][k] = *(const LAS bf16x8*)(lds + G8_SB(b, h) + boff + n * 2048 + k * 1024); } while (0)
#define G8_MMA(ai, bj, At, Bt, Z) do { \
        if constexpr (MODE == 1) { if (Z) mma8z(acc[ai][bj], At, Bt); else mma8(acc[ai][bj], At, Bt); } \
        else if constexpr (MODE == 2) { __builtin_amdgcn_s_setprio(1); _Pragma("unroll") for (int m = 0; m < 4; ++m) _Pragma("unroll") for (int n = 0; n < 2; ++n) { \
            i32x4 c_ = __builtin_bit_cast(i32x4, acc[ai][bj][m][n]); \
            c_ = __builtin_amdgcn_mfma_i32_16x16x64_i8(__builtin_bit_cast(i32x4, Bt[n][0]), __builtin_bit_cast(i32x4, At[m][0]), c_, 0, 0, 0); \
            c_ = __builtin_amdgcn_mfma_i32_16x16x64_i8(__builtin_bit_cast(i32x4, Bt[n][1]), __builtin_bit_cast(i32x4, At[m][1]), c_, 0, 0, 0); \
            acc[ai][bj][m][n] = __builtin_bit_cast(f32x4, c_); } __builtin_amdgcn_s_setprio(0); } \
        else { __builtin_amdgcn_s_setprio(1); _Pragma("unroll") for (int m = 0; m < 4; ++m) _Pragma("unroll") for (int n = 0; n < 2; ++n) { \
            f32x4 c_ = acc[ai][bj][m][n]; \
            c_ = __builtin_amdgcn_mfma_f32_16x16x32_bf16(Bt[n][0], At[m][0], c_, 0, 0, 0); c_ = __builtin_amdgcn_mfma_f32_16x16x32_bf16(Bt[n][1], At[m][1], c_, 0, 0, 0); \
            acc[ai][bj][m][n] = c_; } __builtin_amdgcn_s_setprio(0); } } while (0)
#define G8_WAIT_V(n) asm volatile("s_waitcnt vmcnt(" #n ")" ::: "memory")
#define G8_WAIT_L(n) asm volatile("s_waitcnt lgkmcnt(" #n ")" ::: "memory")
#define G8_BAR __builtin_amdgcn_s_barrier()
#define G8_SCHED __builtin_amdgcn_sched_barrier(0)
    Unit cur, nxt; int ui = 0;
#define G8_NEXT(i, u) ({ int R0_, C0_, R1_, C1_; const int t_ = tidx(); stage_rc(t_ * 16, R0_, C0_); stage_rc(t_ * 16 + 8192, R1_, C1_); S.next((i), (u), R0_, C0_, R1_, C1_); })
    if (!G8_NEXT(0, cur)) return;
    f32x4 acc[2][2][4][2];
    if constexpr (MODE != 1) {
        _Pragma("unroll") for (int a = 0; a < 2; ++a) _Pragma("unroll") for (int b = 0; b < 2; ++b) _Pragma("unroll") for (int m = 0; m < 4; ++m) _Pragma("unroll") for (int n = 0; n < 2; ++n) acc[a][b][m][n] = (f32x4){0.f, 0.f, 0.f, 0.f};
    }
    bf16x8 At[4][2], B0[2][2], B1[2][2];
    G8_STAGE(G8_SB(0, 0), cur.B, vb[0][0], vb[0][1]); G8_STAGE(G8_SB(0, 1), cur.B, vb[1][0], vb[1][1]); G8_STAGE(G8_SA(0, 0), cur.A, cur.va[0][0], cur.va[0][1]); G8_STAGE(G8_SA(0, 1), cur.A, cur.va[1][0], cur.va[1][1]);
    if (wr == 1) G8_BAR;
    G8_WAIT_V(2); G8_BAR;
    G8_STAGE(G8_SB(1, 0), cur.B + kstep, vb[0][0], vb[0][1]); G8_STAGE(G8_SA(1, 0), cur.A + kstep, cur.va[0][0], cur.va[0][1]); G8_STAGE(G8_SB(1, 1), cur.B + kstep, vb[1][0], vb[1][1]);
    G8_WAIT_V(6); G8_BAR;
    for (;;) {
        const bool has_next = G8_NEXT(ui + 1, nxt);
        if (!has_next) nxt = cur;
        for (int t = 0; t < nt; t += 2) {
            const bool last = (t == nt - 2);
            const char* a1 = cur.A + (size_t)(t + 1) * kstep;
            const char* a2 = last ? nxt.A : cur.A + (size_t)(t + 2) * kstep; const char* b2 = last ? nxt.B : cur.B + (size_t)(t + 2) * kstep;
            const char* a3 = a2 + kstep; const char* b3 = b2 + kstep;
            const unsigned w00 = last ? nxt.va[0][0] : cur.va[0][0], w01 = last ? nxt.va[0][1] : cur.va[0][1], w10 = last ? nxt.va[1][0] : cur.va[1][0], w11 = last ? nxt.va[1][1] : cur.va[1][1];
            G8_LDB(B0, 0, 0); G8_LDB(B1, 0, 1); G8_SCHED; G8_LDA(At, 0, 0); G8_STAGE(G8_SA(1, 1), a1, cur.va[1][0], cur.va[1][1]);
            G8_WAIT_V(8); G8_WAIT_L(0); G8_BAR; if (t == 0) { G8_MMA(0, 0, At, B0, true); G8_MMA(0, 1, At, B1, true); } else { G8_MMA(0, 0, At, B0, false); G8_MMA(0, 1, At, B1, false); } G8_BAR; G8_SCHED;
            G8_LDA(At, 0, 1); G8_STAGE(G8_SB(0, 0), b2, vb[0][0], vb[0][1]); G8_STAGE(G8_SB(0, 1), b2, vb[1][0], vb[1][1]); G8_STAGE(G8_SA(0, 0), a2, w00, w01);
            G8_WAIT_V(8); G8_WAIT_L(0); G8_BAR; if (t == 0) { G8_MMA(1, 0, At, B0, true); G8_MMA(1, 1, At, B1, true); } else { G8_MMA(1, 0, At, B0, false); G8_MMA(1, 1, At, B1, false); } G8_BAR; G8_SCHED;
            G8_LDB(B0, 1, 0); G8_LDB(B1, 1, 1); G8_SCHED; G8_LDA(At, 1, 0); G8_STAGE(G8_SA(0, 1), a2, w10, w11);
            G8_WAIT_V(8); G8_WAIT_L(0); G8_BAR; G8_MMA(0, 0, At, B0, false); G8_MMA(0, 1, At, B1, false); G8_BAR; G8_SCHED;
            G8_LDA(At, 1, 1); G8_STAGE(G8_SB(1, 0), b3, vb[0][0], vb[0][1]); G8_STAGE(G8_SB(1, 1), b3, vb[1][0], vb[1][1]); G8_STAGE(G8_SA(1, 0), a3, w00, w01);
            G8_WAIT_V(8); G8_WAIT_L(0); G8_BAR; G8_MMA(1, 0, At, B0, false); G8_MMA(1, 1, At, B1, false); G8_BAR; G8_SCHED;
        }
        if (wr == 0) G8_BAR;
        if constexpr (MODE == 2) {
            const int fr_ = tidx() & 15;
            _Pragma("unroll") for (int a = 0; a < 2; ++a) _Pragma("unroll") for (int m = 0; m < 4; ++m) { const float sc = E.rs(cur, a * 128 + wr * 64 + m * 16 + fr_);
                _Pragma("unroll") for (int b = 0; b < 2; ++b) _Pragma("unroll") for (int n = 0; n < 2; ++n) _Pragma("unroll") for (int i = 0; i < 4; ++i) { const f32x4 t = acc[a][b][m][n]; const i32x4 ti = __builtin_bit_cast(i32x4, t); acc[a][b][m][n][i] = (float)ti[i] * sc; } }
        }
        if constexpr (MODE == 1) {
            mma8_settle<true>(acc[0]); mma8_settle<false>(acc[1]);
        }
        { const int l_ = tidx() & 63; E(acc, cur, wr, wc, l_ & 15, l_ >> 4); }
        if (!has_next) break;
        if constexpr (MODE != 1) {
            _Pragma("unroll") for (int a = 0; a < 2; ++a) _Pragma("unroll") for (int b = 0; b < 2; ++b) _Pragma("unroll") for (int m = 0; m < 4; ++m) _Pragma("unroll") for (int n = 0; n < 2; ++n) acc[a][b][m][n] = (f32x4){0.f, 0.f, 0.f, 0.f};
        }
        cur = nxt; ++ui;
        if (wr == 1) G8_BAR;
    }
    G8_WAIT_V(0);
    G8_BAR;
#undef G8_NEXT
#undef G8_SA
#undef G8_SB
#undef G8_STAGE
#undef G8_LDA
#undef G8_LDB
#undef G8_MMA
#undef G8_WAIT_V
#undef G8_WAIT_L
#undef G8_BAR
#undef G8_SCHED
}

__device__ __forceinline__ const char* uptr(const void* p) {
    const unsigned long long v = (unsigned long long)p; const unsigned lo = __builtin_amdgcn_readfirstlane((unsigned)v), hi = __builtin_amdgcn_readfirstlane((unsigned)(v >> 32));
    return (const char*)(((unsigned long long)hi << 32) | lo); }
__device__ __forceinline__ int ui(int v) { return __builtin_amdgcn_readfirstlane(v); }
__device__ __forceinline__ void dense_unit(Unit& u, const bf16_t* A, int lda, const bf16_t* Bt, int ldb, int pm, int pn, int R0, int C0, int R1, int C1) {
    u.A = uptr(A + (size_t)pm * BM * lda); u.B = uptr(Bt + (size_t)pn * BM * ldb);
    u.va[0][0] = (unsigned)(R0 * lda + C0) * 2u; u.va[0][1] = (unsigned)(R1 * lda + C1) * 2u; u.va[1][0] = (unsigned)((R0 + HALF) * lda + C0) * 2u; u.va[1][1] = (unsigned)((R1 + HALF) * lda + C1) * 2u;
    u.x0 = ui(pm); u.x1 = ui(pn); u.x2 = 0; u.x3 = 0;
}
__device__ __forceinline__ bool static_tile(int i, int G, int c, int nM, int nN, int& pm, int& pn) {
    const int nwg = nM * nN; const long L = (long)i * G + c; if (L >= nwg) return false;
    int wgid = (int)L; { const int q = nwg / 8, r = nwg % 8, xcd = wgid % 8, off = wgid / 8; wgid = (xcd < r ? xcd * (q + 1) : r * (q + 1) + (xcd - r) * q) + off; }
    const int nig = 8 * nN, gid = wgid / nig, fm = gid * 8, gsz = (nM - fm) < 8 ? (nM - fm) : 8;
    pm = fm + ((wgid % nig) % gsz); pn = (wgid % nig) / gsz; return true;
}
}

struct SchedDense {
    const bf16_t* A; const bf16_t* Bt; int lda, ldb, nM, nN;
    __device__ __forceinline__ bool next(int i, g8::Unit& u, int R0, int C0, int R1, int C1) const {
        int pm, pn; if (!g8::static_tile(i, (int)gridDim.x, (int)blockIdx.x, nM, nN, pm, pn)) return false;
        g8::dense_unit(u, A, lda, Bt, ldb, pm, pn, R0, C0, R1, C1); return true;
    }
};
struct EpiInProj {
    bf16_t* proj; bf16_t* kvc; unsigned char* kvi; const float* COS; const float* SIN; const float* srow; const float* qs; unsigned* hm;
    __device__ __forceinline__ float rs(const g8::Unit& u, int r) const { return srow[u.x0 * 256 + r] * qs[0]; }
    __device__ __forceinline__ void operator()(const f32x4 (&acc)[2][2][4][2], const g8::Unit& u, int wr, int wc, int fr, int fq) const {
        const int pm = u.x0, pn = u.x1;
        float hmax = 0.f;
        f32x4 frv;
#pragma unroll
        for (int i = 0; i < 4; ++i) frv[i] = __builtin_amdgcn_exp2f(-(float)(16 * (wc & 1) + 4 * fq + i) * (13.287712379549449f / 32.f)) * 0.15915494309189535f;
#pragma unroll
        for (int ai = 0; ai < 2; ++ai)
#pragma unroll
            for (int m = 0; m < 4; ++m) {
                const int row = pm * 256 + ai * 128 + wr * 64 + m * 16 + fr, t = row & (S - 1);
                f32x4 cs = {0.f, 0.f, 0.f, 0.f}, sn = {0.f, 0.f, 0.f, 0.f};
                if (pn < 5) {
#pragma unroll
                    for (int i = 0; i < 4; ++i) { const float rev = __builtin_amdgcn_fractf((float)t * frv[i]); cs[i] = __builtin_amdgcn_cosf(rev); sn[i] = __builtin_amdgcn_sinf(rev); }
                }
                u32x4 w[2];
#pragma unroll
                for (int bj = 0; bj < 2; ++bj) {
                    f32x4 v0 = acc[ai][bj][m][0], v1 = acc[ai][bj][m][1];
                    if (pn < 2 || (pn < 5 && bj == 0)) { const f32x4 x1 = v0, x2 = v1; v0 = x1 * cs - x2 * sn; v1 = x2 * cs + x1 * sn; }
                    if ((pn == 3 || pn == 4) && bj == 0) {
                        float hs = (v0[0] * v0[0] + v0[1] * v0[1]) + (v0[2] * v0[2] + v0[3] * v0[3]) + (v1[0] * v1[0] + v1[1] * v1[1]) + (v1[2] * v1[2] + v1[3] * v1[3]);
                        hs += __shfl_xor(hs, 16); hs += __shfl_xor(hs, 32);
                        hmax = fmaxf(hmax, hs);
                    }
                    w[bj].x = g8::cvt_pk_bf16(v0[0], v0[1]); w[bj].y = g8::cvt_pk_bf16(v0[2], v0[3]); w[bj].z = g8::cvt_pk_bf16(v1[0], v1[1]); w[bj].w = g8::cvt_pk_bf16(v1[2], v1[3]);
                }
                if (pn == 3 || pn == 4) {
                    const int b = row / S, g = wc >> 1, key = t & 63;
                    unsigned char* ti = kvi + ((size_t)(((pn - 3) * NB + b) * 2 + g) * (S / 64) + (t >> 6)) * 16384;
                    *(u32x4*)(ti + ((wc & 1) * 4 + fq) * 1024 + key * 16) = w[0];
                    *(u32x4*)(ti + 8192 + (wc & 1) * 4096 + (key >> 4) * 1024 + (key & 15) * 64 + fq * 16) = w[1];
                } else {
                    bf16_t* pr = proj + (size_t)row * NP + pn * 256 + wc * 32 + 8 * fq;
                    if (pn != 2) { *(u32x4*)pr = w[0]; *(u32x4*)(pr + 128) = w[1]; }
                    if (pn == 2) {
                        const int b = row / S, g = wc >> 1;
                        bf16_t* kp = kvc + ((size_t)((b * 2 + g) * S + t)) * 64 + (wc & 1) * 32 + 8 * fq;
                        *(u32x4*)kp = w[0]; *(u32x4*)(kp + KVC_STRIDE) = w[1];
                    }
                }
                asm volatile("" ::: "memory");
            }
        if (pn == 3 || pn == 4) {
            hmax = wave_max(hmax) * 1.02f;
            if ((tidx() & 63) == 0) atomicMax(hm + 96 + (pn - 3) * 8 + ((pm * 256) / S) * 2 + (wc >> 1), __builtin_bit_cast(unsigned, hmax));
        }
    }
};
__device__ __forceinline__ void phase2(const Params& P, LAS unsigned char* lds) {
    unsigned char* ws = P.ws;
    SchedDense Sd{(const bf16_t*)(ws + WS_RA), (const bf16_t*)(ws + WS_WIN), D / 2, D / 2, T / 256, NP / 256};
    EpiInProj E{(bf16_t*)(ws + WS_PROJ), (bf16_t*)(ws + WS_KVC), ws + WS_KVI, (const float*)(ws + WS_COS), (const float*)(ws + WS_SIN), (const float*)(ws + WS_SROW), (const float*)(ws + WS_QS), (unsigned*)(ws + WS_CTL)};
    g8::gemm_phase<true, 2>(lds, D / 2, D / 2, Sd, E);
}

__device__ __forceinline__ float tanh_fast(float x) { return 1.f - 2.f * __builtin_amdgcn_rcpf(1.f + __expf(2.f * x)); }
__device__ __forceinline__ float gelu_tanh(float x) { const float u = 0.7978845608028654f * (x + 0.044715f * x * x * x); return 0.5f * x * (1.f + tanh_fast(u)); }
struct SchedCmp {
    const bf16_t* kvc; const bf16_t* cw1;
    __device__ __forceinline__ bool next(int i, g8::Unit& u, int R0, int C0, int R1, int C1) const {
        const int id = (int)blockIdx.x + i * (int)gridDim.x; if (id >= 256) return false;
        const int ks = id & 7, kv = id >> 7, mt = (id >> 3) & 15;
        g8::dense_unit(u, kvc + (size_t)kv * KVC_STRIDE + ks * 256, 1024, cw1 + (size_t)kv * 256 * 2048 + ks * 256, 2048, mt, 0, R0, C0, R1, C1); u.x2 = g8::ui(kv); u.x3 = g8::ui(ks); return true;
    }
};
struct EpiCmp {
    float* part;
    __device__ __forceinline__ void operator()(const f32x4 (&acc)[2][2][4][2], const g8::Unit& u, int wr, int wc, int fr, int fq) const {
        const int col = wc * 32 + 8 * fq;
#pragma unroll
        for (int ai = 0; ai < 2; ++ai)
#pragma unroll
            for (int m = 0; m < 4; ++m) {
                const int row = u.x0 * 256 + ai * 128 + wr * 64 + m * 16 + fr;
                float* o = part + ((size_t)((u.x3 * 2 + u.x2) * 4096 + row)) * 128 + col;
                *(f32x4*)o = acc[ai][0][m][0]; *(f32x4*)(o + 4) = acc[ai][0][m][1];
            }
    }
};
__device__ __forceinline__ void phase3(const Params& P, LAS unsigned char* lds) {
    unsigned char* ws = P.ws;
    {
        SchedCmp Sc{(const bf16_t*)(ws + WS_KVC), (const bf16_t*)(ws + WS_CW1)};
        EpiCmp E{(float*)(ws + WS_CPART)};
        g8::gemm_phase<true>(lds, 256, 2048, Sc, E);
    }
    const bf16_t* proj = (const bf16_t*)(ws + WS_PROJ);
    const float* mu = P.in[I_MU];
    bf16_t* LX = (bf16_t*)(ws + WS_LX);
    for (int e = blockIdx.x * NTHREADS + tidx(); e < T * 32; e += gridDim.x * NTHREADS) {
        const int row = e >> 5, c0 = (e & 31) * 8, t = row & (S - 1);
        u32x4 o = {0u, 0u, 0u, 0u};
        if (c0 < 160) {
            const u32x4 cu = *(const u32x4*)(proj + (size_t)row * NP + WD0 + c0);
            u32x4 pu = {0u, 0u, 0u, 0u}; if (t > 0) pu = *(const u32x4*)(proj + (size_t)(row - 1) * NP + WD0 + c0);
            float cv[8], pv_[8], xs[8]; unpack8(cu, cv); unpack8(pu, pv_);
#pragma unroll
            for (int i = 0; i < 8; ++i) {
                float x = cv[i] + (pv_[i] - cv[i]) * mu[1536 + c0 + i];
                xs[i] = c0 < 32 ? tanh_fast(x) : (c0 >= 64 ? sigmoidf_(x) : x);
            }
            o = pack8(xs);
        }
        *(u32x4*)(LX + (size_t)row * 256 + c0) = o;
    }
}

struct EpiBf16 {
    bf16_t* O; int ldc; const float* srow = nullptr; const float* qs = nullptr;
    __device__ __forceinline__ float rs(const g8::Unit& u, int r) const { return srow[u.x0 * 256 + r] * qs[0]; }
    __device__ __forceinline__ void operator()(const f32x4 (&acc)[2][2][4][2], const g8::Unit& u, int wr, int wc, int fr, int fq) const {
#pragma unroll
        for (int ai = 0; ai < 2; ++ai)
#pragma unroll
            for (int m = 0; m < 4; ++m) {
                bf16_t* rowp = O + (size_t)(u.x0 * 256 + ai * 128 + wr * 64 + m * 16 + fr) * ldc + u.x1 * 256 + wc * 32 + 8 * fq;
#pragma unroll
                for (int bj = 0; bj < 2; ++bj) {
                    const f32x4 v0 = acc[ai][bj][m][0], v1 = acc[ai][bj][m][1];
                    u32x4 w; w.x = g8::cvt_pk_bf16(v0[0], v0[1]); w.y = g8::cvt_pk_bf16(v0[2], v0[3]); w.z = g8::cvt_pk_bf16(v1[0], v1[1]); w.w = g8::cvt_pk_bf16(v1[2], v1[3]);
                    *(u32x4*)(rowp + bj * 128) = w;
                }
            }
    }
};
struct EpiLora {
    bf16_t* wag; bf16_t* rwg;
    __device__ __forceinline__ void operator()(const f32x4 (&acc)[2][2][4][2], const g8::Unit& u, int wr, int wc, int fr, int fq) const {
        const bool gate = u.x1 >= 4;
        bf16_t* O = gate ? rwg + (u.x1 - 4) * 256 : wag + u.x1 * 256; const int ldc = gate ? 512 : 1536;
#pragma unroll
        for (int ai = 0; ai < 2; ++ai)
#pragma unroll
            for (int m = 0; m < 4; ++m) {
                bf16_t* rowp = O + (size_t)(u.x0 * 256 + ai * 128 + wr * 64 + m * 16 + fr) * ldc + wc * 32 + 8 * fq;
#pragma unroll
                for (int bj = 0; bj < 2; ++bj) {
                    const f32x4 v0 = acc[ai][bj][m][0], v1 = acc[ai][bj][m][1];
                    u32x4 w; w.x = g8::cvt_pk_bf16(v0[0], v0[1]); w.y = g8::cvt_pk_bf16(v0[2], v0[3]); w.z = g8::cvt_pk_bf16(v1[0], v1[1]); w.w = g8::cvt_pk_bf16(v1[2], v1[3]);
                    *(u32x4*)(rowp + bj * 128) = w;
                }
            }
    }
};
struct SchedLoraK {
    const bf16_t* A; const bf16_t* Bt;
    __device__ __forceinline__ bool next(int i, g8::Unit& u, int R0, int C0, int R1, int C1) const {
        int pm, pn; if (!g8::static_tile(i, (int)gridDim.x, (int)blockIdx.x, T / 256, 1536 / 256, pm, pn)) return false;
        const int koff = pn >= 4 ? 64 : 0;
        g8::dense_unit(u, A + koff, 256, Bt + koff, 256, pm, pn, R0, C0, R1, C1); return true;
    }
};
__device__ __forceinline__ void phase4(const Params& P, LAS unsigned char* lds, float* ldsf) {
    unsigned char* ws = P.ws;
    {
        SchedLoraK Sd{(const bf16_t*)(ws + WS_LX), (const bf16_t*)(ws + WS_WLORA)};
        EpiLora E{(bf16_t*)(ws + WS_WAG), (bf16_t*)(ws + WS_RW_G)};
        g8::gemm_phase<true>(lds, 128, 256, Sd, E);
    }
    __syncthreads();
    float* w2s = ldsf;
    float* hs = ldsf + 2 * 128 * 64 + (tidx() >> 6) * 128;
    for (int i = tidx(); i < 2 * 128 * 64 / 4; i += NTHREADS) { const int kv = i >> 11, j = i & 2047; ((f32x4*)w2s)[i] = ((const f32x4*)P.in[kv ? I_VW2 : I_KW2])[j]; }
    __syncthreads();
    const int lane = tidx() & 63, gw = blockIdx.x * NWAVES + (tidx() >> 6), ngw = gridDim.x * NWAVES;
    typedef float f2_ __attribute__((ext_vector_type(2)));
    f2_ bsum[2] = {(f2_){0.f, 0.f}, (f2_){0.f, 0.f}};
#pragma unroll
    for (int kv = 0; kv < 2; ++kv)
#pragma unroll
        for (int sl = 0; sl < 8; ++sl) bsum[kv] += *(const f2_*)((const float*)(ws + WS_BIAS1) + (kv * 8 + sl) * 128 + 2 * lane);
    for (int item = gw; item < 2 * 4096; item += ngw) {
        const int kv = item >> 12, row = item & 4095;
        f2_ hsum = kv ? bsum[1] : bsum[0];
#pragma unroll
        for (int ks = 0; ks < 8; ++ks) hsum += *(const f2_*)((const float*)(ws + WS_CPART) + ((size_t)((ks * 2 + kv) * 4096 + row)) * 128 + 2 * lane);
        hs[2 * lane] = gelu_tanh(hsum.x); hs[2 * lane + 1] = gelu_tanh(hsum.y);
        asm volatile("s_waitcnt lgkmcnt(0)" ::: "memory");
        const int ns = kv ? lane : rope_d(lane);
        const float* wc = w2s + kv * 8192 + ns;
        float a0 = 0.f, a1 = 0.f;
#pragma unroll 8
        for (int c = 0; c < 128; c += 4) { const f32x4 h4 = *(const f32x4*)(hs + c); a0 += h4.x * wc[c * 64] + h4.z * wc[(c + 2) * 64]; a1 += h4.y * wc[(c + 1) * 64] + h4.w * wc[(c + 3) * 64]; }
        const float a = a0 + a1;
        { const int bg = row >> 9, i = row & 511, key = i & 63, n = lane; unsigned char* ti = ws + WS_CMPI + ((size_t)bg * 8 + (i >> 6)) * 16384;
          if (kv == 0) *(bf16_t*)(ti + (n >> 3) * 1024 + key * 16 + (n & 7) * 2) = (bf16_t)f2bf(a);
          else *(bf16_t*)(ti + 8192 + (n >> 5) * 4096 + (key >> 4) * 1024 + (key & 15) * 64 + (n & 31) * 2) = (bf16_t)f2bf(a); }
        asm volatile("s_waitcnt lgkmcnt(0)" ::: "memory");
    }
}

__device__ __forceinline__ void phase5p(const Params& P) {
    unsigned char* ws = P.ws;
    const int lane = tidx() & 63, gw = blockIdx.x * NWAVES + (tidx() >> 6), ngw = gridDim.x * NWAVES, c0 = 8 * lane;
    const bf16_t* proj = (const bf16_t*)(ws + WS_PROJ); const bf16_t* wag = (const bf16_t*)(ws + WS_WAG);
    const float* mu = P.in[I_MU];
    float w0[8], a0v[8], kkw[8], kaw[8], mur[8], muk[8], muv[8], rkc[8];
#pragma unroll
    for (int i = 0; i < 8; ++i) { rkc[i] = P.in[I_RK][c0 + i]; w0[i] = P.in[I_W0][c0 + i]; a0v[i] = P.in[I_A0][c0 + i]; kkw[i] = P.in[I_KK][c0 + i]; kaw[i] = P.in[I_KA][c0 + i]; mur[i] = mu[c0 + i]; muk[i] = mu[512 + c0 + i]; muv[i] = mu[1024 + c0 + i]; }
    for (int chunk = gw; chunk < T / 16; chunk += ngw) {
        const int row0 = chunk * 16;
        float rp[8], kp[8], vp[8];
#pragma unroll
        for (int i = 0; i < 8; ++i) { rp[i] = 0.f; kp[i] = 0.f; vp[i] = 0.f; }
        if ((row0 & (S - 1)) != 0) { const bf16_t* pp = proj + (size_t)(row0 - 1) * NP + c0; unpack8(*(const u32x4*)(pp + R0), rp); unpack8(*(const u32x4*)(pp + K0), kp); unpack8(*(const u32x4*)(pp + V0), vp); }
        for (int i2 = 0; i2 < 16; i2 += 2) {
            u32x4 r8[2], k8[2], v8[2], wl8[2], al8[2];
#pragma unroll
            for (int q = 0; q < 2; ++q) {
                const bf16_t* pr = proj + (size_t)(row0 + i2 + q) * NP + c0; const bf16_t* wg = wag + (size_t)(row0 + i2 + q) * 1536 + c0;
                r8[q] = *(const u32x4*)(pr + R0); k8[q] = *(const u32x4*)(pr + K0); v8[q] = *(const u32x4*)(pr + V0);
                wl8[q] = *(const u32x4*)(wg); al8[q] = *(const u32x4*)(wg + 512);
            }
#pragma unroll
            for (int q = 0; q < 2; ++q) {
                float rc[8], kc[8], vc[8], wl[8], al[8];
                unpack8(r8[q], rc); unpack8(k8[q], kc); unpack8(v8[q], vc); unpack8(wl8[q], wl); unpack8(al8[q], al);
                float ro[8], ko[8], vo[8], wo[8], kk[8], kka[8], av[8]; float ss = 0.f, bsp = 0.f;
#pragma unroll
                for (int i = 0; i < 8; ++i) {
                    ro[i] = rc[i] + (rp[i] - rc[i]) * mur[i]; const float k = kc[i] + (kp[i] - kc[i]) * muk[i]; vo[i] = vc[i] + (vp[i] - vc[i]) * muv[i];
                    av[i] = sigmoidf_(a0v[i] + al[i]);
                    wo[i] = __expf(-0.6065306597126334f * sigmoidf_(w0[i] + wl[i]));
                    kk[i] = k * kkw[i]; ss += kk[i] * kk[i];
                    ko[i] = k * (1.f + (av[i] - 1.f) * kaw[i]);
                    bsp += ro[i] * ko[i] * rkc[i];
                    rp[i] = rc[i]; kp[i] = kc[i]; vp[i] = vc[i];
                }
                ss += __shfl_xor(ss, 1); ss += __shfl_xor(ss, 2); ss += __shfl_xor(ss, 4);
                bsp += __shfl_xor(bsp, 1); bsp += __shfl_xor(bsp, 2); bsp += __shfl_xor(bsp, 4);
                if ((lane & 7) == 0) ((float*)(ws + WS_BS))[(size_t)(row0 + i2 + q) * 8 + (lane >> 3)] = bsp;
                const float inv = fminf(__builtin_amdgcn_rsqf(ss), 1e12f);
#pragma unroll
                for (int i = 0; i < 8; ++i) { kk[i] *= inv; kka[i] = kk[i] * av[i]; }
                const size_t o = (size_t)(row0 + i2 + q) * 512 + c0;
                *(f32x4*)((float*)(ws + WS_RW_W) + o) = (f32x4){wo[0], wo[1], wo[2], wo[3]}; *(f32x4*)((float*)(ws + WS_RW_W) + o + 4) = (f32x4){wo[4], wo[5], wo[6], wo[7]};
                *(u32x4*)((bf16_t*)(ws + WS_RW_R) + o) = pack8(ro); *(u32x4*)((bf16_t*)(ws + WS_RW_K) + o) = pack8(ko); *(u32x4*)((bf16_t*)(ws + WS_RW_V) + o) = pack8(vo);
                *(u32x4*)((bf16_t*)(ws + WS_RW_KK) + o) = pack8(kk); *(u32x4*)((bf16_t*)(ws + WS_RW_KKA) + o) = pack8(kka);
            }
        }
    }
}

namespace att {
typedef float f32x16 __attribute__((ext_vector_type(16)));
typedef short s16x4 __attribute__((ext_vector_type(4)));
typedef float f32x2_t __attribute__((ext_vector_type(2)));
typedef __bf16 bf16x2_t __attribute__((ext_vector_type(2)));
constexpr float C2 = 0.125f * 1.4426950408889634f;
constexpr int SLOT = 16384;
constexpr int GROUP = 3, NSLOT = 2 * GROUP;
constexpr int IMP_STRIDE = 136;
constexpr int WAVE_LDS = 256 + 8 * IMP_STRIDE * 4 + 128;
constexpr int WAVE_OFF = NSLOT * SLOT;
constexpr int LDS_NEED = WAVE_OFF + NWAVES * WAVE_LDS;
constexpr int QT = 8 * NWAVES;
constexpr float THR = 8.f;

__device__ __forceinline__ int crow(int r, int hi) { return (r & 3) + 8 * (r >> 2) + 4 * hi; }
__device__ __forceinline__ unsigned cvtpk(float lo, float hi) { f32x2_t v = {lo, hi}; bf16x2_t b = __builtin_convertvector(v, bf16x2_t); return __builtin_bit_cast(unsigned, b); }
__device__ __forceinline__ float ex2(float x) { return __builtin_amdgcn_exp2f(x); }

__device__ __forceinline__ void tile_dma(const unsigned char* gt, LAS unsigned char* slot, int wid, int lane) {
    const unsigned char* src = gt + wid * 2048 + lane * 16;
    __builtin_amdgcn_global_load_lds((const unsigned*)src, (LAS unsigned*)(slot + wid * 2048), 16, 0, 0);
    __builtin_amdgcn_global_load_lds((const unsigned*)(src + 1024), (LAS unsigned*)(slot + wid * 2048 + 1024), 16, 0, 0);
}
__device__ __forceinline__ void qkt(f32x16& p0, f32x16& p1, const LAS unsigned char* Kslot, const bf16x8 (&qr)[4], float cinit, int r32, int hi) {
    const LAS unsigned char* kb = Kslot + hi * 1024 + r32 * 16;
#pragma unroll
    for (int r = 0; r < 16; ++r) { p0[r] = cinit; p1[r] = cinit; }
#pragma unroll
    for (int d0 = 0; d0 < 4; ++d0) {
        const bf16x8 b0 = *(const LAS bf16x8*)(kb + d0 * 2048);
        const bf16x8 b1 = *(const LAS bf16x8*)(kb + d0 * 2048 + 512);
        p0 = __builtin_amdgcn_mfma_f32_32x32x16_bf16(b0, qr[d0], p0, 0, 0, 0);
        p1 = __builtin_amdgcn_mfma_f32_32x32x16_bf16(b1, qr[d0], p1, 0, 0, 0);
    }
}
struct VFrag { s16x4 lo[2][4], hi[2][4]; };
__device__ __forceinline__ void pv_read(VFrag& v, int vb) {
#pragma unroll
    for (int d0 = 0; d0 < 2; ++d0)
#pragma unroll
        for (int ks = 0; ks < 4; ++ks) {
            asm volatile("ds_read_b64_tr_b16 %0,%1 offset:%c2" : "=&v"(v.lo[d0][ks]) : "v"(vb), "i"(d0 * 4096 + ks * 1024) : "memory");
            asm volatile("ds_read_b64_tr_b16 %0,%1 offset:%c2" : "=&v"(v.hi[d0][ks]) : "v"(vb), "i"(d0 * 4096 + ks * 1024 + 512) : "memory");
        }
}
__device__ __forceinline__ void pv_mma(f32x16 (&o)[2], VFrag& v, bf16x8 pa0, bf16x8 pa1, bf16x8 pa2, bf16x8 pa3) {
    asm volatile("s_waitcnt lgkmcnt(0)" : "+v"(v.lo[0][0]), "+v"(v.lo[0][1]), "+v"(v.lo[0][2]), "+v"(v.lo[0][3]), "+v"(v.hi[0][0]), "+v"(v.hi[0][1]), "+v"(v.hi[0][2]), "+v"(v.hi[0][3]) :: "memory");
    asm volatile("" : "+v"(v.lo[1][0]), "+v"(v.lo[1][1]), "+v"(v.lo[1][2]), "+v"(v.lo[1][3]), "+v"(v.hi[1][0]), "+v"(v.hi[1][1]), "+v"(v.hi[1][2]), "+v"(v.hi[1][3]));
#pragma unroll
    for (int d0 = 0; d0 < 2; ++d0) {
#define ATT_PK(k) (bf16x8){v.lo[d0][k][0], v.lo[d0][k][1], v.lo[d0][k][2], v.lo[d0][k][3], v.hi[d0][k][0], v.hi[d0][k][1], v.hi[d0][k][2], v.hi[d0][k][3]}
        o[d0] = __builtin_amdgcn_mfma_f32_32x32x16_bf16(pa0, ATT_PK(0), o[d0], 0, 0, 0);
        o[d0] = __builtin_amdgcn_mfma_f32_32x32x16_bf16(pa1, ATT_PK(1), o[d0], 0, 0, 0);
        o[d0] = __builtin_amdgcn_mfma_f32_32x32x16_bf16(pa2, ATT_PK(2), o[d0], 0, 0, 0);
        o[d0] = __builtin_amdgcn_mfma_f32_32x32x16_bf16(pa3, ATT_PK(3), o[d0], 0, 0, 0);
#undef ATT_PK
    }
}
__device__ __forceinline__ float max3f(float a, float b, float c) { float r; asm("v_max3_f32 %0, %1, %2, %3" : "=v"(r) : "v"(a), "v"(b), "v"(c)); return r; }
__device__ __forceinline__ float max32(const f32x16& p0, const f32x16& p1) {
    float a = max3f(p0[0], p0[1], p1[0]), b = max3f(p0[2], p0[3], p1[1]); a = max3f(a, p1[2], p1[3]);
#pragma unroll
    for (int r = 4; r < 16; r += 4) { a = max3f(a, p0[r], p0[r + 1]); b = max3f(b, p0[r + 2], p0[r + 3]); a = max3f(a, p1[r], p1[r + 1]); b = max3f(b, p1[r + 2], p1[r + 3]); }
    a = fmaxf(a, b);
    float x = a, y = a;
    asm volatile("s_nop 1\n\tv_permlane32_swap_b32 %0, %1" : "+v"(x), "+v"(y));
    return fmaxf(x, y);
}
__device__ __forceinline__ void pack_p(const f32x16& p0, const f32x16& p1, bf16x8& a0, bf16x8& a1, bf16x8& a2, bf16x8& a3) {
    u32x4 w0 = {cvtpk(p0[0], p0[1]), cvtpk(p0[2], p0[3]), cvtpk(p0[4], p0[5]), cvtpk(p0[6], p0[7])};
    u32x4 w1 = {cvtpk(p0[8], p0[9]), cvtpk(p0[10], p0[11]), cvtpk(p0[12], p0[13]), cvtpk(p0[14], p0[15])};
    u32x4 w2 = {cvtpk(p1[0], p1[1]), cvtpk(p1[2], p1[3]), cvtpk(p1[4], p1[5]), cvtpk(p1[6], p1[7])};
    u32x4 w3 = {cvtpk(p1[8], p1[9]), cvtpk(p1[10], p1[11]), cvtpk(p1[12], p1[13]), cvtpk(p1[14], p1[15])};
    a0 = __builtin_bit_cast(bf16x8, w0); a1 = __builtin_bit_cast(bf16x8, w1); a2 = __builtin_bit_cast(bf16x8, w2); a3 = __builtin_bit_cast(bf16x8, w3);
}
__device__ __forceinline__ void bcast_rows(LAS float* wsf, float v, int r32, int hi, float (&f)[16]) {
    if (hi == 0) wsf[r32] = v;
    asm volatile("s_waitcnt lgkmcnt(0)" ::: "memory");
#pragma unroll
    for (int r = 0; r < 16; ++r) f[r] = wsf[crow(r, hi)];
    asm volatile("s_waitcnt lgkmcnt(0)" ::: "memory");
}

__device__ __forceinline__ void issue_group0(LAS unsigned char* lds, const unsigned char* img, int t_lo, int t_hi) {
    if (t_lo > t_hi) return;
    const int tid = tidx(), wid = __builtin_amdgcn_readfirstlane(tid >> 6), lane = tid & 63;
    for (int tt = 0; tt < GROUP; ++tt) if (t_lo + tt <= t_hi) tile_dma(img + (size_t)(t_lo + tt) * SLOT, lds + tt * SLOT, wid, lane);
}
template <int MODE, class PreF, class MaskF>
__device__ __forceinline__ void flash_pass(LAS unsigned char* lds, LAS float* wsf, LAS float* imp, const unsigned char* img, int t_lo, int t_hi,
                                           const bf16x8 (&qr)[4], PreF pref, MaskF maskf, float& m, float& l, f32x16 (&o)[2], int r32, int hi, bool nomax = false, int pre0 = 0) {
    if (t_lo > t_hi) return;
    const int tid = tidx(), wid = __builtin_amdgcn_readfirstlane(tid >> 6), lane = tid & 63;
    const int ngroups = (t_hi - t_lo + GROUP) / GROUP;
    if (!pre0) for (int tt = 0; tt < GROUP; ++tt) if (t_lo + tt <= t_hi) tile_dma(img + (size_t)(t_lo + tt) * SLOT, lds + tt * SLOT, wid, lane);
    asm volatile("s_waitcnt vmcnt(0)" ::: "memory");
    __syncthreads();
    const int vbl = (int)(unsigned)(uintptr_t)(lds + 8192) + ((tid >> 4) & 1) * 32 + (tid & 3) * 8 + (4 * hi + ((tid & 15) >> 2)) * 64;
    float carry_prev = 0.f; bool fresh = (MODE != 1);
    for (int gi = 0; gi < ngroups; ++gi) {
        const int half = (gi & 1) * GROUP;
        if (gi + 1 < ngroups) {
            for (int tt = 0; tt < GROUP; ++tt) { const int t = t_lo + (gi + 1) * GROUP + tt; if (t <= t_hi) tile_dma(img + (size_t)t * SLOT, lds + ((GROUP - half) + tt) * SLOT, wid, lane); }
        }
#pragma unroll 1
        for (int tt = 0; tt < GROUP; ++tt) {
            const int t = t_lo + gi * GROUP + tt;
            if (t > t_hi) break;
            bool sel = true;
            const bool act = pref(t, sel);
            if (!act) { if (MODE == 1) carry_prev = 0.f; continue; }
            LAS unsigned char* buf = lds + (half + tt) * SLOT;
            f32x16 p0, p1;
            qkt(p0, p1, buf, qr, sel ? -m : -__builtin_inff(), r32, hi);
            VFrag vf;
            if (MODE != 0) pv_read(vf, vbl + (half + tt) * SLOT);
            maskf(t, p0, p1);
            if (MODE == 0 || MODE == 2) {
                const float rm = (MODE == 2 && nomax) ? 0.f : max32(p0, p1);
                const float dl = (MODE == 2 && nomax) ? 0.f : (((fresh || rm > THR) && rm > -3.0e38f) ? rm : 0.f);
                if (!(MODE == 2 && nomax) && __any(dl != 0.f)) {
#pragma unroll
                    for (int r = 0; r < 16; ++r) { p0[r] -= dl; p1[r] -= dl; }
                    m += dl; const float alpha = ex2(-dl); l *= alpha;
                    if (MODE == 2 && !fresh) {
                        float f[16]; bcast_rows(wsf, alpha, r32, hi, f);
#pragma unroll
                        for (int r = 0; r < 16; ++r) { o[0][r] *= f[r]; o[1][r] *= f[r]; }
                    }
                }
                fresh = false;
                float sum = 0.f;
#pragma unroll
                for (int r = 0; r < 16; ++r) { p0[r] = ex2(p0[r]); p1[r] = ex2(p1[r]); sum += p0[r] + p1[r]; }
                l += sum;
            } else {
#pragma unroll
                for (int r = 0; r < 16; ++r) { p0[r] = ex2(p0[r]) * l; p1[r] = ex2(p1[r]) * l; }
                float a[8], cy[8];
#pragma unroll
                for (int k = 0; k < 4; ++k) {
                    a[k] = (p0[4 * k] + p0[4 * k + 1]) + (p0[4 * k + 2] + 0.5f * p0[4 * k + 3]); cy[k] = 0.5f * p0[4 * k + 3];
                    a[4 + k] = (p1[4 * k] + p1[4 * k + 1]) + (p1[4 * k + 2] + 0.5f * p1[4 * k + 3]); cy[4 + k] = 0.5f * p1[4 * k + 3];
                }
                float cx[8];
#pragma unroll
                for (int q8 = 0; q8 < 8; ++q8) cx[q8] = __shfl_xor(cy[q8], 32);
#pragma unroll
                for (int q8 = 0; q8 < 8; ++q8) {
                    float v = a[q8] + (hi ? cx[q8] : (q8 > 0 ? cx[q8 - 1] : carry_prev));
                    v += __shfl_xor(v, 1); v += __shfl_xor(v, 2);
                    if ((r32 & 3) == 0) imp[(r32 >> 2) * IMP_STRIDE + 16 * t + 2 * q8 + hi] = v;
                }
                carry_prev = cx[7];
            }
            if (MODE != 0) {
                bf16x8 a0, a1, a2, a3; pack_p(p0, p1, a0, a1, a2, a3);
                pv_mma(o, vf, a0, a1, a2, a3);
            }
        }
        asm volatile("s_waitcnt vmcnt(0)" ::: "memory");
        __syncthreads();
    }
}

__device__ __forceinline__ void nsa_unit(const Params& P, int b, int g, int t0, LAS unsigned char* lds) {
    unsigned char* ws = P.ws;
    const bf16_t* proj = (const bf16_t*)(ws + WS_PROJ);
    const int tid = tidx(), wid = tid >> 6, lane = tid & 63, r32 = lane & 31, hi = lane >> 5;
    LAS unsigned char* wl = lds + WAVE_OFF + wid * WAVE_LDS;
    LAS float* wsf = (LAS float*)wl; LAS float* imp = (LAS float*)(wl + 256); LAS unsigned* selm = (LAS unsigned*)(wl + 256 + 8 * IMP_STRIDE * 4);
    const int tq = t0 + 8 * wid + (r32 >> 2), head = g * 4 + (r32 & 3);
    const int tq_lo = __builtin_amdgcn_readfirstlane(t0 + 8 * wid);
    issue_group0(lds, ws + WS_CMPI + (size_t)(b * 2 + g) * 8 * SLOT, 0, (t0 + QT - 32) >> 10);
    const size_t row = (size_t)b * S + tq;
    bf16x8 qr[4];
#pragma unroll
    for (int d0 = 0; d0 < 4; ++d0) {
        const u32x4 raw = *(const u32x4*)(proj + row * NP + Q0 + head * 64 + d0 * 16 + hi * 8);
        u32x4 sc;
        sc.x = cvtpk(__builtin_bit_cast(float, raw.x << 16) * C2, __builtin_bit_cast(float, raw.x & 0xffff0000u) * C2); sc.y = cvtpk(__builtin_bit_cast(float, raw.y << 16) * C2, __builtin_bit_cast(float, raw.y & 0xffff0000u) * C2);
        sc.z = cvtpk(__builtin_bit_cast(float, raw.z << 16) * C2, __builtin_bit_cast(float, raw.z & 0xffff0000u) * C2); sc.w = cvtpk(__builtin_bit_cast(float, raw.w << 16) * C2, __builtin_bit_cast(float, raw.w & 0xffff0000u) * C2);
        qr[d0] = __builtin_bit_cast(bf16x8, sc);
    }
    float qsq = 0.f;
#pragma unroll
    for (int d0 = 0; d0 < 4; ++d0) { float qf[8]; unpack8(__builtin_bit_cast(u32x4, qr[d0]), qf);
#pragma unroll
        for (int i = 0; i < 8; ++i) qsq += qf[i] * qf[i]; }
    qsq += __shfl_xor(qsq, 32);
    const unsigned* hmx = (const unsigned*)(ws + WS_CTL) + 96 + b * 2 + g;
    const bf16_t* gl = proj + row * NP + GL0 + head * 3;
    const float g0 = sigmoidf_(bf2f(gl[0])), g1 = sigmoidf_(bf2f(gl[1])), g2 = sigmoidf_(bf2f(gl[2]));
    f32x16 o[2], out[2];
    auto emit = [&](float fac, bool first) {
        if (hi == 0) wsf[r32] = fac;
        asm volatile("s_waitcnt lgkmcnt(0)" ::: "memory");
#pragma unroll
        for (int r = 0; r < 16; ++r) {
            const float f = wsf[crow(r, hi)];
            if (first) { out[0][r] = o[0][r] * f; out[1][r] = o[1][r] * f; } else { out[0][r] += o[0][r] * f; out[1][r] += o[1][r] * f; }
        }
        asm volatile("s_waitcnt lgkmcnt(0)" ::: "memory");
    };
    const float NINF = -__builtin_inff();
    auto pre_all = [&](int, bool&) -> bool { return true; };
    for (int i = lane; i < 8 * IMP_STRIDE; i += 64) imp[i] = 0.f;
    {
        const unsigned char* img = ws + WS_CMPI + (size_t)(b * 2 + g) * 8 * SLOT;
        const int c_hi = (t0 + QT - 32) >> 10;
        const int ivis = tq >= 31 ? ((tq - 31) >> 4) : -1;
        const int ivis_lo = tq_lo >= 31 ? ((tq_lo - 31) >> 4) : -1;
        auto maskc = [&](int t, f32x16& p0, f32x16& p1) {
            if (64 * t + 63 > ivis_lo) {
                const int kb = 64 * t + 4 * hi;
#pragma unroll
                for (int r = 0; r < 16; ++r) { const int i = kb + (r & 3) + 8 * (r >> 2); if (i > ivis) p0[r] = NINF; if (i + 32 > ivis) p1[r] = NINF; }
            }
        };
        float m = 0.f, l = 0.f;
        flash_pass<0>(lds, wsf, imp, img, 0, c_hi, qr, pre_all, maskc, m, l, o, r32, hi, false, 1);
        l += __shfl_xor(l, 32);
        float linv = l > 0.f ? 1.f / l : 0.f;
        o[0] = (f32x16){0.f}; o[1] = (f32x16){0.f};
        flash_pass<1>(lds, wsf, imp, img, 0, c_hi, qr, pre_all, maskc, m, linv, o, r32, hi, false, c_hi <= GROUP - 1 ? 2 : 0);
        issue_group0(lds, ws + WS_KVI + (size_t)((0 * NB + b) * 2 + g) * (S / 64) * SLOT, 0, (t0 + QT - 1) >> 6);
        emit(g0, true);
    }
    unsigned sw0, sw1, sw2, sw3;
    {
        const int tok = lane >> 3, sub = lane & 7, tqs = t0 + 8 * wid + tok, cur = tqs >> 6;
        unsigned key[16];
#pragma unroll
        for (int e = 0; e < 16; ++e) {
            const int j = 8 * e + sub; float x = imp[tok * IMP_STRIDE + j];
            if (j == 0 || j == cur || j == cur - 1) x = 1.0e9f;
            key[e] = (j * 64 > tqs) ? 0u : ((__builtin_bit_cast(unsigned, fmaxf(x, 0.f)) & ~0xffu) | (unsigned)(255 - j));
        }
        unsigned m0 = 0u, m1 = 0u, m2 = 0u, m3 = 0u;
#pragma unroll 1
        for (int r = 0; r < 16; ++r) {
            unsigned bk = key[0];
#pragma unroll
            for (int e = 1; e < 16; ++e) bk = bk > key[e] ? bk : key[e];
            { const unsigned o1 = (unsigned)__builtin_amdgcn_update_dpp((int)bk, (int)bk, 0xB1, 0xf, 0xf, false); bk = bk > o1 ? bk : o1; }
            { const unsigned o2 = (unsigned)__builtin_amdgcn_update_dpp((int)bk, (int)bk, 0x4E, 0xf, 0xf, false); bk = bk > o2 ? bk : o2; }
            { const unsigned o3 = (unsigned)__builtin_amdgcn_update_dpp((int)bk, (int)bk, 0x141, 0xf, 0xf, false); bk = bk > o3 ? bk : o3; }
            if (bk != 0u) {
                const int bj = 255 - (int)(bk & 0xffu);
                const unsigned bit = 1u << (bj & 31); const int wq = bj >> 5;
                m0 |= wq == 0 ? bit : 0u; m1 |= wq == 1 ? bit : 0u; m2 |= wq == 2 ? bit : 0u; m3 |= wq == 3 ? bit : 0u;
#pragma unroll
                for (int e = 0; e < 16; ++e) key[e] = key[e] == bk ? 0u : key[e];
            }
        }
        if (sub == 0) { selm[tok * 4 + 0] = m0; selm[tok * 4 + 1] = m1; selm[tok * 4 + 2] = m2; selm[tok * 4 + 3] = m3; }
        asm volatile("s_waitcnt lgkmcnt(0)" ::: "memory");
        sw0 = selm[(r32 >> 2) * 4 + 0]; sw1 = selm[(r32 >> 2) * 4 + 1]; sw2 = selm[(r32 >> 2) * 4 + 2]; sw3 = selm[(r32 >> 2) * 4 + 3];
        asm volatile("s_waitcnt lgkmcnt(0)" ::: "memory");
    }
    {
        const unsigned char* img = ws + WS_KVI + (size_t)((0 * NB + b) * 2 + g) * (S / 64) * SLOT;
        auto pres = [&](int t, bool& sel) -> bool {
            const unsigned w = t < 32 ? sw0 : (t < 64 ? sw1 : (t < 96 ? sw2 : sw3));
            sel = (w >> (t & 31)) & 1u;
            return __any(sel);
        };
        auto masks = [&](int t, f32x16& p0, f32x16& p1) {
            if (64 * t + 63 > tq_lo) {
                const int kb0 = 64 * t + 4 * hi;
#pragma unroll
                for (int r = 0; r < 16; ++r) { const int pos = kb0 + (r & 3) + 8 * (r >> 2); if (pos > tq) p0[r] = NINF; if (pos + 32 > tq) p1[r] = NINF; }
            }
        };
        float m = 0.f, l = 0.f; o[0] = (f32x16){0.f}; o[1] = (f32x16){0.f};
        const bool nomax = __all(qsq * 2.f * __builtin_bit_cast(float, hmx[0]) <= 1600.f);
        flash_pass<2>(lds, wsf, imp, img, 0, (t0 + QT - 1) >> 6, qr, pres, masks, m, l, o, r32, hi, nomax, 1);
        { const int lo_w = t0 - 511 > 0 ? (t0 - 511) >> 6 : 0; issue_group0(lds, ws + WS_KVI + (size_t)((1 * NB + b) * 2 + g) * (S / 64) * SLOT, lo_w, (t0 + QT - 1) >> 6); }
        l += __shfl_xor(l, 32);
        emit(l > 0.f ? g1 / l : 0.f, false);
    }
    {
        const unsigned char* img = ws + WS_KVI + (size_t)((1 * NB + b) * 2 + g) * (S / 64) * SLOT;
        auto maskw = [&](int t, f32x16& p0, f32x16& p1) {
            if (64 * t + 63 > tq_lo || 64 * t < tq_lo + 7 - 511) {
                const int kb0 = 64 * t + 4 * hi;
#pragma unroll
                for (int r = 0; r < 16; ++r) { const int pos = kb0 + (r & 3) + 8 * (r >> 2); if (pos > tq || pos < tq - 511) p0[r] = NINF; if (pos + 32 > tq || pos + 32 < tq - 511) p1[r] = NINF; }
            }
        };
        float m = 0.f, l = 0.f; o[0] = (f32x16){0.f}; o[1] = (f32x16){0.f};
        const int lo = t0 - 511 > 0 ? (t0 - 511) >> 6 : 0;
        const bool nomax = __all(qsq * 2.f * __builtin_bit_cast(float, hmx[8]) <= 1600.f);
        flash_pass<2>(lds, wsf, imp, img, lo, (t0 + QT - 1) >> 6, qr, pre_all, maskw, m, l, o, r32, hi, nomax, 1);
        l += __shfl_xor(l, 32);
        emit(l > 0.f ? g2 / l : 0.f, false);
    }
    bf16_t* on = (bf16_t*)(ws + WS_ONSA) + ((size_t)b * S + t0 + 8 * wid) * 512 + g * 256 + r32;
#pragma unroll
    for (int r = 0; r < 16; ++r) {
        const int q = crow(r, hi); bf16_t* op = on + (size_t)(q >> 2) * 512 + (q & 3) * 64;
        op[0] = (bf16_t)f2bf(out[0][r]); op[32] = (bf16_t)f2bf(out[1][r]);
    }
}
}

template <int CTRL> __device__ __forceinline__ float dppf(float v) { return __builtin_bit_cast(float, __builtin_amdgcn_update_dpp(0, __builtin_bit_cast(int, v), CTRL, 0xf, 0xf, true)); }
__device__ __forceinline__ float sum16(float v) { v += dppf<0x128>(v); v += dppf<0x124>(v); v += dppf<0x122>(v); v += dppf<0x121>(v); return v; }
struct ScanRegs { f32x4 w0, w1; u32x4 kk, ka, k, r; unsigned v; };
__device__ __forceinline__ f32x4 bflo(u32x4 u) { return (f32x4){__builtin_bit_cast(float, u.x << 16), __builtin_bit_cast(float, u.x & 0xffff0000u), __builtin_bit_cast(float, u.y << 16), __builtin_bit_cast(float, u.y & 0xffff0000u)}; }
__device__ __forceinline__ f32x4 bfhi(u32x4 u) { return (f32x4){__builtin_bit_cast(float, u.z << 16), __builtin_bit_cast(float, u.z & 0xffff0000u), __builtin_bit_cast(float, u.w << 16), __builtin_bit_cast(float, u.w & 0xffff0000u)}; }
__device__ __forceinline__ void rwkv_scan_unit(const Params& P, int b, int h, int qr, int unit, float* sm  ) {
    unsigned char* ws = P.ws;
    const int tid = tidx(); const bool comp = tid < 256;
    const int rowl = (tid & 255) >> 4, l16 = tid & 15;
    const int lst = (tid & 255) >> 3, j8 = tid & 7;
    float s0 = 0.f, s1 = 0.f, s2 = 0.f, s3 = 0.f;
    const float* Ww = (const float*)(ws + WS_RW_W);
    const bf16_t* Rr = (const bf16_t*)(ws + WS_RW_R); const bf16_t* Kk = (const bf16_t*)(ws + WS_RW_K); const bf16_t* Vv = (const bf16_t*)(ws + WS_RW_V);
    const bf16_t* KK = (const bf16_t*)(ws + WS_RW_KK); const bf16_t* KA = (const bf16_t*)(ws + WS_RW_KKA);
    float* Y = (float*)(ws + WS_Y);
    constexpr int SR = 336, CH = 32 * SR;
    auto gload = [&](ScanRegs& R, int t0) {
        const size_t base = ((size_t)b * S + t0 + lst) * 512 + h * 64 + 8 * j8;
        R.w0 = *(const f32x4*)(Ww + base); R.w1 = *(const f32x4*)(Ww + base + 4); R.kk = *(const u32x4*)(KK + base); R.ka = *(const u32x4*)(KA + base);
        R.k = *(const u32x4*)(Kk + base); R.r = *(const u32x4*)(Rr + base); R.v = *(const unsigned*)(Vv + base - 8 * j8 + qr * 16 + 2 * j8);
    };
    auto lstore = [&](const ScanRegs& R, float* buf) {
        float* q = buf + lst * SR + 8 * j8;
        *(f32x4*)q = R.w0; *(f32x4*)(q + 4) = R.w1; *(f32x4*)(q + 64) = bflo(R.kk); *(f32x4*)(q + 68) = bfhi(R.kk); *(f32x4*)(q + 128) = bflo(R.ka); *(f32x4*)(q + 132) = bfhi(R.ka);
        *(f32x4*)(q + 192) = bflo(R.k); *(f32x4*)(q + 196) = bfhi(R.k); *(f32x4*)(q + 256) = bflo(R.r); *(f32x4*)(q + 260) = bfhi(R.r);
        buf[lst * SR + 320 + 2 * j8] = __builtin_bit_cast(float, R.v << 16); buf[lst * SR + 321 + 2 * j8] = __builtin_bit_cast(float, R.v & 0xffff0000u);
    };
    typedef float f2 __attribute__((ext_vector_type(2)));
    auto compute16 = [&](const float* buf) -> float {
        const float* q0 = buf + l16 * 4; const float* qv = buf + 320 + rowl;
        f2 sa_ = {s0, s1}, sb_ = {s2, s3};
        f32x4 w = *(const f32x4*)(q0), kk = *(const f32x4*)(q0 + 64), ka = *(const f32x4*)(q0 + 128), k = *(const f32x4*)(q0 + 192), r = *(const f32x4*)(q0 + 256);
        float v = qv[0];
        float ep[16];
#pragma unroll
        for (int st = 0; st < 16; ++st) {
            f32x4 wn, kkn, kan, kn, rn; float vn;
            if (st < 15) { const float* q = q0 + (st + 1) * SR; wn = *(const f32x4*)(q); kkn = *(const f32x4*)(q + 64); kan = *(const f32x4*)(q + 128); kn = *(const f32x4*)(q + 192); rn = *(const f32x4*)(q + 256); vn = qv[(st + 1) * SR]; }
            const f2 d = sa_ * (f2){kk.x, kk.y} + sb_ * (f2){kk.z, kk.w};
            const float sa = -sum16(d.x + d.y);
            const f2 vv = {v, v}, ss = {sa, sa};
            const f2 ta = sa_ * (f2){w.x, w.y} + vv * (f2){k.x, k.y}, tb = sb_ * (f2){w.z, w.w} + vv * (f2){k.z, k.w};
            sa_ = ta + ss * (f2){ka.x, ka.y}; sb_ = tb + ss * (f2){ka.z, ka.w};
            const f2 e = sa_ * (f2){r.x, r.y} + sb_ * (f2){r.z, r.w};
            ep[st] = e.x + e.y;
            asm volatile("" : "+v"(ep[st]));
            if (st < 15) { w = wn; kk = kkn; ka = kan; k = kn; r = rn; v = vn; }
        }
        s0 = sa_.x; s1 = sa_.y; s2 = sb_.x; s3 = sb_.y;
        const bool b3 = (l16 & 8) != 0, b2 = (l16 & 4) != 0, b1 = (l16 & 2) != 0, b0 = (l16 & 1) != 0;
        float e8[8], e4[4], e2[2];
        asm volatile("s_nop 1\n\t"
                     "v_add_f32_dpp %0, %8, %8 row_ror:8 row_mask:0xf bank_mask:0x3\n\tv_add_f32_dpp %0, %16, %16 row_ror:8 row_mask:0xf bank_mask:0xc\n\t"
                     "v_add_f32_dpp %1, %9, %9 row_ror:8 row_mask:0xf bank_mask:0x3\n\tv_add_f32_dpp %1, %17, %17 row_ror:8 row_mask:0xf bank_mask:0xc\n\t"
                     "v_add_f32_dpp %2, %10, %10 row_ror:8 row_mask:0xf bank_mask:0x3\n\tv_add_f32_dpp %2, %18, %18 row_ror:8 row_mask:0xf bank_mask:0xc\n\t"
                     "v_add_f32_dpp %3, %11, %11 row_ror:8 row_mask:0xf bank_mask:0x3\n\tv_add_f32_dpp %3, %19, %19 row_ror:8 row_mask:0xf bank_mask:0xc\n\t"
                     "v_add_f32_dpp %4, %12, %12 row_ror:8 row_mask:0xf bank_mask:0x3\n\tv_add_f32_dpp %4, %20, %20 row_ror:8 row_mask:0xf bank_mask:0xc\n\t"
                     "v_add_f32_dpp %5, %13, %13 row_ror:8 row_mask:0xf bank_mask:0x3\n\tv_add_f32_dpp %5, %21, %21 row_ror:8 row_mask:0xf bank_mask:0xc\n\t"
                     "v_add_f32_dpp %6, %14, %14 row_ror:8 row_mask:0xf bank_mask:0x3\n\tv_add_f32_dpp %6, %22, %22 row_ror:8 row_mask:0xf bank_mask:0xc\n\t"
                     "v_add_f32_dpp %7, %15, %15 row_ror:8 row_mask:0xf bank_mask:0x3\n\tv_add_f32_dpp %7, %23, %23 row_ror:8 row_mask:0xf bank_mask:0xc"
                     : "=&v"(e8[0]), "=&v"(e8[1]), "=&v"(e8[2]), "=&v"(e8[3]), "=&v"(e8[4]), "=&v"(e8[5]), "=&v"(e8[6]), "=&v"(e8[7])
                     : "v"(ep[0]), "v"(ep[1]), "v"(ep[2]), "v"(ep[3]), "v"(ep[4]), "v"(ep[5]), "v"(ep[6]), "v"(ep[7]),
                       "v"(ep[8]), "v"(ep[9]), "v"(ep[10]), "v"(ep[11]), "v"(ep[12]), "v"(ep[13]), "v"(ep[14]), "v"(ep[15]));
        asm volatile("s_nop 1\n\t"
                     "v_add_f32_dpp %0, %4, %4 row_half_mirror row_mask:0xf bank_mask:0x5\n\tv_add_f32_dpp %0, %8, %8 row_half_mirror row_mask:0xf bank_mask:0xa\n\t"
                     "v_add_f32_dpp %1, %5, %5 row_half_mirror row_mask:0xf bank_mask:0x5\n\tv_add_f32_dpp %1, %9, %9 row_half_mirror row_mask:0xf bank_mask:0xa\n\t"
                     "v_add_f32_dpp %2, %6, %6 row_half_mirror row_mask:0xf bank_mask:0x5\n\tv_add_f32_dpp %2, %10, %10 row_half_mirror row_mask:0xf bank_mask:0xa\n\t"
                     "v_add_f32_dpp %3, %7, %7 row_half_mirror row_mask:0xf bank_mask:0x5\n\tv_add_f32_dpp %3, %11, %11 row_half_mirror row_mask:0xf bank_mask:0xa"
                     : "=&v"(e4[0]), "=&v"(e4[1]), "=&v"(e4[2]), "=&v"(e4[3])
                     : "v"(e8[0]), "v"(e8[1]), "v"(e8[2]), "v"(e8[3]), "v"(e8[4]), "v"(e8[5]), "v"(e8[6]), "v"(e8[7]));
#pragma unroll
        for (int i = 0; i < 2; ++i) { const float keep = b1 ? e4[i + 2] : e4[i], send = b1 ? e4[i] : e4[i + 2]; e2[i] = keep + dppf<0x4E>(send); }
        { const float keep = b0 ? e2[1] : e2[0], send = b0 ? e2[0] : e2[1]; return keep + dppf<0xB1>(send); }
    };
    auto ystore = [&](float yk, int t0) { Y[((size_t)b * S + t0 + l16) * 512 + h * 64 + qr * 16 + rowl] = yk; };
    float* ct = sm + 2 * CH;
    constexpr int CT = 64 * 65;
    const int lt = tid & 255, ctx = lt & 63, cty = lt >> 6, cpp = lt >> 2, ckq = lt & 3;
    float cva[16], cvb[16];
    auto conv_src = [&](int tile, const float*& src, int& nsrc, unsigned char*& dst, int& p0, int& k0, int& col) {
        if (tile < 16384) { const int e = tile >> 9, q = tile & 511; src = P.in[I_EGU] + (size_t)e * 1024 * 2048; nsrc = 2048; dst = ws + WS_GU + (size_t)e * 2048 * 1024; p0 = (q >> 4) * 64; k0 = (q & 15) * 64; col = MapGU()(p0 + ctx); }
        else { const int t2 = tile - 16384, e = t2 >> 8, q = t2 & 255; src = P.in[I_EDN] + (size_t)e * 1024 * 1024; nsrc = 1024; dst = ws + WS_DN + (size_t)e * 1024 * 1024; p0 = (q >> 4) * 64; k0 = (q & 15) * 64; col = p0 + ctx; }
    };
    auto conv_load = [&](float (&cv)[16], int iv) {
        const int tile = unit * 192 + iv; if (iv >= 192 || !EXPERT_CONV_IN_SCAN) return;
        const float* src; int nsrc, p0, k0, col; unsigned char* dst; conv_src(tile, src, nsrc, dst, p0, k0, col);
#pragma unroll
        for (int i = 0; i < 16; ++i) cv[i] = src[(size_t)(k0 + cty + 4 * i) * nsrc + col];
    };
    auto conv_lds = [&](const float (&cv)[16], float* buf, int iv) {
        if (iv >= 192 || !EXPERT_CONV_IN_SCAN) return;
#pragma unroll
        for (int i = 0; i < 16; ++i) buf[(cty + 4 * i) * 65 + ctx] = cv[i];
    };
    auto conv_out = [&](const float* buf, int iv) {
        const int tile = unit * 192 + iv; if (iv >= 192 || !EXPERT_CONV_IN_SCAN) return;
        const float* src; int nsrc, p0, k0, col; unsigned char* dst; conv_src(tile, src, nsrc, dst, p0, k0, col);
        const float* tp = buf + (16 * ckq) * 65 + cpp;
        u32x4 o0;
        o0.x = pk4f8(32.f * tp[0], 32.f * tp[65], 32.f * tp[2 * 65], 32.f * tp[3 * 65]); o0.y = pk4f8(32.f * tp[4 * 65], 32.f * tp[5 * 65], 32.f * tp[6 * 65], 32.f * tp[7 * 65]);
        o0.z = pk4f8(32.f * tp[8 * 65], 32.f * tp[9 * 65], 32.f * tp[10 * 65], 32.f * tp[11 * 65]); o0.w = pk4f8(32.f * tp[12 * 65], 32.f * tp[13 * 65], 32.f * tp[14 * 65], 32.f * tp[15 * 65]);
        *(u32x4*)(dst + (size_t)(p0 + cpp) * 1024 + k0 + 16 * ckq) = o0;
    };
    ScanRegs RA, RB;
    __syncthreads();
    if (!comp) { gload(RA, 0); lstore(RA, sm); gload(RA, 32); gload(RB, 64); conv_load(cva, 0); conv_load(cvb, 1); }
    __syncthreads();
    if (comp) __builtin_amdgcn_s_setprio(3);
    for (int c = 0; c < S / 32; c += 2) {
        if (comp) { const float y0 = compute16(sm), y1 = compute16(sm + 16 * SR); ystore(y0, 32 * c); ystore(y1, 32 * c + 16); }
        else { lstore(RA, sm + CH); if (32 * (c + 3) < S) gload(RA, 32 * (c + 3)); conv_lds(cva, ct, c); }
        __syncthreads();
        if (comp) { const float y2 = compute16(sm + CH), y3 = compute16(sm + CH + 16 * SR); ystore(y2, 32 * (c + 1)); ystore(y3, 32 * (c + 1) + 16); }
        else { if (32 * (c + 2) < S) lstore(RB, sm); if (32 * (c + 4) < S) gload(RB, 32 * (c + 4)); conv_out(ct, c); conv_load(cva, c + 2); conv_lds(cvb, ct + CT, c + 1); }
        __syncthreads();
        if (!comp) { conv_out(ct + CT, c + 1); conv_load(cvb, c + 3); }
    }
    __builtin_amdgcn_s_setprio(0);
    __syncthreads();
}

__device__ __forceinline__ void phase5(const Params& P, LAS unsigned char* lds, float* ldsf) {
    constexpr int U_SCAN = NB * 8 * 4, U_ATT = NB * 2 * (S / att::QT);
    for (int u = blockIdx.x; u < U_SCAN; u += gridDim.x) rwkv_scan_unit(P, u >> 5, (u >> 2) & 7, u & 3, u, ldsf);
    unsigned* qhead = (unsigned*)(P.ws + WS_CTL) + 64;
    LAS int* slot = (LAS int*)(lds + LDS_RING + 64);
    for (;;) {
        __syncthreads();
        if (tidx() == 0) *slot = (int)atomicAdd(qhead, 1u);
        __syncthreads();
        const int a = *slot;
        if (a >= U_ATT) break;
        const int qt = (S / att::QT - 1) - (a >> 3), b = (a >> 1) & 3, g = a & 1;
        att::nsa_unit(P, b, g, qt * att::QT, lds);
    }
}


__device__ __forceinline__ void phase6(const Params& P) {
    unsigned char* ws = P.ws;
    const int lane = tidx() & 63, gw = blockIdx.x * NWAVES + (tidx() >> 6), ngw = gridDim.x * NWAVES, c0 = 8 * lane;
    unsigned char* amix = ws + WS_RA;
    float gn[8], lw[8], lb[8];
#pragma unroll
    for (int i = 0; i < 8; ++i) { gn[i] = P.in[I_NSANORM][c0 + i]; lw[i] = P.in[I_LNW][c0 + i]; lb[i] = P.in[I_LNB][c0 + i]; }
    for (int row = gw; row < T; row += ngw) {
        const size_t o = (size_t)row * 512 + c0;
        const u32x4 n8 = *(const u32x4*)((const bf16_t*)(ws + WS_ONSA) + o);
        const f32x4 y0 = *(const f32x4*)((const float*)(ws + WS_Y) + o), y1 = *(const f32x4*)((const float*)(ws + WS_Y) + o + 4);
        const u32x4 v8 = *(const u32x4*)((const bf16_t*)(ws + WS_RW_V) + o), g8 = *(const u32x4*)((const bf16_t*)(ws + WS_RW_G) + o);
        const float bs = ((const float*)(ws + WS_BS))[(size_t)row * 8 + (lane >> 3)];
        float nv[8]; unpack8(n8, nv); const float yv[8] = {y0.x, y0.y, y0.z, y0.w, y1.x, y1.y, y1.z, y1.w};
        float s = 0.f;
#pragma unroll
        for (int i = 0; i < 8; ++i) s += nv[i] * nv[i];
        const float rstd = rsqrtf(wave_sum(s) * (1.f / 512.f) + 1e-6f);
        float on[8];
#pragma unroll
        for (int i = 0; i < 8; ++i) on[i] = nv[i] * rstd * gn[i];
        float vv[8], gg[8]; unpack8(v8, vv); unpack8(g8, gg);
        float sm = 0.f;
#pragma unroll
        for (int i = 0; i < 8; ++i) sm += yv[i];
        sm += __shfl_xor(sm, 1); sm += __shfl_xor(sm, 2); sm += __shfl_xor(sm, 4);
        const float mean = sm * (1.f / 64.f); float vs = 0.f;
#pragma unroll
        for (int i = 0; i < 8; ++i) { const float d = yv[i] - mean; vs += d * d; }
        vs += __shfl_xor(vs, 1); vs += __shfl_xor(vs, 2); vs += __shfl_xor(vs, 4);
        const float rs = rsqrtf(vs * (1.f / 64.f) + 64e-5f);
        float oo[8];
#pragma unroll
        for (int i = 0; i < 8; ++i) oo[i] = ((yv[i] - mean) * rs * lw[i] + lb[i] + bs * vv[i]) * gg[i];
        float am = 0.f;
#pragma unroll
        for (int i = 0; i < 8; ++i) am = fmaxf(am, fmaxf(fabsf(on[i]), fabsf(oo[i])));
        am = wave_max(am);
        const float qm = am > 0.f ? 127.f / am : 0.f;
        if (lane == 0) ((float*)(ws + WS_SROW))[row] = am * (1.f / 127.f);
        { u32x2 w; w.x = pk4i8(on[0] * qm, on[1] * qm, on[2] * qm, on[3] * qm); w.y = pk4i8(on[4] * qm, on[5] * qm, on[6] * qm, on[7] * qm); *(u32x2*)(amix + (size_t)row * D + c0) = w; }
        { u32x2 w; w.x = pk4i8(oo[0] * qm, oo[1] * qm, oo[2] * qm, oo[3] * qm); w.y = pk4i8(oo[4] * qm, oo[5] * qm, oo[6] * qm, oo[7] * qm); *(u32x2*)(amix + (size_t)row * D + 512 + c0) = w; }
    }
}

struct EpiF32 {
    float* C; int ldc;
    __device__ __forceinline__ void operator()(const f32x4 (&acc)[2][2][4][2], const g8::Unit& u, int wr, int wc, int fr, int fq) const {
        const int row0 = u.x0 * 256 + wr * 64 + fr, col0 = u.x1 * 256 + wc * 32 + 4 * fq;
#pragma unroll
        for (int ai = 0; ai < 2; ++ai)
#pragma unroll
            for (int m = 0; m < 4; ++m) { float* rowp = C + (size_t)(row0 + ai * 128 + m * 16) * ldc + col0;
#pragma unroll
                for (int bj = 0; bj < 2; ++bj)
#pragma unroll
                    for (int n = 0; n < 2; ++n) *(f32x4*)(rowp + bj * 128 + n * 16) = acc[ai][bj][m][n]; }
    }
};
__device__ __forceinline__ void phase7(const Params& P, LAS unsigned char* lds) {
    unsigned char* ws = P.ws;
    SchedDense Sd{(const bf16_t*)(ws + WS_RA), (const bf16_t*)(ws + WS_WOUT), D / 2, D / 2, T / 256, D / 256};
    EpiBf16 E{(bf16_t*)(ws + WS_MIXED), D, (const float*)(ws + WS_SROW), (const float*)(ws + WS_QS) + 1};
    g8::gemm_phase<true, 2>(lds, D / 2, D / 2, Sd, E);
}

constexpr int LGS = 33;
__device__ __forceinline__ void phase9f(const Params& P, LAS unsigned char* lds) {
    unsigned char* ws = P.ws;
    const int tid = tidx(), wid = tid >> 6, lane = tid & 63;
    const float* ada = (const float*)(ws + WS_ADA);
    unsigned* cnt = (unsigned*)(ws + WS_CTL);
    LAS float* Wl = (LAS float*)lds;
    auto lgrow = [&](int tok) -> LAS float* { return tok < 62 ? (LAS float*)(lds + 131072) + tok * LGS : (LAS float*)(lds + LDS_RING + 1024) + (tok - 62) * LGS; };
    LAS unsigned* lcnt = (LAS unsigned*)(lds + LDS_RING + 1024 + 66 * LGS * 4);
    static_assert(131072 + 62 * LGS * 4 <= LDS_RING && LDS_RING + 1024 + 66 * LGS * 4 + 256 <= LDS_TOTAL, "phase 9 LDS layout");
    for (int q = tid; q < 8192; q += NTHREADS) {
        const int c = q >> 3, eq = q & 7; const f32x4 w = *(const f32x4*)(P.in[I_RW] + c * 32 + 4 * eq);
        *(LAS f32x4*)(Wl + ((((c >> 8) * 4 + (c & 3)) * 8 + eq) * 64 + ((c >> 2) & 63)) * 4) = w;
    }
    const bool b5 = (lane & 32) != 0, b4 = (lane & 16) != 0, b3 = (lane & 8) != 0, b2 = (lane & 4) != 0, b1 = (lane & 2) != 0, b0 = (lane & 1) != 0;
    for (int blk = blockIdx.x; blk < T / 128; blk += gridDim.x) {
        __syncthreads();
        { const int t0 = tidx(); if (t0 < 64) lcnt[t0] = 0u; }
        f32x4 A1[4], A2[4], A3[4];
        { const int b = (blk * 128) / S;
#pragma unroll
          for (int j = 0; j < 4; ++j) {
              const int c = 4 * (lane + 64 * j);
              A1[j] = *(const f32x4*)(P.in[I_MIXPOST] + c) * *(const f32x4*)(ada + b * 6144 + 2048 + c);
              A2[j] = *(const f32x4*)(P.in[I_FFNPRE] + c) * (*(const f32x4*)(ada + b * 6144 + 4096 + c) + 1.f);
              A3[j] = *(const f32x4*)(ada + b * 6144 + 3072 + c);
          } }
        for (int pr = 0; pr < 8; ++pr) {
            float hh[2][16];
            const int row0 = blk * 128 + wid * 16 + pr * 2;
            f32x4 xq[2][4]; u32x2 mq[2][4];
#pragma unroll
            for (int tk = 0; tk < 2; ++tk)
#pragma unroll
                for (int j = 0; j < 4; ++j) {
                    xq[tk][j] = ((const f32x4*)(P.in[I_X] + (size_t)(row0 + tk) * D) + lane)[64 * j];
                    mq[tk][j] = ((const u32x2*)((const bf16_t*)(ws + WS_MIXED) + (size_t)(row0 + tk) * D) + lane)[64 * j];
                }
#pragma unroll
            for (int tk = 0; tk < 2; ++tk) {
                const int row = row0 + tk;
                f32x4 m[4]; float sq = 0.f;
#pragma unroll
                for (int j = 0; j < 4; ++j) { const u32x2 w = mq[tk][j]; m[j] = (f32x4){__builtin_bit_cast(float, w.x << 16), __builtin_bit_cast(float, w.x & 0xffff0000u), __builtin_bit_cast(float, w.y << 16), __builtin_bit_cast(float, w.y & 0xffff0000u)};
                    sq += m[j].x * m[j].x + m[j].y * m[j].y + m[j].z * m[j].z + m[j].w * m[j].w; }
                const float rstd = rsqrtf(wave_sum(sq) * (1.f / D) + 1e-6f);
                f32x4 x1[4]; float s2 = 0.f;
#pragma unroll
                for (int j = 0; j < 4; ++j) {
                    x1[j] = xq[tk][j] + A1[j] * (m[j] * rstd);
                    s2 += x1[j].x * x1[j].x + x1[j].y * x1[j].y + x1[j].z * x1[j].z + x1[j].w * x1[j].w;
                    { u32x2 w; w.x = pk2(x1[j].x, x1[j].y); w.y = pk2(x1[j].z, x1[j].w); ((u32x2*)((bf16_t*)(ws + WS_X1) + (size_t)row * D))[lane + 64 * j] = w; }
                }
                const float rstd2 = rsqrtf(wave_sum(s2) * (1.f / D) + 1e-6f);
#pragma unroll
                for (int j = 0; j < 4; ++j) {
                    const f32x4 h = x1[j] * rstd2 * A2[j] + A3[j];
                    hh[tk][4 * j] = h.x; hh[tk][4 * j + 1] = h.y; hh[tk][4 * j + 2] = h.z; hh[tk][4 * j + 3] = h.w;
                    ((unsigned*)(ws + WS_H8 + (size_t)row * 1024))[lane + 64 * j] = pk4f8(__builtin_amdgcn_fmed3f(h.x, -448.f, 448.f), __builtin_amdgcn_fmed3f(h.y, -448.f, 448.f), __builtin_amdgcn_fmed3f(h.z, -448.f, 448.f), __builtin_amdgcn_fmed3f(h.w, -448.f, 448.f));
                }
            }
            typedef float f2 __attribute__((ext_vector_type(2)));
            f2 ac[2][16];
#pragma unroll
            for (int v = 0; v < 16; ++v) { ac[0][v] = (f2){0.f, 0.f}; ac[1][v] = (f2){0.f, 0.f}; }
            const LAS f32x4* wp = (const LAS f32x4*)Wl + lane;
            f32x4 wa[4], wb[4];
#define P9_LDW(dst, g) do { _Pragma("unroll") for (int q = 0; q < 4; ++q) dst[q] = wp[((g) * 4 + q) * 64]; } while (0)
#define P9_FMW(src, g) do { const float h0 = hh[0][(g) >> 1], h1 = hh[1][(g) >> 1]; _Pragma("unroll") for (int q = 0; q < 4; ++q) { const int eq = 4 * ((g) & 1) + q; const f2 w01 = {src[q].x, src[q].y}, w23 = {src[q].z, src[q].w}; \
                ac[0][2 * eq] += w01 * h0; ac[0][2 * eq + 1] += w23 * h0; ac[1][2 * eq] += w01 * h1; ac[1][2 * eq + 1] += w23 * h1; } } while (0)
            P9_LDW(wa, 0);
#pragma unroll
            for (int g = 0; g < 32; g += 2) {
                P9_LDW(wb, g + 1); __builtin_amdgcn_sched_barrier(0);
                P9_FMW(wa, g); __builtin_amdgcn_sched_barrier(0);
                if (g + 2 < 32) P9_LDW(wa, g + 2);
                __builtin_amdgcn_sched_barrier(0);
                P9_FMW(wb, g + 1); __builtin_amdgcn_sched_barrier(0);
            }
#undef P9_LDW
#undef P9_FMW
            float a64[64];
#pragma unroll
            for (int v = 0; v < 16; ++v) { a64[2 * v] = ac[0][v].x; a64[2 * v + 1] = ac[0][v].y; a64[32 + 2 * v] = ac[1][v].x; a64[32 + 2 * v + 1] = ac[1][v].y; }
            float a32[32], a16[16], a8[8], a4[4], a2[2];
#pragma unroll
            for (int i = 0; i < 32; ++i) { const float keep = b5 ? a64[i + 32] : a64[i], send = b5 ? a64[i] : a64[i + 32]; a32[i] = keep + __shfl_xor(send, 32); }
#pragma unroll
            for (int i = 0; i < 16; ++i) { const float keep = b4 ? a32[i + 16] : a32[i], send = b4 ? a32[i] : a32[i + 16]; a16[i] = keep + __shfl_xor(send, 16); }
#pragma unroll
            for (int i = 0; i < 8; ++i) { const float keep = b3 ? a16[i + 8] : a16[i], send = b3 ? a16[i] : a16[i + 8]; a8[i] = keep + __shfl_xor(send, 8); }
#pragma unroll
            for (int i = 0; i < 4; ++i) { const float keep = b2 ? a8[i + 4] : a8[i], send = b2 ? a8[i] : a8[i + 4]; a4[i] = keep + __shfl_xor(send, 4); }
#pragma unroll
            for (int i = 0; i < 2; ++i) { const float keep = b1 ? a4[i + 2] : a4[i], send = b1 ? a4[i] : a4[i + 2]; a2[i] = keep + __shfl_xor(send, 2); }
            { const float keep = b0 ? a2[1] : a2[0], send = b0 ? a2[0] : a2[1];
              lgrow(wid * 16 + pr * 2 + (lane >> 5))[lane & 31] = keep + __shfl_xor(send, 1); }
        }
        __syncthreads();
        const int t2 = tidx();
        int ti[4] = {0, 0, 0, 0}; float wv[4] = {0.f, 0.f, 0.f, 0.f}; unsigned rk[4] = {0u, 0u, 0u, 0u};
        const int row = blk * 128 + t2;
        if (t2 < 128) {
            float lg[32];
            { const LAS float* lr = lgrow(t2);
#pragma unroll
              for (int e = 0; e < 32; ++e) lg[e] = lr[e] + P.in[I_RB][e]; }
            float tv[4];
#pragma unroll
            for (int r = 0; r < 4; ++r) {
                float bv = lg[0]; int bi = 0;
#pragma unroll
                for (int e = 1; e < 32; ++e) if (lg[e] > bv) { bv = lg[e]; bi = e; }
                tv[r] = bv; ti[r] = bi;
#pragma unroll
                for (int e = 0; e < 32; ++e) if (e == bi) lg[e] = -3.0e38f;
            }
            const float e1 = __expf(tv[1] - tv[0]), e2 = __expf(tv[2] - tv[0]), e3 = __expf(tv[3] - tv[0]);
            const float inv = 1.f / (1.f + e1 + e2 + e3);
            wv[0] = inv; wv[1] = e1 * inv; wv[2] = e2 * inv; wv[3] = e3 * inv;
#pragma unroll
            for (int r = 0; r < 4; ++r) rk[r] = atomicAdd((unsigned*)(lcnt + ti[r]), 1u);
        }
        __syncthreads();
        if (t2 < 32) lcnt[32 + t2] = atomicAdd(cnt + t2, lcnt[t2]);
        __syncthreads();
        if (t2 < 128) {
#pragma unroll
            for (int r = 0; r < 4; ++r) {
                const unsigned pos = lcnt[32 + ti[r]] + rk[r];
                ((u32x2*)(ws + WS_LIST))[(size_t)ti[r] * T + pos] = (u32x2){(unsigned)(row * 4 + r), 0u};
                ((unsigned*)(ws + WS_TOKW))[row * 4 + r] = ((unsigned)ti[r] << 20) | pos;
                ((float*)(ws + WS_TOKW + 524288))[row * 4 + r] = wv[r];
            }
        }
    }
}

constexpr int MOE_TAB_OFF = LDS_RING + 256;
__device__ __forceinline__ void moe_table(const unsigned* cnt, int ntn, LAS unsigned char* lds) {
    LAS int* tab = (LAS int*)(lds + MOE_TAB_OFF);
    __syncthreads();
    if (tidx() < 64) {
        const int lane = tidx(); const int c = lane < NE ? (int)cnt[lane] : 0, m = (c + 255) >> 8;
        int inc = m;
#pragma unroll
        for (int o = 1; o < 32; o <<= 1) { const int t = __shfl_up(inc, o); if (lane >= o) inc += t; }
        if (lane < NE) { tab[lane] = (inc - m) * ntn; tab[64 + lane] = (inc - m) * 256; tab[128 + lane] = c; }
        if (lane == NE - 1) tab[NE] = inc * ntn;
    }
    __syncthreads();
}
__device__ __forceinline__ bool moe_unit(LAS unsigned char* lds, int u, int ntn, int& e, int& mt, int& nt, int& base_rows, int& ce) {
    const LAS int* tab = (const LAS int*)(lds + MOE_TAB_OFF);
    const int lane = tidx() & 63;
    if (u >= tab[NE]) return false;
    const int st = lane < NE ? tab[lane] : 0x7fffffff;
    const unsigned long long bal = __ballot(u >= st);
    e = __builtin_popcountll(bal) - 1;
    const int r = u - tab[e]; mt = r / ntn; nt = r % ntn; base_rows = tab[64 + e]; ce = tab[128 + e];
    return true;
}
struct SchedGU {
    LAS unsigned char* lds; const u32x2* list; const unsigned char* H8; const unsigned char* W;
    __device__ __forceinline__ bool next(int i, g8::Unit& u, int R0, int C0, int R1, int C1) const {
        int e, mt, nt, base, ce; if (!moe_unit(lds, (int)((blockIdx.x & 7) * (gridDim.x >> 3) + (blockIdx.x >> 3)) + i * (int)gridDim.x, 8, e, mt, nt, base, ce)) return false;
        const u32x2* le = list + (size_t)e * T;
        const int i00 = mt * 256 + R0, i01 = mt * 256 + R1, i10 = i00 + 128, i11 = i01 + 128;
        const int t00 = (int)(i00 < ce ? le[i00].x : 0u) >> 2, t01 = (int)(i01 < ce ? le[i01].x : 0u) >> 2, t10 = (int)(i10 < ce ? le[i10].x : 0u) >> 2, t11 = (int)(i11 < ce ? le[i11].x : 0u) >> 2;
        u.A = g8::uptr(H8); u.B = g8::uptr(W + ((size_t)e * 2048 + nt * 256) * 1024);
        u.va[0][0] = (unsigned)(t00 * 512 + C0) * 2u; u.va[0][1] = (unsigned)(t01 * 512 + C1) * 2u; u.va[1][0] = (unsigned)(t10 * 512 + C0) * 2u; u.va[1][1] = (unsigned)(t11 * 512 + C1) * 2u;
        u.x0 = g8::ui(base + mt * 256); u.x1 = g8::ui(nt); u.x2 = g8::ui(e); u.x3 = g8::ui(ce - mt * 256); return true;
    }
};
struct EpiGU {
    unsigned char* act; const float* bgu;
    __device__ __forceinline__ void operator()(const f32x4 (&acc)[2][2][4][2], const g8::Unit& u, int wr, int wc, int fr, int fq) const {
        const int col = u.x1 * 128 + wc * 32 + 8 * fq; const float* bg = bgu + (size_t)u.x2 * 2048 + col;
        const f32x4 bg0 = *(const f32x4*)bg, bg1 = *(const f32x4*)(bg + 4), bu0 = *(const f32x4*)(bg + 1024), bu1 = *(const f32x4*)(bg + 1028);
#pragma unroll
        for (int ai = 0; ai < 2; ++ai)
#pragma unroll
            for (int m = 0; m < 4; ++m) {
                const int r = ai * 128 + wr * 64 + m * 16 + fr;
                f32x4 o[2];
#pragma unroll
                for (int n = 0; n < 2; ++n) {
                    typedef float f2 __attribute__((ext_vector_type(2)));
                    const f32x4 ag = acc[ai][0][m][n], au = acc[ai][1][m][n], bgv = n ? bg1 : bg0, buv = n ? bu1 : bu0;
#pragma unroll
                    for (int h = 0; h < 2; ++h) {
                        const f2 gv = (f2){ag[2 * h], ag[2 * h + 1]} * (1.f / 32.f) + (f2){bgv[2 * h], bgv[2 * h + 1]};
                        const f2 uv = (f2){au[2 * h], au[2 * h + 1]} * (1.f / 32.f) + (f2){buv[2 * h], buv[2 * h + 1]};
                        const f2 gate = {fminf(gv.x, 7.f), fminf(gv.y, 7.f)}, up = {__builtin_amdgcn_fmed3f(uv.x, -7.f, 7.f), __builtin_amdgcn_fmed3f(uv.y, -7.f, 7.f)};
                        const f2 tt = gate * -2.4554669595930156f;
                        const f2 den = (f2){__builtin_amdgcn_exp2f(tt.x), __builtin_amdgcn_exp2f(tt.y)} + 1.f;
                        const f2 gs = gate * (f2){__builtin_amdgcn_rcpf(den.x), __builtin_amdgcn_rcpf(den.y)};
                        const f2 ov = up * gs + gs;
                        o[n][2 * h] = ov.x; o[n][2 * h + 1] = ov.y;
                    }
                }
                u32x2 w; w.x = pk4f8(o[0][0], o[0][1], o[0][2], o[0][3]); w.y = pk4f8(o[1][0], o[1][1], o[1][2], o[1][3]);
                *(u32x2*)(act + (size_t)(u.x0 + r) * D + col) = w;
                asm volatile("" ::: "memory");
            }
    }
};
__device__ __forceinline__ void phase9(const Params& P, LAS unsigned char* lds) {
    unsigned char* ws = P.ws;
    moe_table((const unsigned*)(ws + WS_CTL), 8, lds);
    SchedGU Sg{lds, (const u32x2*)(ws + WS_LIST), ws + WS_H8, ws + WS_GU};
    EpiGU E{ws + WS_ACT, P.in[I_EBGU]};
    g8::gemm_phase<true, true>(lds, D / 2, D / 2, Sg, E);
}
struct SchedDN {
    LAS unsigned char* lds; const unsigned char* act; const unsigned char* W;
    __device__ __forceinline__ bool next(int i, g8::Unit& u, int R0, int C0, int R1, int C1) const {
        int e, mt, nt, base, ce; if (!moe_unit(lds, (int)((blockIdx.x & 7) * (gridDim.x >> 3) + (blockIdx.x >> 3)) + i * (int)gridDim.x, 4, e, mt, nt, base, ce)) return false;
        g8::dense_unit(u, (const bf16_t*)(act + (size_t)(base + mt * 256) * D), D / 2, (const bf16_t*)(W + ((size_t)e * 1024 + nt * 256) * 1024), D / 2, 0, 0, R0, C0, R1, C1);
        u.x0 = g8::ui(base + mt * 256); u.x1 = g8::ui(nt); u.x2 = g8::ui(e); u.x3 = 0; return true;
    }
};
struct EpiDN {
    bf16_t* yk; const float* bdn;
    __device__ __forceinline__ void operator()(const f32x4 (&acc)[2][2][4][2], const g8::Unit& u, int wr, int wc, int fr, int fq) const {
        f32x4 bd[2][2];
#pragma unroll
        for (int bj = 0; bj < 2; ++bj) { const float* bp = bdn + (size_t)u.x2 * 1024 + u.x1 * 256 + bj * 128 + wc * 32 + 8 * fq; bd[bj][0] = *(const f32x4*)bp; bd[bj][1] = *(const f32x4*)(bp + 4); }
#pragma unroll
        for (int ai = 0; ai < 2; ++ai)
#pragma unroll
            for (int m = 0; m < 4; ++m) {
                bf16_t* rowp = yk + (size_t)(u.x0 + ai * 128 + wr * 64 + m * 16 + fr) * D + u.x1 * 256 + wc * 32 + 8 * fq;
#pragma unroll
                for (int bj = 0; bj < 2; ++bj) {
                    const f32x4 v0 = acc[ai][bj][m][0] * (1.f / 32.f) + bd[bj][0], v1 = acc[ai][bj][m][1] * (1.f / 32.f) + bd[bj][1];
                    u32x4 o; o.x = g8::cvt_pk_bf16(v0[0], v0[1]); o.y = g8::cvt_pk_bf16(v0[2], v0[3]); o.z = g8::cvt_pk_bf16(v1[0], v1[1]); o.w = g8::cvt_pk_bf16(v1[2], v1[3]);
                    *(u32x4*)(rowp + bj * 128) = o;
                }
            }
    }
};
__device__ __forceinline__ void phase10(const Params& P, LAS unsigned char* lds) {
    unsigned char* ws = P.ws;
    moe_table((const unsigned*)(ws + WS_CTL), 4, lds);
    SchedDN Sn{lds, ws + WS_ACT, ws + WS_DN};
    EpiDN E{(bf16_t*)(ws + WS_YK), P.in[I_EBDN]};
    g8::gemm_phase<true, true>(lds, D / 2, D / 2, Sn, E);
}

__device__ __forceinline__ void phase11(const Params& P, LAS unsigned char* lds) {
    unsigned char* ws = P.ws;
    const int lane = tidx() & 63, gw = blockIdx.x * NWAVES + (tidx() >> 6), ngw = gridDim.x * NWAVES;
    const float* ada = (const float*)(ws + WS_ADA);
    LAS int* ebase = (LAS int*)lds;
    if (tidx() == 0) { const unsigned* cnt = (const unsigned*)(ws + WS_CTL); int rows = 0; for (int i = 0; i < NE; ++i) { ebase[i] = rows; rows += (((int)cnt[i] + 255) >> 8) * 256; } }
    __syncthreads();
    u32x4 tpn = {0u, 0u, 0u, 0u}; f32x4 twn = {0.f, 0.f, 0.f, 0.f};
    if (gw < T) { tpn = *(const u32x4*)((const unsigned*)(ws + WS_TOKW) + (size_t)gw * 4); twn = *(const f32x4*)((const float*)(ws + WS_TOKW + 524288) + (size_t)gw * 4); }
    for (int row = gw; row < T; row += ngw) {
        const int b = row / S;
        const u32x4 tp0 = tpn; const f32x4 tw0 = twn;
        { const int nrow = row + ngw < T ? row + ngw : row; tpn = *(const u32x4*)((const unsigned*)(ws + WS_TOKW) + (size_t)nrow * 4); twn = *(const f32x4*)((const float*)(ws + WS_TOKW + 524288) + (size_t)nrow * 4); }
        u32x2 xwq[4];
#pragma unroll
        for (int j = 0; j < 4; ++j) xwq[j] = ((const u32x2*)((const bf16_t*)(ws + WS_X1) + (size_t)row * D))[lane + 64 * j];
        const unsigned ep[4] = {tp0.x, tp0.y, tp0.z, tp0.w}; const float wk[4] = {tw0.x, tw0.y, tw0.z, tw0.w};
        f32x4 y[4]; float s = 0.f;
#pragma unroll
        for (int j = 0; j < 4; ++j) y[j] = (f32x4){0.f, 0.f, 0.f, 0.f};
#pragma unroll
        for (int k = 0; k < 4; ++k) {
            const size_t prow = (size_t)(ebase[ep[k] >> 20] + (int)(ep[k] & 0xfffffu));
            const u32x2* yr = (const u32x2*)((const bf16_t*)(ws + WS_YK) + prow * D);
#pragma unroll
            for (int j = 0; j < 4; ++j) { const u32x2 w = yr[lane + 64 * j];
                y[j].x += wk[k] * __builtin_bit_cast(float, w.x << 16); y[j].y += wk[k] * __builtin_bit_cast(float, w.x & 0xffff0000u); y[j].z += wk[k] * __builtin_bit_cast(float, w.y << 16); y[j].w += wk[k] * __builtin_bit_cast(float, w.y & 0xffff0000u); }
        }
#pragma unroll
        for (int j = 0; j < 4; ++j) s += y[j].x * y[j].x + y[j].y * y[j].y + y[j].z * y[j].z + y[j].w * y[j].w;
        const float rstd = rsqrtf(wave_sum(s) * (1.f / D) + 1e-6f);
#pragma unroll
        for (int j = 0; j < 4; ++j) {
            const int c = 4 * (lane + 64 * j);
            const f32x4 g = *(const f32x4*)(P.in[I_FFNPOST] + c), gf = *(const f32x4*)(ada + b * 6144 + 5120 + c);
            const u32x2 xw = xwq[j];
            const f32x4 x1 = {__builtin_bit_cast(float, xw.x << 16), __builtin_bit_cast(float, xw.x & 0xffff0000u), __builtin_bit_cast(float, xw.y << 16), __builtin_bit_cast(float, xw.y & 0xffff0000u)};
            ((f32x4*)(P.out + (size_t)row * D))[lane + 64 * j] = x1 + gf * (y[j] * rstd * g);
        }
    }
}

#define RLX_AGENT __ATOMIC_RELAXED, __HIP_MEMORY_SCOPE_AGENT
#define XB_TMO      128
#define XB_XCNT(j)  (256  + 64 * (j))
#define XB_XSUB(j)  (1280 + 64 * (j))
#define XB_XGEN(j)  (2304 + 64 * (j))
#define XB_TOP      3328
#define XB_TOPGEN   3392
#define XCD_BAR_WORDS 3456
#define XB_SPIN_CAP (1u << 18)

__device__ __forceinline__ unsigned xb_ld(unsigned* p)              { return __hip_atomic_load(p, __ATOMIC_RELAXED, __HIP_MEMORY_SCOPE_AGENT); }
__device__ __forceinline__ unsigned xb_add(unsigned* p, unsigned v) { return __hip_atomic_fetch_add(p, v, __ATOMIC_RELAXED, __HIP_MEMORY_SCOPE_AGENT); }
__device__ __forceinline__ unsigned xb_xcc_id() { return (unsigned)__builtin_amdgcn_s_getreg((3 << 11) | 20) & 0xFu; }
#define XB_SPIN(cond, bar) do { unsigned _sp = 0; while (cond) { __builtin_amdgcn_s_sleep(1); \
    if ((++_sp & 255u) == 0u) { if (xb_ld(&(bar)[XB_TMO])) break; if (_sp > XB_SPIN_CAP) { atomicAdd(&(bar)[XB_TMO], 1u); break; } } } } while (0)

struct XcdBarrier {
    unsigned* bar; unsigned x;
    volatile LAS unsigned* st;
};

__device__ __forceinline__ XcdBarrier xcd_barrier_post(unsigned* bar, volatile LAS unsigned* st) {
    XcdBarrier b; b.bar = bar; b.x = xb_xcc_id(); b.st = st;
    if (threadIdx.x == 0) (void)xb_add(&bar[XB_XCNT(b.x)], 1u);
    return b;
}
__device__ __forceinline__ void xcd_barrier_complete(unsigned* bar, unsigned x, unsigned& nloc, unsigned& nx) {
    const unsigned G = gridDim.x * gridDim.y * gridDim.z;
    unsigned sum, cnt, mine, sp = 0u;
    for (;;) {
        sum = 0u; cnt = 0u; mine = 0u;
#pragma unroll
        for (unsigned j = 0; j < 16; ++j) { const unsigned c = xb_ld(&bar[XB_XCNT(j)]); sum += c; cnt += (c > 0u) ? 1u : 0u; mine = (j == x) ? c : mine; }
        if (sum == G) break;
        __builtin_amdgcn_s_sleep(1);
        if ((++sp & 255u) == 0u) { if (xb_ld(&bar[XB_TMO])) break; if (sp > XB_SPIN_CAP) { atomicAdd(&bar[XB_TMO], 1u); break; } }
    }
    nloc = mine > 0u ? mine : 1u; nx = cnt > 0u ? cnt : 1u;
}

__device__ __forceinline__ void xcd_barrier(const XcdBarrier& b) {
    asm volatile("s_waitcnt vmcnt(0)" ::: "memory");
    __syncthreads();
    if (threadIdx.x == 0) {
        unsigned* bar = b.bar;
        __builtin_amdgcn_s_waitcnt(0);
        unsigned nloc = b.st[0], nx = b.st[1];
        if (nloc == 0u) { xcd_barrier_complete(bar, b.x, nloc, nx); b.st[0] = nloc; b.st[1] = nx; }
        const unsigned old = xb_add(&bar[XB_XSUB(b.x)], 1u);
        const unsigned gen = old / nloc;
        if (old + 1u == (gen + 1u) * nloc) {
            __builtin_amdgcn_fence(__ATOMIC_RELEASE, "agent");
            asm volatile("s_waitcnt vmcnt(0)" ::: "memory");
            const unsigned og = xb_add(&bar[XB_TOP], 1u);
            const unsigned tg = og / nx;
            if (og + 1u == (tg + 1u) * nx) xb_add(&bar[XB_TOPGEN], 1u);
            else XB_SPIN(xb_ld(&bar[XB_TOPGEN]) == tg, bar);
            __builtin_amdgcn_fence(__ATOMIC_ACQUIRE, "agent");
            xb_add(&bar[XB_XGEN(b.x)], 1u);
            asm volatile("s_waitcnt vmcnt(0)" ::: "memory");
        } else {
            XB_SPIN(xb_ld(&bar[XB_XGEN(b.x)]) == gen, bar);
            __builtin_amdgcn_fence(__ATOMIC_ACQUIRE, "agent");
            asm volatile("s_waitcnt vmcnt(0)" ::: "memory");
        }
    }
    __syncthreads();
}


static_assert(att::LDS_NEED <= LDS_RING && g8::STAGE_BYTES <= LDS_RING, "LDS ring");
__global__ void __launch_bounds__(NTHREADS, 2) mega(Params P, int ph_lo, int ph_hi) {
    extern __shared__ __attribute__((aligned(16))) unsigned char lds_raw[];
    LAS unsigned char* lds = (LAS unsigned char*)lds_raw;
    float* ldsf = (float*)lds_raw;
    cg::grid_group grid = cg::this_grid();
    LAS unsigned* bst = (LAS unsigned*)(lds + LDS_RING);
    if (threadIdx.x < 2) bst[threadIdx.x] = 0u;
    __syncthreads();
    const bool one = (ph_hi - ph_lo) > 1;
    XcdBarrier bar; bar.bar = (unsigned*)(P.ws + WS_BAR); bar.x = 0; bar.st = nullptr;
    if (one) bar = xcd_barrier_post((unsigned*)(P.ws + WS_BAR), (volatile LAS unsigned*)bst);
#define RUN_PHASE(k, call) do { if (ph_lo <= (k) && (k) < ph_hi) { call; if ((k) + 1 < ph_hi) { if ((k) == 0 && ph_hi > 1000) grid.sync(); else xcd_barrier(bar); } } } while (0)
    RUN_PHASE(0, phase0(P, ldsf));
    RUN_PHASE(1, phase1(P));
    RUN_PHASE(2, phase2(P, lds));
    RUN_PHASE(3, phase3(P, lds));
    RUN_PHASE(4, phase4(P, lds, ldsf));
    RUN_PHASE(5, phase5p(P));
    RUN_PHASE(6, phase5(P, lds, ldsf));
    RUN_PHASE(7, phase6(P));
    RUN_PHASE(8, phase7(P, lds));
    RUN_PHASE(9, phase9f(P, lds));
    RUN_PHASE(10, phase9(P, lds));
    RUN_PHASE(11, phase10(P, lds));
    RUN_PHASE(12, phase11(P, lds));
#undef RUN_PHASE
}

extern "C" void kernel_launch(void* const* d_in, const int* in_sizes, int n_in, void* d_out, int out_size, void* d_ws, size_t ws_size, hipStream_t stream) {
    static int grid = 0;
    if (grid == 0) {
        if (n_in != 34 || out_size != T * D || ws_size < WS_END) { fprintf(stderr, "kernel_launch: unexpected problem (n_in %d, out %d, ws %zu)\n", n_in, out_size, ws_size); grid = -1; return; }
        int dev = 0, cus = 0, per_cu = 0;
        (void)hipGetDevice(&dev);
        (void)hipDeviceGetAttribute(&cus, hipDeviceAttributeMultiprocessorCount, dev);
        if (hipFuncSetAttribute((const void*)mega, hipFuncAttributeMaxDynamicSharedMemorySize, LDS_TOTAL) != hipSuccess) { fprintf(stderr, "kernel_launch: hipFuncSetAttribute failed\n"); grid = -1; return; }
        (void)hipOccupancyMaxActiveBlocksPerMultiprocessor(&per_cu, mega, NTHREADS, LDS_TOTAL);
        if (per_cu < 1) { fprintf(stderr, "kernel_launch: occupancy query says %d\n", per_cu); grid = -1; return; }
        grid = cus;
    }
    if (grid < 0) return;
    Params p{};
    for (int i = 0; i < 34; ++i) p.in[i] = (const float*)d_in[i];
    p.out = (float*)d_out; p.ws = (unsigned char*)d_ws;
#if MK_ONE_LAUNCH
    (void)hipMemsetAsync((char*)d_ws + WS_BAR, 0, XCD_BAR_WORDS * 4, stream);
    int lo = 0, hi = NPHASES;
    void* args[] = {&p, &lo, &hi};
    hipError_t e = hipLaunchCooperativeKernel((void*)mega, dim3(grid), dim3(NTHREADS), args, LDS_TOTAL, stream);
    if (e != hipSuccess) fprintf(stderr, "cooperative launch failed: %s (grid %d)\n", hipGetErrorString(e), grid);
#else
    for (int ph = 0; ph < NPHASES; ++ph) hipLaunchKernelGGL(mega, dim3(grid), dim3(NTHREADS), LDS_TOTAL, stream, p, ph, ph + 1);
#endif
}
```
